# Optimizing an MI355X kernel written in HIP

```python
import math
import jax, jax.numpy as jnp
from jax import lax
import numpy as np

D_MODEL = 1024
BATCH = 4
SEQ = 8192
DEPTH = 2
DEC_BATCH = 16
DEC_SEQ = 64
PAST_LEN = 4096

CHUNK = 64
N_MIXERS = 2
N_SSM_LAYERS = (DEPTH + 1) // 2
N_FOX_LAYERS = DEPTH // 2
SSM_GROUP = 16
SSM_GROUPS = D_MODEL // SSM_GROUP
SSM_STATE = 64
SSM_DT_MIN = 1e-3
SSM_DT_MAX = 1e-1
FOX_HEADS = 16
FOX_HEAD_DIM = D_MODEL // FOX_HEADS
FOX_Q_BLOCK = 128
FOX_BIAS_INIT = 3.0
D_FF = 2816
CONV_WIDTH = 3
NORM_EPS = 1e-6
NEG_INF = -1e30

kernel_name = "hybrid_s5_fox_convffn_stream_step"


def rms_norm(x, g):
    x32 = x.astype(jnp.float32)
    y = x32 * lax.rsqrt(jnp.mean(x32 * x32, axis=-1, keepdims=True) + NORM_EPS)
    return (y * g.astype(jnp.float32)).astype(x.dtype)


def _cmul(ar, ai, br, bi):
    return ar * br - ai * bi, ar * bi + ai * br


def _ssm_combine(earlier, later):
    a1r, a1i, b1r, b1i = earlier
    a2r, a2i, b2r, b2i = later
    ar, ai = _cmul(a2r, a2i, a1r, a1i)
    br, bi = _cmul(a2r, a2i, b1r, b1i)
    return ar, ai, br + b2r, bi + b2i


def s5_mixer(u, h0_re, h0_im, a_re, a_im, log_step, b_re, b_im, c_re, c_im, d_skip, w_glu):
    n, l, _ = u.shape
    f32 = jnp.float32
    lam_re = a_re.astype(f32)
    lam_im = a_im.astype(f32)
    dt = jnp.exp(log_step.astype(f32))[:, None]
    mag = jnp.exp(lam_re * dt)
    abar_re = mag * jnp.cos(lam_im * dt)
    abar_im = mag * jnp.sin(lam_im * dt)
    den = lam_re * lam_re + lam_im * lam_im
    nr = abar_re - 1.0
    z_re = (nr * lam_re + abar_im * lam_im) / den
    z_im = (abar_im * lam_re - nr * lam_im) / den
    bb_re, bb_im = _cmul(z_re[..., None], z_im[..., None], b_re.astype(f32), b_im.astype(f32))
    ug = u.astype(f32).reshape(n, l, SSM_GROUPS, SSM_GROUP)
    bu_re = jnp.einsum('nlgh,gph->nlgp', ug, bb_re)
    bu_im = jnp.einsum('nlgh,gph->nlgp', ug, bb_im)
    h0r, h0i = _cmul(abar_re, abar_im, h0_re.astype(f32), h0_im.astype(f32))
    bu_re = bu_re.at[:, 0].add(h0r)
    bu_im = bu_im.at[:, 0].add(h0i)
    a_r = jnp.broadcast_to(abar_re, (1, l) + abar_re.shape)
    a_i = jnp.broadcast_to(abar_im, (1, l) + abar_im.shape)
    _, _, s_re, s_im = lax.associative_scan(_ssm_combine, (a_r, a_i, bu_re, bu_im), axis=1)
    y = (jnp.einsum('nlgp,ghp->nlgh', s_re, c_re.astype(f32))
         - jnp.einsum('nlgp,ghp->nlgh', s_im, c_im.astype(f32)))
    y = y.reshape(n, l, D_MODEL) + d_skip.astype(f32) * u.astype(f32)
    g = jax.nn.gelu(y).astype(u.dtype)
    val, gate = jnp.split(g @ w_glu, 2, axis=-1)
    return val * jax.nn.sigmoid(gate), s_re[:, -1], s_im[:, -1]


def fox_project(u, w_qkvf, b_f):
    n, l, _ = u.shape
    proj = u @ w_qkvf
    q = proj[..., :D_MODEL].reshape(n, l, FOX_HEADS, FOX_HEAD_DIM)
    k = proj[..., D_MODEL:2 * D_MODEL].reshape(n, l, FOX_HEADS, FOX_HEAD_DIM)
    v = proj[..., 2 * D_MODEL:3 * D_MODEL].reshape(n, l, FOX_HEADS, FOX_HEAD_DIM)
    logf = jax.nn.log_sigmoid(proj[..., 3 * D_MODEL:].astype(jnp.float32) + b_f.astype(jnp.float32))
    return q, k, v, logf


def fox_attend(q, k, v, c_q, c_k, q_pos, k_pos):
    s = jnp.einsum('nqhe,nkhe->nhqk', q, k, preferred_element_type=jnp.float32) * (FOX_HEAD_DIM ** -0.5)
    s = s + (jnp.transpose(c_q, (0, 2, 1))[..., :, None] - jnp.transpose(c_k, (0, 2, 1))[..., None, :])
    mask = k_pos[None, :] <= q_pos[:, None]
    s = jnp.where(mask, s, NEG_INF)
    p = jax.nn.softmax(s, axis=-1)
    return jnp.einsum('nhqk,nkhe->nqhe', p.astype(v.dtype), v)


def fox_prompt(u, w_qkvf, b_f, w_o):
    n, l, _ = u.shape
    q, k, v, logf = fox_project(u, w_qkvf, b_f)
    c = jnp.cumsum(logf, axis=1)
    nb = l // FOX_Q_BLOCK
    qb = q.reshape(n, nb, FOX_Q_BLOCK, FOX_HEADS, FOX_HEAD_DIM).transpose(1, 0, 2, 3, 4)
    cb = c.reshape(n, nb, FOX_Q_BLOCK, FOX_HEADS).transpose(1, 0, 2, 3)
    pos = jnp.arange(l)
    pb = pos.reshape(nb, FOX_Q_BLOCK)
    ob = lax.map(lambda blk: fox_attend(blk[0], k, v, blk[1], c, blk[2], pos), (qb, cb, pb))
    o = ob.transpose(1, 0, 2, 3, 4).reshape(n, l, D_MODEL)
    return o @ w_o, k, v, logf


def fox_sample(u, cache_k, cache_v, cache_logf, w_qkvf, b_f, w_o):
    n, t, _ = u.shape
    past = cache_k.shape[1]
    q, k, v, logf = fox_project(u, w_qkvf, b_f)
    k_all = jnp.concatenate([cache_k.astype(k.dtype), k], axis=1)
    v_all = jnp.concatenate([cache_v.astype(v.dtype), v], axis=1)
    c = jnp.cumsum(jnp.concatenate([cache_logf.astype(jnp.float32), logf], axis=1), axis=1)
    k_pos = jnp.arange(past + t)
    q_pos = past + jnp.arange(t)
    o = fox_attend(q, k_all, v_all, c[:, past:], c, q_pos, k_pos).reshape(n, t, D_MODEL)
    return o @ w_o, k, v, logf


def conv_ffn(x, hist, w_up, w_gate, conv_w, conv_b, w_down):
    l = x.shape[1]
    a = x @ w_up
    a_pad = jnp.concatenate([hist.astype(a.dtype), a], axis=1)
    conv = a_pad[:, 0:l] * conv_w[0]
    for j in range(1, CONV_WIDTH):
        conv = conv + a_pad[:, j:j + l] * conv_w[j]
    h = jax.nn.gelu(conv + conv_b) * (x @ w_gate)
    return h @ w_down, a_pad[:, -(CONV_WIDTH - 1):]


def setup_inputs(seed: int = 0) -> dict:
    key = jax.random.key(seed)
    ks = jax.random.split(key, 32)
    f32 = jnp.float32

    def nrm(k, shape, scale):
        return scale * jax.random.normal(k, shape, f32)

    n_idx = jnp.arange(SSM_STATE, dtype=f32)
    ssm_shape = (N_SSM_LAYERS, SSM_GROUPS, SSM_STATE)
    return {
        "x_prompt": nrm(ks[0], (BATCH, SEQ, D_MODEL), 1.0),
        "x_sample": nrm(ks[1], (DEC_BATCH, DEC_SEQ, D_MODEL), 1.0),
        "state_ssm_re": nrm(ks[2], (N_SSM_LAYERS, DEC_BATCH, SSM_GROUPS, SSM_STATE), 0.1),
        "state_ssm_im": nrm(ks[3], (N_SSM_LAYERS, DEC_BATCH, SSM_GROUPS, SSM_STATE), 0.1),
        "cache_fox_k": nrm(ks[4], (N_FOX_LAYERS, DEC_BATCH, PAST_LEN, FOX_HEADS, FOX_HEAD_DIM), 1.0),
        "cache_fox_v": nrm(ks[5], (N_FOX_LAYERS, DEC_BATCH, PAST_LEN, FOX_HEADS, FOX_HEAD_DIM), 1.0),
        "cache_fox_logf": jax.nn.log_sigmoid(FOX_BIAS_INIT + nrm(ks[6], (N_FOX_LAYERS, DEC_BATCH, PAST_LEN, FOX_HEADS), 1.0)),
        "state_ffn_conv": nrm(ks[7], (DEPTH, DEC_BATCH, CONV_WIDTH - 1, D_FF), 1.0),
        "norm_mix": 1.0 + nrm(ks[8], (DEPTH, D_MODEL), 0.05),
        "norm_ffn": 1.0 + nrm(ks[9], (DEPTH, D_MODEL), 0.05),
        "norm_final": 1.0 + nrm(ks[10], (D_MODEL,), 0.05),
        "ssm_a_re": -0.5 + nrm(ks[11], ssm_shape, 0.01),
        "ssm_a_im": jnp.broadcast_to(np.pi * n_idx, ssm_shape) + nrm(ks[12], ssm_shape, 0.01),
        "ssm_log_step": jax.random.uniform(ks[13], (N_SSM_LAYERS, SSM_GROUPS), f32,
                                           minval=math.log(SSM_DT_MIN), maxval=math.log(SSM_DT_MAX)),
        "ssm_b_re": nrm(ks[14], (N_SSM_LAYERS, SSM_GROUPS, SSM_STATE, SSM_GROUP), (2 * SSM_GROUP) ** -0.5),
        "ssm_b_im": nrm(ks[15], (N_SSM_LAYERS, SSM_GROUPS, SSM_STATE, SSM_GROUP), (2 * SSM_GROUP) ** -0.5),
        "ssm_c_re": nrm(ks[16], (N_SSM_LAYERS, SSM_GROUPS, SSM_GROUP, SSM_STATE), SSM_STATE ** -0.5),
        "ssm_c_im": nrm(ks[17], (N_SSM_LAYERS, SSM_GROUPS, SSM_GROUP, SSM_STATE), SSM_STATE ** -0.5),
        "ssm_d": nrm(ks[18], (N_SSM_LAYERS, D_MODEL), 1.0),
        "ssm_w_glu": nrm(ks[19], (N_SSM_LAYERS, D_MODEL, 2 * D_MODEL), D_MODEL ** -0.5),
        "fox_w_qkvf": nrm(ks[20], (N_FOX_LAYERS, D_MODEL, 3 * D_MODEL + FOX_HEADS), D_MODEL ** -0.5),
        "fox_b_f": FOX_BIAS_INIT + nrm(ks[21], (N_FOX_LAYERS, FOX_HEADS), 0.5),
        "fox_w_o": nrm(ks[22], (N_FOX_LAYERS, D_MODEL, D_MODEL), D_MODEL ** -0.5),
        "ffn_w_up": nrm(ks[23], (DEPTH, D_MODEL, D_FF), D_MODEL ** -0.5),
        "ffn_w_gate": nrm(ks[24], (DEPTH, D_MODEL, D_FF), D_MODEL ** -0.5),
        "ffn_conv_w": nrm(ks[25], (DEPTH, CONV_WIDTH, D_FF), CONV_WIDTH ** -0.5),
        "ffn_conv_b": nrm(ks[26], (DEPTH, D_FF), 0.01),
        "ffn_w_down": nrm(ks[27], (DEPTH, D_FF, D_MODEL), D_FF ** -0.5),
    }


def reference(x_prompt, x_sample, state_ssm_re, state_ssm_im, cache_fox_k, cache_fox_v,
              cache_fox_logf, state_ffn_conv, norm_mix, norm_ffn, norm_final,
              ssm_a_re, ssm_a_im, ssm_log_step, ssm_b_re, ssm_b_im, ssm_c_re, ssm_c_im,
              ssm_d, ssm_w_glu, fox_w_qkvf, fox_b_f, fox_w_o,
              ffn_w_up, ffn_w_gate, ffn_conv_w, ffn_conv_b, ffn_w_down):
    xp, xs = x_prompt, x_sample
    n_p = xp.shape[0]
    ssm_re_p, ssm_im_p, ssm_re_s, ssm_im_s = [], [], [], []
    k_p, v_p, lf_p, k_s, v_s, lf_s = [], [], [], [], [], []
    conv_p, conv_s = [], []
    for i in range(DEPTH):
        j = i // N_MIXERS
        up = rms_norm(xp, norm_mix[i])
        us = rms_norm(xs, norm_mix[i])
        if i % N_MIXERS == 0:
            ssm_w = (ssm_a_re[j], ssm_a_im[j], ssm_log_step[j], ssm_b_re[j], ssm_b_im[j],
                     ssm_c_re[j], ssm_c_im[j], ssm_d[j], ssm_w_glu[j])
            zero_state = jnp.zeros((n_p, SSM_GROUPS, SSM_STATE), jnp.float32)
            mp, hr_p, hi_p = s5_mixer(up, zero_state, zero_state, *ssm_w)
            ms, hr_s, hi_s = s5_mixer(us, state_ssm_re[j], state_ssm_im[j], *ssm_w)
            ssm_re_p.append(hr_p)
            ssm_im_p.append(hi_p)
            ssm_re_s.append(hr_s)
            ssm_im_s.append(hi_s)
        else:
            mp, kp, vp, lp = fox_prompt(up, fox_w_qkvf[j], fox_b_f[j], fox_w_o[j])
            ms, kn, vn, ln = fox_sample(us, cache_fox_k[j], cache_fox_v[j], cache_fox_logf[j],
                                        fox_w_qkvf[j], fox_b_f[j], fox_w_o[j])
            k_p.append(kp)
            v_p.append(vp)
            lf_p.append(lp)
            k_s.append(kn)
            v_s.append(vn)
            lf_s.append(ln)
        xp = xp + mp
        xs = xs + ms
        hp = rms_norm(xp, norm_ffn[i])
        hs = rms_norm(xs, norm_ffn[i])
        ffn_w = (ffn_w_up[i], ffn_w_gate[i], ffn_conv_w[i], ffn_conv_b[i], ffn_w_down[i])
        fp, cp = conv_ffn(hp, jnp.zeros((n_p, CONV_WIDTH - 1, D_FF), hp.dtype), *ffn_w)
        fs, cs = conv_ffn(hs, state_ffn_conv[i], *ffn_w)
        conv_p.append(cp)
        conv_s.append(cs)
        xp = xp + fp
        xs = xs + fs
    y_prompt = rms_norm(xp, norm_final)
    y_sample = rms_norm(xs, norm_final)
    new_ssm_re_p = jnp.stack(ssm_re_p)
    new_ssm_im_p = jnp.stack(ssm_im_p)
    new_fox_k_p = jnp.stack(k_p)
    new_fox_v_p = jnp.stack(v_p)
    new_fox_logf_p = jnp.stack(lf_p)
    new_ffn_conv_p = jnp.stack(conv_p)
    new_ssm_re_s = jnp.stack(ssm_re_s)
    new_ssm_im_s = jnp.stack(ssm_im_s)
    new_fox_k_s = jnp.stack(k_s)
    new_fox_v_s = jnp.stack(v_s)
    new_fox_logf_s = jnp.stack(lf_s)
    new_ffn_conv_s = jnp.stack(conv_s)
    return (y_prompt, y_sample,
            new_ssm_re_p, new_ssm_im_p, new_fox_k_p, new_fox_v_p, new_fox_logf_p, new_ffn_conv_p,
            new_ssm_re_s, new_ssm_im_s, new_fox_k_s, new_fox_v_s, new_fox_logf_s, new_ffn_conv_s)
```

```cpp
#include <hip/hip_runtime.h>
#include <hip/hip_cooperative_groups.h>
#include <hip/hip_bf16.h>
#include <cstdint>
#include <cstdio>
namespace cg = cooperative_groups;

#define LAS __attribute__((address_space(3)))
typedef unsigned short bf16_t;
typedef short bf16x8 __attribute__((ext_vector_type(8)));
typedef short s16x4 __attribute__((ext_vector_type(4)));
typedef float f32x2 __attribute__((ext_vector_type(2)));
typedef float f32x4 __attribute__((ext_vector_type(4)));
typedef float f32x16 __attribute__((ext_vector_type(16)));
typedef unsigned u32x4 __attribute__((ext_vector_type(4)));
typedef unsigned u32x2 __attribute__((ext_vector_type(2)));

constexpr int DM = 1024, NB = 4, SEQ = 8192, SB = 16, SS = 64, PAST = 4096, KALL = PAST + SS;
constexpr int MP = NB * SEQ, MS = SB * SS, MT = MP + MS;
constexpr int FF = 2816, NH = 16, HD = 64, NG = 64, NP = 64;
constexpr int NQKV = 3328;
constexpr float EPS = 1e-6f;
constexpr float C2 = 0.125f * 1.4426950408889634f;
constexpr float LOG2E = 1.4426950408889634f;
constexpr int NCH = SEQ / 64;
constexpr int NITEM = NB * NCH + SB;

constexpr size_t O_Y = 0;
constexpr size_t O_SRE_P = (size_t)MT * DM;
constexpr size_t O_SIM_P = O_SRE_P + NB * NG * NP;
constexpr size_t O_K_P = O_SIM_P + NB * NG * NP;
constexpr size_t O_V_P = O_K_P + (size_t)MP * DM;
constexpr size_t O_LF_P = O_V_P + (size_t)MP * DM;
constexpr size_t O_CV_P = O_LF_P + (size_t)MP * NH;
constexpr size_t O_SRE_S = O_CV_P + 2 * NB * 2 * FF;
constexpr size_t O_SIM_S = O_SRE_S + SB * NG * NP;
constexpr size_t O_K_S = O_SIM_S + SB * NG * NP;
constexpr size_t O_V_S = O_K_S + (size_t)MS * DM;
constexpr size_t O_LF_S = O_V_S + (size_t)MS * DM;
constexpr size_t O_CV_S = O_LF_S + (size_t)MS * NH;

constexpr size_t MiB = 1u << 20;
constexpr size_t WS_ABAR = 0, WS_A16 = 32768, WS_A64 = 65536, WS_BBT = 131072, WS_CMT = 393216;
constexpr size_t WS_SS = 1 * MiB, WS_IR0 = 2 * MiB, WS_CKP = 3 * MiB, WS_CKS = 5 * MiB;
constexpr size_t WS_WGLU = 10 * MiB, WS_WUG = 14 * MiB, WS_WDN = 36 * MiB, WS_WQKV = 47 * MiB, WS_WO = 54 * MiB;
constexpr size_t WS_X = 64 * MiB, WS_XB = 197 * MiB;
constexpr size_t WS_BIG = 264 * MiB;
constexpr size_t WS_G = WS_BIG, WS_E1 = 346 * MiB;
constexpr size_t WS_H = WS_BIG;
constexpr size_t WS_Q = WS_BIG, WS_KP = 330 * MiB, WS_VP = 394 * MiB, WS_KS = 458 * MiB, WS_VS = 588 * MiB;

__device__ __forceinline__ unsigned cvt_pk_bf16(float lo, float hi) { unsigned r; asm volatile("v_cvt_pk_bf16_f32 %0, %1, %2" : "=v"(r) : "v"(lo), "v"(hi)); return r; }
__device__ __forceinline__ unsigned cvtpk_s(float lo, float hi) { typedef __bf16 bf16x2_t __attribute__((ext_vector_type(2))); f32x2 v = {lo, hi}; bf16x2_t b = __builtin_convertvector(v, bf16x2_t); return __builtin_bit_cast(unsigned, b); }
__device__ __forceinline__ float gelu_tanh(float v) {
    const float t = v * (0.7978845608f + 0.0356774081f * v * v);
    const float e = __builtin_amdgcn_exp2f(-2.8853900818f * t);
    return v * __builtin_amdgcn_rcpf(1.0f + e);
}
__device__ __forceinline__ float sigmoidf_(float v) { const float e = __builtin_amdgcn_exp2f(-LOG2E * v); return __builtin_amdgcn_rcpf(1.0f + e); }
__device__ __forceinline__ float wave_sum(float v) {
#pragma unroll
    for (int o = 1; o < 64; o <<= 1) v += __shfl_xor(v, o);
    return v;
}
template <int CTRL> __device__ __forceinline__ float dppf(float v) { return __int_as_float(__builtin_amdgcn_update_dpp(0, __float_as_int(v), CTRL, 0xf, 0xf, false)); }
#define LDS_WAIT() asm volatile("s_waitcnt lgkmcnt(0)" ::: "memory")

namespace pg8 {
constexpr int BM = 256, BK = 64, HALF = 128, HTB = HALF * BK * 2, STAGE_BYTES = 8 * HTB, NXCD = 8, WGM = 8;
__host__ __device__ __forceinline__ int lds_byte(int r, int c) { const int st = (r >> 4) * 2 + (c >> 5), rr = r & 15, cc = c & 31, ob = rr * 64 + cc * 2; return st * 1024 + (ob ^ (((ob >> 9) & 1) << 5)); }
__host__ __device__ __forceinline__ void stage_rc(int b, int& R, int& C) { const int st = b / 1024, sb = b % 1024, swz = sb ^ (((sb >> 9) & 1) << 5); R = (st >> 1) * 16 + swz / 64; C = (st & 1) * 32 + (swz % 64) / 2; }
__host__ __device__ __forceinline__ int perm32(int rho) { const int n = rho >> 4, i = rho & 15; return 8 * (i >> 2) + 4 * n + (i & 3); }
struct Unit { int pm, pn; };
struct Gemm { const bf16_t* A; const bf16_t* Bt; int K; };
template <bool FFNROWS> struct Order {
    int nM, nN, nwg, G, c;
    __device__ void init(int nM_, int nN_, int G_, int c_) { nM = nM_; nN = nN_; nwg = nM * nN; G = G_; c = c_; }
    __device__ bool next(int i, Unit& u) const {
        const long L = (long)i * G + c; if (L >= nwg) return false;
        int wgid = (int)L; { const int q = nwg / NXCD, r = nwg % NXCD, xcd = wgid % NXCD, off = wgid / NXCD; wgid = (xcd < r ? xcd * (q + 1) : r * (q + 1) + (xcd - r) * q) + off; }
        const int nig = WGM * nN, gid = wgid / nig, fm = gid * WGM, gsz = (nM - fm) < WGM ? (nM - fm) : WGM;
        u.pm = fm + ((wgid % nig) % gsz); u.pn = (wgid % nig) / gsz; return true;
    }
    __device__ __forceinline__ long arow(int pm) const {
        if (!FFNROWS) return (long)pm * BM;
        if (pm < 132) { const int n = pm / 33, R = pm % 33; return (long)n * SEQ + 254 * R - 2; }
        return (long)MP + 256 * (pm - 132);
    }
};

template <class Epi, class Sched>
__device__ __forceinline__ void gemm_phase(LAS unsigned char* lds, const Gemm g, const Sched& S, const Epi& E) {
    int tid_ = threadIdx.x; asm volatile("" : "+v"(tid_));
    const int tid = tid_, wid = __builtin_amdgcn_readfirstlane(tid >> 6), lane = tid & 63, wr = wid >> 2, wc = wid & 3, fr = lane & 15, fq = lane >> 4;
    const int K = g.K, nt = K / BK;
    unsigned voffA[2], voffB[2];
#pragma unroll
    for (int i = 0; i < 2; ++i) { int R, C; stage_rc(tid * 16 + i * 8192, R, C); const int Rb = ((R & ~31) + perm32(R & 31));
        voffA[i] = (unsigned)(R * K + C) * 2u; voffB[i] = (unsigned)(Rb * K + C) * 2u; }
    const size_t kstep = (size_t)(BK * 2);
    const size_t hstep = (size_t)HALF * K * 2;
    const size_t tstep = 2 * hstep;
    const size_t rowb = (size_t)K * 2;
    const unsigned ldsw = (unsigned)wid * 1024u;
    const int aoff = lds_byte(wr * 64 + fr, fq * 8), boff = lds_byte(wc * 32 + fr, fq * 8);
#define PG8_SA(b, h) (((b) * 2 + (h)) * HTB)
#define PG8_SB(b, h) ((4 + (b) * 2 + (h)) * HTB)
#define PG8_STAGE(bufoff, gbase, voff) do { _Pragma("unroll") for (int _i = 0; _i < 2; ++_i) \
        __builtin_amdgcn_global_load_lds((const unsigned*)((const char*)(gbase) + (voff)[_i]), (LAS unsigned*)(lds + (bufoff) + ldsw + _i * 8192), 16, 0, 0); } while (0)
#define PG8_LDA(dst, b, h) do { _Pragma("unroll") for (int m = 0; m < 4; ++m) _Pragma("unroll") for (int k = 0; k < 2; ++k) dst[m][k] = *(const LAS bf16x8*)(lds + PG8_SA(b, h) + aoff + m * 2048 + k * 1024); } while (0)
#define PG8_LDB(dst, b, h) do { _Pragma("unroll") for (int n = 0; n < 2; ++n) _Pragma("unroll") for (int k = 0; k < 2; ++k) dst[n][k] = *(const LAS bf16x8*)(lds + PG8_SB(b, h) + boff + n * 2048 + k * 1024); } while (0)
#define PG8_MMA(ai, bj, At, Bt) do { __builtin_amdgcn_s_setprio(1); _Pragma("unroll") for (int m = 0; m < 4; ++m) _Pragma("unroll") for (int n = 0; n < 2; ++n) _Pragma("unroll") for (int k = 0; k < 2; ++k) \
        acc[ai][bj][m][n] = __builtin_amdgcn_mfma_f32_16x16x32_bf16(Bt[n][k], At[m][k], acc[ai][bj][m][n], 0, 0, 0); __builtin_amdgcn_s_setprio(0); } while (0)
#define PG8_WAIT_V(n) asm volatile("s_waitcnt vmcnt(" #n ")" ::: "memory")
#define PG8_WAIT_L(n) asm volatile("s_waitcnt lgkmcnt(" #n ")" ::: "memory")
#define PG8_BAR __builtin_amdgcn_s_barrier()
#define PG8_SCHED __builtin_amdgcn_sched_barrier(0)
    Unit cur, nxt; int ui = 0;
    if (!S.next(0, cur)) return;
    f32x4 acc[2][2][4][2];
#pragma unroll
    for (int a = 0; a < 2; ++a)
#pragma unroll
        for (int b = 0; b < 2; ++b)
#pragma unroll
            for (int m = 0; m < 4; ++m)
#pragma unroll
                for (int n = 0; n < 2; ++n) acc[a][b][m][n] = (f32x4){0.f, 0.f, 0.f, 0.f};
    bf16x8 At[4][2], B0[2][2], B1[2][2];
    const char* cA = (const char*)g.A + S.arow(cur.pm) * (long)rowb; const char* cB = (const char*)g.Bt + (size_t)cur.pn * tstep;
    PG8_STAGE(PG8_SB(0, 0), cB, voffB); PG8_STAGE(PG8_SB(0, 1), cB + hstep, voffB); PG8_STAGE(PG8_SA(0, 0), cA, voffA); PG8_STAGE(PG8_SA(0, 1), cA + hstep, voffA);
    if (wr == 1) PG8_BAR;
    PG8_WAIT_V(2); PG8_BAR;
    PG8_STAGE(PG8_SB(1, 0), cB + kstep, voffB); PG8_STAGE(PG8_SA(1, 0), cA + kstep, voffA); PG8_STAGE(PG8_SB(1, 1), cB + hstep + kstep, voffB);
    PG8_WAIT_V(6); PG8_BAR;
    for (;;) {
        const bool has_next = S.next(ui + 1, nxt);
        const char* nA = has_next ? (const char*)g.A + S.arow(nxt.pm) * (long)rowb : cA; const char* nB = has_next ? (const char*)g.Bt + (size_t)nxt.pn * tstep : cB;
        for (int t = 0; t < nt; t += 2) {
            const bool last = (t == nt - 2);
            const char* a1 = cA + (size_t)(t + 1) * kstep;
            const char* a2 = last ? nA : cA + (size_t)(t + 2) * kstep; const char* b2 = last ? nB : cB + (size_t)(t + 2) * kstep;
            const char* a3 = a2 + kstep; const char* b3 = b2 + kstep;
            PG8_LDB(B0, 0, 0); PG8_LDB(B1, 0, 1); PG8_SCHED; PG8_LDA(At, 0, 0); PG8_STAGE(PG8_SA(1, 1), a1 + hstep, voffA);
            PG8_WAIT_V(8); PG8_WAIT_L(0); PG8_BAR; PG8_MMA(0, 0, At, B0); PG8_MMA(0, 1, At, B1); PG8_BAR; PG8_SCHED;
            PG8_LDA(At, 0, 1); PG8_STAGE(PG8_SB(0, 0), b2, voffB); PG8_STAGE(PG8_SB(0, 1), b2 + hstep, voffB); PG8_STAGE(PG8_SA(0, 0), a2, voffA);
            PG8_WAIT_V(8); PG8_WAIT_L(0); PG8_BAR; PG8_MMA(1, 0, At, B0); PG8_MMA(1, 1, At, B1); PG8_BAR; PG8_SCHED;
            PG8_LDB(B0, 1, 0); PG8_LDB(B1, 1, 1); PG8_SCHED; PG8_LDA(At, 1, 0); PG8_STAGE(PG8_SA(0, 1), a2 + hstep, voffA);
            PG8_WAIT_V(8); PG8_WAIT_L(0); PG8_BAR; PG8_MMA(0, 0, At, B0); PG8_MMA(0, 1, At, B1); PG8_BAR; PG8_SCHED;
            PG8_LDA(At, 1, 1); PG8_STAGE(PG8_SB(1, 0), b3, voffB); PG8_STAGE(PG8_SB(1, 1), b3 + hstep, voffB); PG8_STAGE(PG8_SA(1, 0), a3, voffA);
            PG8_WAIT_V(8); PG8_WAIT_L(0); PG8_BAR; PG8_MMA(1, 0, At, B0); PG8_MMA(1, 1, At, B1); PG8_BAR; PG8_SCHED;
        }
        if (wr == 0) PG8_BAR;
        { int fr_ = fr, fq_ = fq; asm volatile("" : "+v"(fr_), "+v"(fq_)); E(acc, cur, wr, wc, fr_, fq_); }
        if (!has_next) break;
#pragma unroll
        for (int a = 0; a < 2; ++a)
#pragma unroll
            for (int b = 0; b < 2; ++b)
#pragma unroll
                for (int m = 0; m < 4; ++m)
#pragma unroll
                    for (int n = 0; n < 2; ++n) acc[a][b][m][n] = (f32x4){0.f, 0.f, 0.f, 0.f};
        cur = nxt; cA = nA; cB = nB; ++ui;
        if (wr == 1) PG8_BAR;
    }
    PG8_WAIT_V(0);
    PG8_BAR;
#undef PG8_SA
#undef PG8_SB
#undef PG8_STAGE
#undef PG8_LDA
#undef PG8_LDB
#undef PG8_MMA
#undef PG8_WAIT_V
#undef PG8_WAIT_L
#undef PG8_BAR
#undef PG8_SCHED
}
}


template <int MODE  , bool WRITE_XB> struct EpiRes {
    const float* r0; const float* r1;
    float* X; bf16_t* xb; float* sumsq;
    __device__ __forceinline__ void operator()(f32x4 (&acc)[2][2][4][2], const pg8::Unit& u, int wr, int wc, int fr, int fq) const {
#pragma unroll
        for (int ai = 0; ai < 2; ++ai)
#pragma unroll
            for (int m = 0; m < 4; ++m) {
                const int row = u.pm * 256 + ai * 128 + wr * 64 + m * 16 + fr;
                const float* rp = row < MP ? r0 + (size_t)row * DM : r1 + (size_t)(row - MP) * DM;
                float ss = 0.f;
#pragma unroll
                for (int bj = 0; bj < (MODE == 1 ? 1 : 2); ++bj) {
                    const int col = (MODE == 1 ? u.pn * 128 : u.pn * 256 + bj * 128) + wc * 32 + fq * 8;
                    f32x4 v0, v1;
                    if (MODE == 1) {
                        const f32x4 a0 = acc[ai][0][m][0], a1 = acc[ai][0][m][1], g0 = acc[ai][1][m][0], g1 = acc[ai][1][m][1];
#pragma unroll
                        for (int j = 0; j < 4; ++j) { v0[j] = a0[j] * sigmoidf_(g0[j]); v1[j] = a1[j] * sigmoidf_(g1[j]); }
                    } else { v0 = acc[ai][bj][m][0]; v1 = acc[ai][bj][m][1]; }
                    const f32x4 b0 = *(const f32x4*)(rp + col), b1 = *(const f32x4*)(rp + col + 4);
                    v0 += b0; v1 += b1;
                    *(f32x4*)(X + (size_t)row * DM + col) = v0; *(f32x4*)(X + (size_t)row * DM + col + 4) = v1;
                    if (WRITE_XB) { u32x4 w; w.x = cvt_pk_bf16(v0[0], v0[1]); w.y = cvt_pk_bf16(v0[2], v0[3]); w.z = cvt_pk_bf16(v1[0], v1[1]); w.w = cvt_pk_bf16(v1[2], v1[3]);
                        *(u32x4*)(xb + (size_t)row * DM + col) = w; }
                    ss += (v0[0] * v0[0] + v0[1] * v0[1]) + (v0[2] * v0[2] + v0[3] * v0[3]) + (v1[0] * v1[0] + v1[1] * v1[1]) + (v1[2] * v1[2] + v1[3] * v1[3]);
                }
                ss += __shfl_xor(ss, 16); ss += __shfl_xor(ss, 32);
                if (fq == 0) atomicAdd(sumsq + row, ss);
            }
    }
};

struct EpiConv {
    bf16_t* H; const float* sumsq; const float* convw; const float* convb; const float* hist; float* outc_p; float* outc_s; LAS float* xch;
    __device__ __forceinline__ void operator()(f32x4 (&acc)[2][2][4][2], const pg8::Unit& u, int wr, int wc, int fr, int fq) const {
        const bool samp = u.pm >= 132;
        int n = 0, tok0 = 0; long grow0;
        if (!samp) { n = u.pm / 33; const int R = u.pm % 33; tok0 = 254 * R - 2; grow0 = (long)n * SEQ + tok0; } else { grow0 = (long)MP + 256 * (u.pm - 132); }
        const int f0 = 128 * u.pn + 32 * wc + 8 * fq;
#pragma unroll
        for (int ai = 0; ai < 2; ++ai)
#pragma unroll
            for (int m = 0; m < 4; ++m) {
                const int i = ai * 128 + wr * 64 + m * 16 + fr; long gr = grow0 + i; if (gr < 0) gr = 0;
                float rs = __builtin_amdgcn_rsqf(sumsq[gr] * (1.0f / DM) + EPS);
                float ra = rs; if (!samp && tok0 + i < 0) ra = 0.f;
#pragma unroll
                for (int nn = 0; nn < 2; ++nn) { acc[ai][0][m][nn] *= ra; acc[ai][1][m][nn] *= rs; }
            }
        if (fr >= 14) {
#pragma unroll
            for (int ai = 0; ai < 2; ++ai) { LAS float* p = xch + ((ai * 2 + wr) * 2 + (fr - 14)) * 128 + 32 * wc + 8 * fq;
                *(LAS f32x4*)p = acc[ai][0][3][0]; *(LAS f32x4*)(p + 4) = acc[ai][0][3][1]; }
        }
        asm volatile("s_waitcnt lgkmcnt(0)\n\ts_barrier" ::: "memory");
#pragma unroll
        for (int nn = 0; nn < 2; ++nn) {
            asm volatile("" ::: "memory");
            const int fc = f0 + 4 * nn;
            const f32x4 w0 = *(const f32x4*)(convw + fc), w1 = *(const f32x4*)(convw + FF + fc), w2 = *(const f32x4*)(convw + 2 * FF + fc), cb = *(const f32x4*)(convb + fc);
#pragma unroll
            for (int ai = 0; ai < 2; ++ai) {
                const int blk = ai * 2 + wr;
                f32x4 prev = (f32x4){0.f, 0.f, 0.f, 0.f};
                if (fr >= 14) {
                    if (samp) { prev = *(const f32x4*)(hist + ((size_t)((4 * (u.pm - 132) + blk) * 2 + (fr - 14))) * FF + fc); }
                    else if (blk > 0) { prev = *(const LAS f32x4*)(xch + (((blk - 1) * 2) + (fr - 14)) * 128 + 32 * wc + 8 * fq + 4 * nn); }
                }
#pragma unroll
                for (int m = 0; m < 4; ++m) {
                    const int i = ai * 128 + wr * 64 + m * 16 + fr; const long gr = grow0 + i;
                    const f32x4 a = acc[ai][0][m][nn], gt = acc[ai][1][m][nn]; f32x4 hv;
#pragma unroll
                    for (int j = 0; j < 4; ++j) {
                        const float c1 = dppf<0x121>(a[j]), p1 = dppf<0x121>(prev[j]);
                        const float c2 = dppf<0x122>(a[j]), p2 = dppf<0x122>(prev[j]);
                        const float a1 = fr >= 1 ? c1 : p1, a2 = fr >= 2 ? c2 : p2;
                        const float cv = w0[j] * a2 + w1[j] * a1 + w2[j] * a[j] + cb[j];
                        hv[j] = gelu_tanh(cv) * gt[j];
                    }
                    u32x2 wv; wv.x = cvt_pk_bf16(hv[0], hv[1]); wv.y = cvt_pk_bf16(hv[2], hv[3]);
                    const int tok = tok0 + i;
                    const bool valid = samp || (i >= 2 && tok < SEQ);
                    if (valid) *(u32x2*)(H + (size_t)gr * FF + fc) = wv;
                    if (!samp) { if (valid && tok >= SEQ - 2) { float* o = outc_p + ((size_t)(n * 2 + (tok - (SEQ - 2)))) * FF + fc; *(f32x4*)o = a; } }
                    else { if ((i & 63) >= 62) { float* o = outc_s + ((size_t)((4 * (u.pm - 132) + (i >> 6)) * 2 + ((i & 63) - 62))) * FF + fc; *(f32x4*)o = a; } }
                    prev = a;
                }
            }
        }
    }
};

struct EpiQKV {
    const float* sumsq; const float* bf; bf16_t* Q; bf16_t* Kp; bf16_t* Vp; bf16_t* Ks; bf16_t* Vs; float* out;
    __device__ __forceinline__ void operator()(f32x4 (&acc)[2][2][4][2], const pg8::Unit& u, int wr, int wc, int fr, int fq) const {
        const int sec = u.pn >> 2;
#pragma unroll
        for (int ai = 0; ai < 2; ++ai)
#pragma unroll
            for (int m = 0; m < 4; ++m) {
                const int row = u.pm * 256 + ai * 128 + wr * 64 + m * 16 + fr;
                const float rs = __builtin_amdgcn_rsqf(sumsq[row] * (1.0f / DM) + EPS);
                if (sec == 3) {
                    if (wc == 0 && fq < 2) {
                        const f32x4 v0 = acc[ai][0][m][0] * rs, v1 = acc[ai][0][m][1] * rs; f32x4 l0, l1;
#pragma unroll
                        for (int j = 0; j < 4; ++j) { const float x0 = v0[j] + bf[8 * fq + j], x1 = v1[j] + bf[8 * fq + 4 + j];
                            l0[j] = fminf(x0, 0.f) - log1pf(__expf(-fabsf(x0))); l1[j] = fminf(x1, 0.f) - log1pf(__expf(-fabsf(x1))); }
                        float* o = row < MP ? out + O_LF_P + (size_t)row * NH + 8 * fq : out + O_LF_S + (size_t)(row - MP) * NH + 8 * fq;
                        *(f32x4*)o = l0; *(f32x4*)(o + 4) = l1;
                    }
                } else {
#pragma unroll
                    for (int bj = 0; bj < 2; ++bj) {
                        const int col = (u.pn & 3) * 256 + bj * 128 + wc * 32 + fq * 8;
                        const float sc = sec == 0 ? rs * C2 : rs;
                        const f32x4 v0 = acc[ai][bj][m][0] * sc, v1 = acc[ai][bj][m][1] * sc;
                        u32x4 w; w.x = cvt_pk_bf16(v0[0], v0[1]); w.y = cvt_pk_bf16(v0[2], v0[3]); w.z = cvt_pk_bf16(v1[0], v1[1]); w.w = cvt_pk_bf16(v1[2], v1[3]);
                        if (sec == 0) { *(u32x4*)(Q + (size_t)row * DM + col) = w; }
                        else {
                            bf16_t* dst; float* o;
                            if (row < MP) { dst = (sec == 1 ? Kp : Vp) + (size_t)row * DM + col; o = out + (sec == 1 ? O_K_P : O_V_P) + (size_t)row * DM + col; }
                            else { const int rs_ = row - MP, b = rs_ >> 6, t = rs_ & 63; dst = (sec == 1 ? Ks : Vs) + ((size_t)b * KALL + PAST + t) * DM + col; o = out + (sec == 1 ? O_K_S : O_V_S) + (size_t)rs_ * DM + col; }
                            *(u32x4*)dst = w; *(f32x4*)o = v0; *(f32x4*)(o + 4) = v1;
                        }
                    }
                }
            }
    }
};

namespace att {
constexpr int OFF_K = 0, OFF_V = 16384, OFF_CK = 32768, OFF_WSF = 33280, OFF_OST = 35328;
__device__ __forceinline__ int crow(int r, int hi) { return (r & 3) + 8 * (r >> 2) + 4 * hi; }
__device__ __forceinline__ void glds16(const void* gsrc, unsigned lds_dst) { unsigned keep;
    asm volatile("s_mov_b32 %0, m0\n\ts_mov_b32 m0, %2\n\ts_nop 0\n\tglobal_load_lds_dwordx4 %1, off\n\ts_mov_b32 m0, %0" : "=&s"(keep) : "v"(gsrc), "s"(lds_dst) : "memory"); }
__device__ __forceinline__ void glds4(const void* gsrc, unsigned lds_dst) { unsigned keep;
    asm volatile("s_mov_b32 %0, m0\n\ts_mov_b32 m0, %2\n\ts_nop 0\n\tglobal_load_lds_dword %1, off\n\ts_mov_b32 m0, %0" : "=&s"(keep) : "v"(gsrc), "s"(lds_dst) : "memory"); }
__device__ __forceinline__ float max3f(float a, float b, float c) { return __builtin_fmaxf(__builtin_fmaxf(a, b), c); }
#define SBAR() __builtin_amdgcn_sched_barrier(0)
__device__ __forceinline__ void qkt(f32x16& p0, f32x16& p1, const char* Kslot, const bf16x8* qr, const f32x16& negm, int r32, int hi) {
    const char* kb = Kslot + hi * 1024 + r32 * 16;
#pragma unroll
    for (int d0 = 0; d0 < 4; ++d0) {
        const bf16x8 b0 = *reinterpret_cast<const bf16x8*>(kb + d0 * 2048);
        const bf16x8 b1 = *reinterpret_cast<const bf16x8*>(kb + d0 * 2048 + 512);
        if (d0 == 0) { p0 = __builtin_amdgcn_mfma_f32_32x32x16_bf16(b0, qr[0], negm, 0, 0, 0); p1 = __builtin_amdgcn_mfma_f32_32x32x16_bf16(b1, qr[0], negm, 0, 0, 0); }
        else { p0 = __builtin_amdgcn_mfma_f32_32x32x16_bf16(b0, qr[d0], p0, 0, 0, 0); p1 = __builtin_amdgcn_mfma_f32_32x32x16_bf16(b1, qr[d0], p1, 0, 0, 0); } }
}
__device__ __forceinline__ void pv(f32x16* o, int vb, bf16x8 pa0, bf16x8 pa1, bf16x8 pa2, bf16x8 pa3) {
#pragma unroll
    for (int d0 = 0; d0 < 2; ++d0) { s16x4 lo[4], hi[4];
#pragma unroll
        for (int ks = 0; ks < 4; ++ks) {
            asm volatile("ds_read_b64_tr_b16 %0,%1 offset:%c2" : "=&v"(lo[ks]) : "v"(vb), "i"(d0 * 4096 + ks * 1024) : "memory");
            asm volatile("ds_read_b64_tr_b16 %0,%1 offset:%c2" : "=&v"(hi[ks]) : "v"(vb), "i"(d0 * 4096 + ks * 1024 + 512) : "memory"); }
        asm volatile("s_waitcnt lgkmcnt(0)" ::: "memory"); SBAR();
#define PK(k) (bf16x8){lo[k][0], lo[k][1], lo[k][2], lo[k][3], hi[k][0], hi[k][1], hi[k][2], hi[k][3]}
        o[d0] = __builtin_amdgcn_mfma_f32_32x32x16_bf16(pa0, PK(0), o[d0], 0, 0, 0);
        o[d0] = __builtin_amdgcn_mfma_f32_32x32x16_bf16(pa1, PK(1), o[d0], 0, 0, 0);
        o[d0] = __builtin_amdgcn_mfma_f32_32x32x16_bf16(pa2, PK(2), o[d0], 0, 0, 0);
        o[d0] = __builtin_amdgcn_mfma_f32_32x32x16_bf16(pa3, PK(3), o[d0], 0, 0, 0);
#undef PK
    }
}
__device__ __forceinline__ void attn_unit(char* shm, const bf16_t* Q, const bf16_t* K, const bf16_t* V, bf16_t* O, const float* ck, int NT, int qpos0, int nqw) {
    int tid_ = threadIdx.x; asm volatile("" : "+v"(tid_));
    const int tid = tid_, lane = tid & 63, r32 = lane & 31, hi = lane >> 5; const int wid = __builtin_amdgcn_readfirstlane(tid >> 6);
    const unsigned lds0 = (unsigned)(uintptr_t)shm;
    float* wsf = (float*)(shm + OFF_WSF) + wid * 64;
    const bf16_t* ksrc = K + (long)lane * DM + wid * 8;
    const bf16_t* vsrc = V + (long)(16 * (wid & 3) + (lane >> 2)) * DM + (wid >> 2) * 32 + (lane & 3) * 8;
    const unsigned kdst = lds0 + OFF_K + wid * 1024, vdst = lds0 + OFF_V + wid * 1024, cdst = lds0 + OFF_CK;
#define DMA(t, slot) do { glds16(ksrc + (long)(t) * 64 * DM, (unsigned)__builtin_amdgcn_readfirstlane(kdst + (slot) * 8192)); glds16(vsrc + (long)(t) * 64 * DM, (unsigned)__builtin_amdgcn_readfirstlane(vdst + (slot) * 8192)); \
        if (wid == 0) glds4(ck + (t) * 64 + lane, (unsigned)__builtin_amdgcn_readfirstlane(cdst + (slot) * 256)); } while (0)
    const bool active = wid < nqw; const int qw = active ? wid : 0;
    const int vb0 = (int)(lds0 + OFF_V) + ((lane >> 4) & 1) * 32 + (lane & 3) * 8 + (4 * hi + ((lane & 15) >> 2)) * 64;
    DMA(0, 0);
    const bf16_t* Qw = Q + (long)(qw * 32) * DM;
    bf16x8 qr[4];
#pragma unroll
    for (int d0 = 0; d0 < 4; ++d0) qr[d0] = *reinterpret_cast<const bf16x8*>(&Qw[(long)r32 * DM + d0 * 16 + hi * 8]);
    const int qpos = qpos0 + qw * 32 + r32, qmin = qpos0 + qw * 32, qmax = qmin + 31;
    float mhat = -ck[qpos], l_reg = 0.f;
    f32x16 o[2]; o[0] = f32x16{}; o[1] = f32x16{};
    f32x16 negm;
#pragma unroll
    for (int r = 0; r < 16; ++r) negm[r] = -mhat;
    for (int t = 0; t < NT; ++t) {
        asm volatile("s_waitcnt vmcnt(0) lgkmcnt(0)\n\ts_barrier" ::: "memory");
        if (t + 1 < NT) DMA(t + 1, (t + 1) & 1);
        if (active && 64 * t <= qmax) {
            const int slot = t & 1;
            f32x16 p0, p1;
            qkt(p0, p1, shm + OFF_K + slot * 8192, qr, negm, r32, hi);
            const float* ckp = (const float*)(shm + OFF_CK + slot * 256);
#pragma unroll
            for (int a = 0; a < 4; ++a) { const f32x4 c0 = *(const f32x4*)(ckp + 8 * a + 4 * hi), c1 = *(const f32x4*)(ckp + 32 + 8 * a + 4 * hi);
#pragma unroll
                for (int j = 0; j < 4; ++j) { p0[4 * a + j] -= c0[j]; p1[4 * a + j] -= c1[j]; } }
            if (64 * t + 63 > qmin) {
#pragma unroll
                for (int r = 0; r < 16; ++r) { const int kv = 64 * t + crow(r, hi); if (kv > qpos) p0[r] = -1e30f; if (kv + 32 > qpos) p1[r] = -1e30f; }
            }
            float a = max3f(p0[0], p0[1], p1[0]), b = max3f(p0[2], p0[3], p1[1]); a = max3f(a, p1[2], p1[3]);
#pragma unroll
            for (int r = 4; r < 16; r += 4) { a = max3f(a, p0[r], p0[r + 1]); b = max3f(b, p0[r + 2], p0[r + 3]); a = max3f(a, p1[r], p1[r + 1]); b = max3f(b, p1[r + 2], p1[r + 3]); }
            float rm = __builtin_fmaxf(a, b); rm = __builtin_fmaxf(rm, __shfl_xor(rm, 32));
            if (__any(rm > 8.f)) {
                const float dl = __builtin_fmaxf(rm, 0.f); mhat += dl;
#pragma unroll
                for (int r = 0; r < 16; ++r) { p0[r] -= dl; p1[r] -= dl; }
#pragma unroll
                for (int r = 0; r < 16; ++r) negm[r] = -mhat;
                const float f = __builtin_amdgcn_exp2f(-dl); l_reg *= f; if (hi == 0) wsf[r32] = f;
                LDS_WAIT();
#pragma unroll
                for (int d_ = 0; d_ < 2; ++d_)
#pragma unroll
                    for (int r = 0; r < 16; ++r) o[d_][r] *= wsf[crow(r, hi)];
            }
            float sacc = 0.f;
#pragma unroll
            for (int r = 0; r < 16; ++r) { p0[r] = __builtin_amdgcn_exp2f(p0[r]); p1[r] = __builtin_amdgcn_exp2f(p1[r]); sacc += p0[r] + p1[r]; }
            l_reg += sacc;
            u32x4 pw0, pw1, pw2, pw3;
            pw0 = (u32x4){cvtpk_s(p0[0], p0[1]), cvtpk_s(p0[2], p0[3]), cvtpk_s(p0[4], p0[5]), cvtpk_s(p0[6], p0[7])};
            pw1 = (u32x4){cvtpk_s(p0[8], p0[9]), cvtpk_s(p0[10], p0[11]), cvtpk_s(p0[12], p0[13]), cvtpk_s(p0[14], p0[15])};
            pw2 = (u32x4){cvtpk_s(p1[0], p1[1]), cvtpk_s(p1[2], p1[3]), cvtpk_s(p1[4], p1[5]), cvtpk_s(p1[6], p1[7])};
            pw3 = (u32x4){cvtpk_s(p1[8], p1[9]), cvtpk_s(p1[10], p1[11]), cvtpk_s(p1[12], p1[13]), cvtpk_s(p1[14], p1[15])};
            SBAR();
            pv(o, vb0 + slot * 8192, __builtin_bit_cast(bf16x8, pw0), __builtin_bit_cast(bf16x8, pw1), __builtin_bit_cast(bf16x8, pw2), __builtin_bit_cast(bf16x8, pw3));
        }
    }
    if (active) {
        l_reg += __shfl_xor(l_reg, 32);
        if (hi == 0) wsf[32 + r32] = l_reg;
        LDS_WAIT();
        float rli[16];
#pragma unroll
        for (int r = 0; r < 16; ++r) rli[r] = __builtin_amdgcn_rcpf(wsf[32 + crow(r, hi)]);
        bf16_t* Ow = O + (long)(qw * 32) * DM;
        __hip_bfloat16* stg = (__hip_bfloat16*)(shm + OFF_OST) + wid * 2048;
#pragma unroll
        for (int r = 0; r < 16; ++r) { const int orow = crow(r, hi);
#pragma unroll
            for (int d0 = 0; d0 < 2; ++d0) stg[orow * 64 + d0 * 32 + r32] = __float2bfloat16(o[d0][r] * rli[r]); }
        LDS_WAIT();
#pragma unroll
        for (int i = 0; i < 4; ++i) { const int row = i * 8 + (lane >> 3), ch = lane & 7; const u32x4 v = *(const u32x4*)(stg + row * 64 + ch * 8); *(u32x4*)(Ow + (long)row * DM + ch * 8) = v; }
    }
    asm volatile("s_waitcnt vmcnt(0) lgkmcnt(0)\n\ts_barrier" ::: "memory");
#undef DMA
}
#undef SBAR
}

__device__ __forceinline__ unsigned f2bf(float f) { unsigned u = __builtin_bit_cast(unsigned, f); return (u + 0x7fffu + ((u >> 16) & 1u)) >> 16; }
__device__ __forceinline__ unsigned pk2(float lo, float hi) { return f2bf(lo) | (f2bf(hi) << 16); }
__device__ __forceinline__ void transpose_item(const float* W, int K, int Nsrc, int src_n0, int valid, const float* kscale, bf16_t* WT, int dst_row0, LAS float* scr, int kb, int lane) {
    const int k0 = 64 * kb;
#pragma unroll 8
    for (int i = 0; i < 32; ++i) { const int kk = 2 * i + (lane >> 5), c = lane & 31; float v = (c < valid) ? W[(size_t)(k0 + kk) * Nsrc + src_n0 + c] : 0.f; if (kscale) v *= kscale[k0 + kk]; scr[kk * 33 + c] = v; }
    LDS_WAIT(); asm volatile("" ::: "memory");
    const int c = lane & 7;
#pragma unroll
    for (int j = 0; j < 4; ++j) { const int n = (lane >> 3) + 8 * j; const LAS float* s = scr + (8 * c) * 33 + n;
        u32x4 o; o.x = pk2(s[0 * 33], s[1 * 33]); o.y = pk2(s[2 * 33], s[3 * 33]); o.z = pk2(s[4 * 33], s[5 * 33]); o.w = pk2(s[6 * 33], s[7 * 33]);
        *(u32x4*)(WT + (size_t)(dst_row0 + n) * K + k0 + 8 * c) = o; }
    LDS_WAIT(); asm volatile("" ::: "memory");
}

struct Args { const float* in[28]; float* out; unsigned char* ws; };

__device__ __forceinline__ void s5_tables(const Args& A, int g, int p) {
    const double lre = A.in[11][g * NP + p], lim = A.in[12][g * NP + p], dt = exp((double)A.in[13][g]);
    const double mag = exp(lre * dt); double x = lim * dt;
    const double TWO_PI = 6.283185307179586476925; x -= TWO_PI * rint(x / TWO_PI);
    const double x2 = x * x; double sn = 0.0, cs = 0.0;
#pragma unroll
    for (int k = 14; k >= 0; --k) { sn = sn * x2 * (-1.0 / ((2.0 * k + 2.0) * (2.0 * k + 3.0))) + 1.0; cs = cs * x2 * (-1.0 / ((2.0 * k + 1.0) * (2.0 * k + 2.0))) + 1.0; }
    sn *= x;
    const double ar = mag * cs, ai = mag * sn;
    const double den = lre * lre + lim * lim, nr = ar - 1.0;
    const double zr = (nr * lre + ai * lim) / den, zi = (ai * lre - nr * lim) / den;
    unsigned char* ws = A.ws;
    float* abar = (float*)(ws + WS_ABAR); float* a16 = (float*)(ws + WS_A16); float* a64 = (float*)(ws + WS_A64);
    abar[(g * NP + p) * 2] = (float)ar; abar[(g * NP + p) * 2 + 1] = (float)ai;
    double pr = ar, pi = ai;
#pragma unroll
    for (int s = 0; s < 4; ++s) { const double t = pr * pr - pi * pi; pi = 2.0 * pr * pi; pr = t; }
    a16[(g * NP + p) * 2] = (float)pr; a16[(g * NP + p) * 2 + 1] = (float)pi;
#pragma unroll
    for (int s = 0; s < 2; ++s) { const double t = pr * pr - pi * pi; pi = 2.0 * pr * pi; pr = t; }
    a64[(g * NP + p) * 2] = (float)pr; a64[(g * NP + p) * 2 + 1] = (float)pi;
    bf16_t* bbT = (bf16_t*)(ws + WS_BBT); bf16_t* cmT = (bf16_t*)(ws + WS_CMT);
    const int pb = p >> 5, pp = p & 31;
    const float* bre = A.in[14] + ((size_t)g * NP + p) * 16; const float* bim = A.in[15] + ((size_t)g * NP + p) * 16;
#pragma unroll
    for (int h = 0; h < 16; ++h) {
        const double br = bre[h], bi = bim[h];
        const float vr = (float)(zr * br - zi * bi), vi = (float)(zr * bi + zi * br);
        const int ln = pp + 32 * (h >> 3), i = h & 7;
        bbT[(((size_t)g * 4 + pb) * 64 + ln) * 8 + i] = (bf16_t)f2bf(vr);
        bbT[(((size_t)g * 4 + pb + 2) * 64 + ln) * 8 + i] = (bf16_t)f2bf(vi);
        const float cr = A.in[16][((size_t)g * 16 + h) * NP + p], ci = A.in[17][((size_t)g * 16 + h) * NP + p];
        const int l2 = h + 16 * (pp >> 3), i2 = pp & 7;
        cmT[((((size_t)g * 2 + pb) * 2 + 0) * 64 + l2) * 8 + i2] = (bf16_t)f2bf(cr);
        cmT[((((size_t)g * 2 + pb) * 2 + 1) * 64 + l2) * 8 + i2] = (bf16_t)f2bf(-ci);
    }
}

__device__ __forceinline__ const float* xrow_ptr(const Args& A, int row) { return row < MP ? A.in[0] + (size_t)row * DM : A.in[1] + (size_t)(row - MP) * DM; }

template <int PASS> __device__ __forceinline__ void s5_item(const Args& A, int item, int g, LAS unsigned char* sbuf  , int lane) {
    unsigned char* ws = A.ws;
    const bool samp = item >= NB * NCH; const int n = item / NCH, c = item % NCH, b = item - NB * NCH;
    const int row0 = samp ? MP + 64 * b : n * SEQ + 64 * c;
    const float* ir0 = (const float*)(ws + WS_IR0);
    const float* gm = A.in[8];
    const int n32 = lane & 31, hh = lane >> 5;
    bf16x8 ua[2];
    {
        const int tp = 16 * ((n32 >> 2) & 1) + 4 * (n32 >> 3) + (n32 & 3);
        const f32x4 g0 = *(const f32x4*)(gm + 16 * g + 8 * hh), g1 = *(const f32x4*)(gm + 16 * g + 8 * hh + 4);
#pragma unroll
        for (int tb = 0; tb < 2; ++tb) { const int row = row0 + 32 * tb + tp; const float* xp = xrow_ptr(A, row) + 16 * g + 8 * hh; const float rs = ir0[row];
            const f32x4 x0 = *(const f32x4*)xp * rs * g0, x1 = *(const f32x4*)(xp + 4) * rs * g1;
            u32x4 w; w.x = cvt_pk_bf16(x0[0], x0[1]); w.y = cvt_pk_bf16(x0[2], x0[3]); w.z = cvt_pk_bf16(x1[0], x1[1]); w.w = cvt_pk_bf16(x1[2], x1[3]); ua[tb] = __builtin_bit_cast(bf16x8, w); }
    }
    float hin_r = 0.f, hin_i = 0.f;
    if (PASS == 2) {
        if (samp) { hin_r = A.in[2][((size_t)b * NG + g) * NP + lane]; hin_i = A.in[3][((size_t)b * NG + g) * NP + lane]; }
        else {
            const f32x2 a64 = *(const f32x2*)(ws + WS_A64 + ((size_t)(g * NP + lane)) * 8);
            const float* e1 = (const float*)(ws + WS_E1) + (((size_t)(n * NCH) * NG + g) * NP + lane) * 2;
            for (int cc = 0; cc < c; ++cc) { const f32x2 e = *(const f32x2*)(e1 + (size_t)cc * NG * NP * 2);
                const float tr = a64.x * hin_r - a64.y * hin_i + e.x; hin_i = a64.x * hin_i + a64.y * hin_r + e.y; hin_r = tr; }
        }
    }
    f32x4 yacc[4] = {(f32x4){0, 0, 0, 0}, (f32x4){0, 0, 0, 0}, (f32x4){0, 0, 0, 0}, (f32x4){0, 0, 0, 0}};
    const bf16_t* bbT = (const bf16_t*)(ws + WS_BBT); const bf16_t* cmT = (const bf16_t*)(ws + WS_CMT);
#pragma unroll 1
    for (int pb = 0; pb < 2; ++pb) {
        const int p = 32 * pb + n32;
        const bf16x8 Bre = *(const bf16x8*)(bbT + (((size_t)g * 4 + pb) * 64 + lane) * 8), Bim = *(const bf16x8*)(bbT + (((size_t)g * 4 + pb + 2) * 64 + lane) * 8);
        f32x16 xr[2], xi[2];
        const f32x16 z16 = f32x16{};
#pragma unroll
        for (int tb = 0; tb < 2; ++tb) { xr[tb] = __builtin_amdgcn_mfma_f32_32x32x16_bf16(ua[tb], Bre, z16, 0, 0, 0); xi[tb] = __builtin_amdgcn_mfma_f32_32x32x16_bf16(ua[tb], Bim, z16, 0, 0, 0); }
        const f32x2 ab = *(const f32x2*)(ws + WS_ABAR + ((size_t)(g * NP + p)) * 8), a16 = *(const f32x2*)(ws + WS_A16 + ((size_t)(g * NP + p)) * 8);
        const float ar = ab.x, ai = ab.y;
#pragma unroll
        for (int tb = 0; tb < 2; ++tb)
#pragma unroll
            for (int r = 1; r < 16; ++r) { const float pr = xr[tb][r - 1], pi = xi[tb][r - 1];
                xr[tb][r] += ar * pr - ai * pi; xi[tb][r] += ar * pi + ai * pr; }
        float H_r = __shfl(hin_r, p), H_i = __shfl(hin_i, p);
        float Hs_r[2], Hs_i[2];
#pragma unroll
        for (int tb = 0; tb < 2; ++tb) {
            const float er = xr[tb][15], ei = xi[tb][15];
            const float or_ = __shfl_xor(er, 32), oi_ = __shfl_xor(ei, 32);
            const float e0r = hh ? or_ : er, e0i = hh ? oi_ : ei, e1r = hh ? er : or_, e1i = hh ? ei : oi_;
            const float h0r = H_r, h0i = H_i;
            const float h1r = a16.x * h0r - a16.y * h0i + e0r, h1i = a16.x * h0i + a16.y * h0r + e0i;
            const float h2r = a16.x * h1r - a16.y * h1i + e1r, h2i = a16.x * h1i + a16.y * h1r + e1i;
            Hs_r[tb] = hh ? h1r : h0r; Hs_i[tb] = hh ? h1i : h0i;
            H_r = h2r; H_i = h2i;
        }
        if (PASS == 1) {
            if (hh == 0) { float* e1 = (float*)(ws + WS_E1) + (((size_t)item * NG + g) * NP + p) * 2; *(f32x2*)e1 = (f32x2){H_r, H_i}; }
        } else {
            if (samp || c == NCH - 1) { if (hh == 0) { const size_t o = samp ? ((size_t)b * NG + g) * NP + p : ((size_t)n * NG + g) * NP + p;
                A.out[(samp ? O_SRE_S : O_SRE_P) + o] = H_r; A.out[(samp ? O_SIM_S : O_SIM_P) + o] = H_i; } }
#pragma unroll
            for (int tb = 0; tb < 2; ++tb) { float cr = Hs_r[tb], ci = Hs_i[tb];
#pragma unroll
                for (int r = 0; r < 16; ++r) { const float t = ar * cr - ai * ci; ci = ar * ci + ai * cr; cr = t;
                    const float sr = xr[tb][r] + cr, si = xi[tb][r] + ci;
                    LAS unsigned short* rowp = (LAS unsigned short*)(sbuf + (32 * tb + 16 * hh + r) * 144);
                    rowp[n32] = (unsigned short)f2bf(sr); rowp[32 + n32] = (unsigned short)f2bf(si); } }
            LDS_WAIT(); asm volatile("" ::: "memory");
#pragma unroll
            for (int ks = 0; ks < 2; ++ks) { const bf16x8 Bc = *(const bf16x8*)(cmT + ((((size_t)g * 2 + pb) * 2 + ks) * 64 + lane) * 8);
#pragma unroll
                for (int t4 = 0; t4 < 4; ++t4) { const bf16x8 Af = *(const LAS bf16x8*)(sbuf + (16 * t4 + (lane & 15)) * 144 + ks * 64 + (lane >> 4) * 16);
                    yacc[t4] = __builtin_amdgcn_mfma_f32_16x16x32_bf16(Af, Bc, yacc[t4], 0, 0, 0); } }
            LDS_WAIT(); asm volatile("" ::: "memory");
        }
    }
    if (PASS == 2) {
        const int h = lane & 15, ch = 16 * g + h; const float dsk = A.in[18][ch], gmh = gm[ch];
        bf16_t* G = (bf16_t*)(ws + WS_G);
#pragma unroll
        for (int t4 = 0; t4 < 4; ++t4)
#pragma unroll
            for (int r = 0; r < 4; ++r) { const int row = row0 + 16 * t4 + 4 * (lane >> 4) + r;
                const float u = xrow_ptr(A, row)[ch] * ir0[row] * gmh; const float v = yacc[t4][r] + dsk * u;
                G[(size_t)row * DM + ch] = (bf16_t)f2bf(gelu_tanh(v)); }
    }
}

#ifndef PHM
#define PHM 2047
#endif
constexpr int LDS_BYTES = 147456;
constexpr int XCH_OFF = 131072;

__global__ void __launch_bounds__(512, 2) fwd_mega(Args A) {
    extern __shared__ __attribute__((aligned(16))) unsigned char lds[];
    cg::grid_group grid = cg::this_grid();
    LAS unsigned char* L = (LAS unsigned char*)lds;
    const int tid = threadIdx.x, lane = tid & 63, wave = __builtin_amdgcn_readfirstlane(tid >> 6);
    const int G = gridDim.x, bx = blockIdx.x;
    const int gw = bx * 8 + wave, NGW = G * 8;
    unsigned char* ws = A.ws;
    float* sumsq = (float*)(ws + WS_SS);
    float* X = (float*)(ws + WS_X); bf16_t* XB = (bf16_t*)(ws + WS_XB);

    if (PHM & 1) {
        for (int i = bx * 512 + tid; i < 4 * MT; i += G * 512) sumsq[i] = 0.f;
        LAS float* scr = (LAS float*)(L + wave * 16384);
        constexpr int I_GLU = 16 * 64, I_UG = 16 * 176, I_DN = 44 * 32, I_QKV = 16 * 104, I_WO = 16 * 32;
        constexpr int NW_ITEMS = I_GLU + 2 * I_UG + 2 * I_DN + I_QKV + I_WO;
        for (int it = gw; it < NW_ITEMS; it += NGW) {
            int r = it;
            if (r < I_GLU) { const int kb = r / 64, nb = r % 64, pn = nb >> 3, j = nb & 7; const int src = j < 4 ? 128 * pn + 32 * j : 1024 + 128 * pn + 32 * (j - 4);
                transpose_item(A.in[19], DM, 2048, src, 32, nullptr, (bf16_t*)(ws + WS_WGLU), 32 * nb, scr, kb, lane); continue; } r -= I_GLU;
            if (r < 2 * I_UG) { const int l = r / I_UG; r %= I_UG; const int kb = r / 176, nb = r % 176, pn = nb >> 3, j = nb & 7;
                const float* W = (j < 4 ? A.in[23] : A.in[24]) + (size_t)l * DM * FF; const int src = 128 * pn + 32 * (j & 3);
                transpose_item(W, DM, FF, src, 32, A.in[9] + l * DM, (bf16_t*)(ws + WS_WUG) + (size_t)l * 5632 * DM, 32 * nb, scr, kb, lane); continue; } r -= 2 * I_UG;
            if (r < 2 * I_DN) { const int l = r / I_DN; r %= I_DN; const int kb = r / 32, nb = r % 32;
                transpose_item(A.in[27] + (size_t)l * FF * DM, FF, DM, 32 * nb, 32, nullptr, (bf16_t*)(ws + WS_WDN) + (size_t)l * DM * FF, 32 * nb, scr, kb, lane); continue; } r -= 2 * I_DN;
            if (r < I_QKV) { const int kb = r / 104, nb = r % 104; int valid = 3088 - 32 * nb; valid = valid < 0 ? 0 : (valid > 32 ? 32 : valid);
                transpose_item(A.in[20], DM, 3088, 32 * nb, valid, A.in[8] + DM, (bf16_t*)(ws + WS_WQKV), 32 * nb, scr, kb, lane); continue; } r -= I_QKV;
            { const int kb = r / 32, nb = r % 32; transpose_item(A.in[22], DM, DM, 32 * nb, 32, nullptr, (bf16_t*)(ws + WS_WO), 32 * nb, scr, kb, lane); }
        }
        for (int g = gw; g < NG; g += NGW) s5_tables(A, g, lane);
        float* ir0 = (float*)(ws + WS_IR0);
        for (int m = gw; m < MT; m += NGW) { const f32x4* xr = (const f32x4*)xrow_ptr(A, m) + lane; float s = 0.f;
#pragma unroll
            for (int j = 0; j < 4; ++j) { const f32x4 v = xr[64 * j]; s += (v.x * v.x + v.y * v.y) + (v.z * v.z + v.w * v.w); }
            s = wave_sum(s); if (lane == 0) ir0[m] = __builtin_amdgcn_rsqf(s * (1.0f / DM) + EPS); }
        for (int it = gw; it < 2 * SB * PAST; it += NGW) { const int kv = it >= SB * PAST, rr = it - kv * SB * PAST, b = rr / PAST, t = rr % PAST;
            const f32x4* src = (const f32x4*)(A.in[4 + kv] + (size_t)rr * DM) + lane; u32x2* dst = (u32x2*)((bf16_t*)(ws + (kv ? WS_VS : WS_KS)) + ((size_t)b * KALL + t) * DM) + lane;
#pragma unroll
            for (int j = 0; j < 4; ++j) { const f32x4 v = src[64 * j]; u32x2 w; w.x = cvt_pk_bf16(v.x, v.y); w.y = cvt_pk_bf16(v.z, v.w); dst[64 * j] = w; } }
    }
    grid.sync();

    if (PHM & 2) {
        LAS unsigned char* sbuf = L + wave * 9216;
        for (int it = gw; it < NB * NCH * NG; it += NGW) { const int item = it / NG, g = it % NG; if ((item % NCH) == NCH - 1) continue; s5_item<1>(A, item, g, sbuf, lane); }
    }
    grid.sync();
    if (PHM & 4) {
        LAS unsigned char* sbuf = L + wave * 9216;
        for (int it = gw; it < NITEM * NG; it += NGW) { const int item = it / NG, g = it % NG; s5_item<2>(A, item, g, sbuf, lane); }
    }
    grid.sync();

    if (PHM & 8) {
        pg8::Gemm g{(const bf16_t*)(ws + WS_G), (const bf16_t*)(ws + WS_WGLU), DM}; pg8::Order<false> S; S.init(MT / 256, 8, G, bx);
        EpiRes<1, true> E{A.in[0], A.in[1], X, XB, sumsq};
        pg8::gemm_phase(L, g, S, E);
    }
    grid.sync();

#pragma unroll 1
    for (int layer = 0; layer < 2; ++layer) {
        if (layer == 1) {
            if (PHM & 16) {
                pg8::Gemm g{XB, (const bf16_t*)(ws + WS_WQKV), DM}; pg8::Order<false> S; S.init(MT / 256, 13, G, bx);
                EpiQKV E{sumsq + 1 * MT, A.in[21], (bf16_t*)(ws + WS_Q), (bf16_t*)(ws + WS_KP), (bf16_t*)(ws + WS_VP), (bf16_t*)(ws + WS_KS), (bf16_t*)(ws + WS_VS), A.out};
                pg8::gemm_phase(L, g, S, E);
            }
            grid.sync();
            if (PHM & 32) {
                float* ckp = (float*)(ws + WS_CKP); float* cks = (float*)(ws + WS_CKS);
                for (int it = gw; it < 64 * 8 + 256 * 5; it += NGW) {
                    const bool sm = it >= 512; const int seq = sm ? (it - 512) / 5 : it / 8, ch = sm ? (it - 512) % 5 : it % 8;
                    const int len = sm ? KALL : SEQ; const int bb = seq >> 4, h = seq & 15;
                    auto ld = [&](int j) -> float { if (j >= len) return 0.f; if (!sm) return A.out[O_LF_P + ((size_t)bb * SEQ + j) * NH + h];
                        return j < PAST ? A.in[6][((size_t)bb * PAST + j) * NH + h] : A.out[O_LF_S + ((size_t)bb * SS + (j - PAST)) * NH + h]; };
                    float pre = 0.f;
                    for (int cc = 0; cc < ch; ++cc) {
#pragma unroll
                        for (int j = 0; j < 16; ++j) pre += ld(cc * 1024 + lane * 16 + j);
                    }
                    pre = wave_sum(pre);
                    float v[16]; float tot = 0.f;
#pragma unroll
                    for (int j = 0; j < 16; ++j) { tot += ld(ch * 1024 + lane * 16 + j); v[j] = tot; }
                    float sc = tot;
#pragma unroll
                    for (int o = 1; o < 64; o <<= 1) { const float t = __shfl_up(sc, o); if (lane >= o) sc += t; }
                    const float base = pre + (sc - tot);
                    float* dst = (sm ? cks + (size_t)seq * KALL : ckp + (size_t)seq * SEQ) + ch * 1024 + lane * 16;
#pragma unroll
                    for (int j = 0; j < 16; ++j) if (ch * 1024 + lane * 16 + j < len) dst[j] = (base + v[j]) * LOG2E;
                }
            }
            grid.sync();
            if (PHM & 64) {
                const bf16_t* Q = (const bf16_t*)(ws + WS_Q); bf16_t* O = (bf16_t*)(ws + WS_Q);
                const bf16_t* Kp = (const bf16_t*)(ws + WS_KP); const bf16_t* Vp = (const bf16_t*)(ws + WS_VP);
                const bf16_t* Ks = (const bf16_t*)(ws + WS_KS); const bf16_t* Vs = (const bf16_t*)(ws + WS_VS);
                const float* ckp = (const float*)(ws + WS_CKP); const float* cks = (const float*)(ws + WS_CKS);
                for (int idx = bx; idx < 9 * 256; idx += G) {
                    const int i = idx >> 8, v = idx & 255;
                    if (i < 8) { const int bh = v >> 2, s = v & 3, b = bh >> 4, h = bh & 15; const int qb = (i & 1) ? (8 * (i >> 1) + 7 - s) : (8 * (i >> 1) + s);
                        const size_t r0 = (size_t)b * SEQ;
                        att::attn_unit((char*)lds, Q + (r0 + 256 * qb) * DM + h * HD, Kp + r0 * DM + h * HD, Vp + r0 * DM + h * HD, O + (r0 + 256 * qb) * DM + h * HD, ckp + (size_t)bh * SEQ, 4 * qb + 4, 256 * qb, 8);
                    } else { const int b = v >> 4, h = v & 15;
                        att::attn_unit((char*)lds, Q + ((size_t)MP + 64 * b) * DM + h * HD, Ks + (size_t)b * KALL * DM + h * HD, Vs + (size_t)b * KALL * DM + h * HD, O + ((size_t)MP + 64 * b) * DM + h * HD, cks + (size_t)v * KALL, KALL / 64, PAST, 2);
                    }
                }
            }
            grid.sync();
            if (PHM & 128) {
                pg8::Gemm g{(const bf16_t*)(ws + WS_Q), (const bf16_t*)(ws + WS_WO), DM}; pg8::Order<false> S; S.init(MT / 256, 4, G, bx);
                EpiRes<0, true> E{X, X + (size_t)MP * DM, X, XB, sumsq + 2 * MT};
                pg8::gemm_phase(L, g, S, E);
            }
            grid.sync();
        }
        if (PHM & 256) {
            pg8::Gemm g{XB, (const bf16_t*)(ws + WS_WUG) + (size_t)layer * 5632 * DM, DM}; pg8::Order<true> S; S.init(136, 22, G, bx);
            EpiConv E{(bf16_t*)(ws + WS_H), sumsq + (layer == 0 ? 0 : 2 * MT), A.in[25] + (size_t)layer * 3 * FF, A.in[26] + (size_t)layer * FF, A.in[7] + (size_t)layer * SB * 2 * FF,
                      A.out + O_CV_P + (size_t)layer * NB * 2 * FF, A.out + O_CV_S + (size_t)layer * SB * 2 * FF, (LAS float*)(L + XCH_OFF)};
            pg8::gemm_phase(L, g, S, E);
        }
        grid.sync();
        if (PHM & 512) {
            pg8::Gemm g{(const bf16_t*)(ws + WS_H), (const bf16_t*)(ws + WS_WDN) + (size_t)layer * DM * FF, FF}; pg8::Order<false> S; S.init(MT / 256, 4, G, bx);
            if (layer == 0) { EpiRes<0, true> E{X, X + (size_t)MP * DM, X, XB, sumsq + 1 * MT}; pg8::gemm_phase(L, g, S, E); }
            else { EpiRes<0, false> E{X, X + (size_t)MP * DM, X, XB, sumsq + 3 * MT}; pg8::gemm_phase(L, g, S, E); }
        }
        grid.sync();
    }
    if (PHM & 1024) {
        const float* gf = A.in[10]; const float* ssq = sumsq + 3 * MT;
        for (int m = gw; m < MT; m += NGW) { const float rs = __builtin_amdgcn_rsqf(ssq[m] * (1.0f / DM) + EPS);
            const f32x4* xr = (const f32x4*)(X + (size_t)m * DM) + lane; f32x4* o = (f32x4*)(A.out + O_Y + (size_t)m * DM) + lane; const f32x4* gg = (const f32x4*)gf + lane;
#pragma unroll
            for (int j = 0; j < 4; ++j) o[64 * j] = xr[64 * j] * rs * gg[64 * j]; }
    }
}

extern "C" void kernel_launch(void* const* d_in, const int* in_sizes, int n_in, void* d_out, int out_size, void* d_ws, size_t ws_size, hipStream_t stream) {
    static int grid = 0;
    if (grid == 0) {
        int dev = 0, cus = 0, per_cu = 0;
        hipGetDevice(&dev); hipDeviceGetAttribute(&cus, hipDeviceAttributeMultiprocessorCount, dev);
        hipFuncSetAttribute((const void*)fwd_mega, hipFuncAttributeMaxDynamicSharedMemorySize, LDS_BYTES);
        hipOccupancyMaxActiveBlocksPerMultiprocessor(&per_cu, (const void*)fwd_mega, 512, LDS_BYTES);
        if (per_cu < 1) per_cu = 1;
        grid = cus * 1;
        if (grid <= 0) grid = 256;
    }
    Args a{};
    for (int i = 0; i < 28; ++i) a.in[i] = (const float*)d_in[i];
    a.out = (float*)d_out; a.ws = (unsigned char*)d_ws;
    void* args[] = {&a};
    hipError_t e = hipLaunchCooperativeKernel((const void*)fwd_mega, dim3(grid), dim3(512), args, LDS_BYTES, stream);
    if (e != hipSuccess) fprintf(stderr, "cooperative launch failed: %s (grid %d)\n", hipGetErrorString(e), grid);
}
```

```cpp
#include <hip/hip_runtime.h>
#include <hip/hip_cooperative_groups.h>
#include <hip/hip_bf16.h>
#include <cstdint>
#include <cstdio>
namespace cg = cooperative_groups;

#define LAS __attribute__((address_space(3)))
typedef unsigned short bf16_t;
typedef short bf16x8 __attribute__((ext_vector_type(8)));
typedef short s16x4 __attribute__((ext_vector_type(4)));
typedef float f32x2 __attribute__((ext_vector_type(2)));
typedef float f32x4 __attribute__((ext_vector_type(4)));
typedef float f32x16 __attribute__((ext_vector_type(16)));
typedef unsigned u32x4 __attribute__((ext_vector_type(4)));
typedef unsigned u32x2 __attribute__((ext_vector_type(2)));

constexpr int DM = 1024, NB = 4, SEQ = 8192, SB = 16, SS = 64, PAST = 4096, KALL = PAST + SS;
constexpr int MP = NB * SEQ, MS = SB * SS, MT = MP + MS;
constexpr int FF = 2816, NH = 16, HD = 64, NG = 64, NP = 64;
constexpr int NQKV = 3328;
constexpr float EPS = 1e-6f;
constexpr float C2 = 0.125f * 1.4426950408889634f;
constexpr float LOG2E = 1.4426950408889634f;
constexpr int NCH = SEQ / 64;
constexpr int NITEM = NB * NCH + SB;

constexpr size_t O_Y = 0;
constexpr size_t O_SRE_P = (size_t)MT * DM;
constexpr size_t O_SIM_P = O_SRE_P + NB * NG * NP;
constexpr size_t O_K_P = O_SIM_P + NB * NG * NP;
constexpr size_t O_V_P = O_K_P + (size_t)MP * DM;
constexpr size_t O_LF_P = O_V_P + (size_t)MP * DM;
constexpr size_t O_CV_P = O_LF_P + (size_t)MP * NH;
constexpr size_t O_SRE_S = O_CV_P + 2 * NB * 2 * FF;
constexpr size_t O_SIM_S = O_SRE_S + SB * NG * NP;
constexpr size_t O_K_S = O_SIM_S + SB * NG * NP;
constexpr size_t O_V_S = O_K_S + (size_t)MS * DM;
constexpr size_t O_LF_S = O_V_S + (size_t)MS * DM;
constexpr size_t O_CV_S = O_LF_S + (size_t)MS * NH;

constexpr size_t MiB = 1u << 20;
constexpr size_t WS_ABAR = 0, WS_A16 = 32768, WS_A64 = 65536, WS_BBT = 131072, WS_CMT = 393216;
constexpr size_t WS_SS = 1 * MiB, WS_IR0 = 2 * MiB, WS_CKP = 3 * MiB, WS_CKS = 5 * MiB;
constexpr size_t WS_WGLU = 10 * MiB, WS_WUG = 14 * MiB, WS_WDN = 36 * MiB, WS_WQKV = 47 * MiB, WS_WO = 54 * MiB;
constexpr size_t WS_X = 64 * MiB, WS_XB = 197 * MiB;
constexpr size_t WS_BIG = 264 * MiB;
constexpr size_t WS_G = WS_BIG, WS_E1 = 346 * MiB;
constexpr size_t WS_H = WS_BIG;
constexpr size_t WS_PG1 = 734 * MiB, WS_PDN0 = 798 * MiB, WS_PWO = 842 * MiB, WS_PDN1 = 874 * MiB;
constexpr size_t WS_CNT = WS_SS + 655360;
constexpr size_t WS_KX = 718 * MiB;
constexpr size_t WS_Q = WS_BIG, WS_KP = 330 * MiB, WS_VP = 394 * MiB, WS_KS = 458 * MiB, WS_VS = 588 * MiB;

__device__ __forceinline__ unsigned cvt_pk_bf16(float lo, float hi) { unsigned r; asm volatile("v_cvt_pk_bf16_f32 %0, %1, %2" : "=v"(r) : "v"(lo), "v"(hi)); return r; }
__device__ __forceinline__ unsigned cvtpk_s(float lo, float hi) { typedef __bf16 bf16x2_t __attribute__((ext_vector_type(2))); f32x2 v = {lo, hi}; bf16x2_t b = __builtin_convertvector(v, bf16x2_t); return __builtin_bit_cast(unsigned, b); }
__device__ __forceinline__ float gelu_tanh(float v) {
    const float t = v * (0.7978845608f + 0.0356774081f * v * v);
    const float e = __builtin_amdgcn_exp2f(-2.8853900818f * t);
    return v * __builtin_amdgcn_rcpf(1.0f + e);
}
__device__ __forceinline__ float sigmoidf_(float v) { const float e = __builtin_amdgcn_exp2f(-LOG2E * v); return __builtin_amdgcn_rcpf(1.0f + e); }
__device__ __forceinline__ float wave_sum(float v) {
#pragma unroll
    for (int o = 1; o < 64; o <<= 1) v += __shfl_xor(v, o);
    return v;
}
template <int CTRL> __device__ __forceinline__ float dppf(float v) { return __int_as_float(__builtin_amdgcn_update_dpp(0, __float_as_int(v), CTRL, 0xf, 0xf, false)); }
#define LDS_WAIT() asm volatile("s_waitcnt lgkmcnt(0)" ::: "memory")

namespace pg8 {
constexpr int BM = 256, BK = 64, HALF = 128, HTB = HALF * BK * 2, STAGE_BYTES = 8 * HTB, NXCD = 8, WGM = 8;
__host__ __device__ __forceinline__ int lds_byte(int r, int c) { const int st = (r >> 4) * 2 + (c >> 5), rr = r & 15, cc = c & 31, ob = rr * 64 + cc * 2; return st * 1024 + (ob ^ (((ob >> 9) & 1) << 5)); }
__host__ __device__ __forceinline__ void stage_rc(int b, int& R, int& C) { const int st = b / 1024, sb = b % 1024, swz = sb ^ (((sb >> 9) & 1) << 5); R = (st >> 1) * 16 + swz / 64; C = (st & 1) * 32 + (swz % 64) / 2; }
__host__ __device__ __forceinline__ int perm32(int rho) { const int n = rho >> 4, i = rho & 15; return 8 * (i >> 2) + 4 * n + (i & 3); }
struct Unit { int pm, pn, ks; };
struct Gemm { const bf16_t* A; const bf16_t* Bt; int K; int nt; };
template <bool FFNROWS> struct Order {
    int nM, nN, nwg, G, c;
    __device__ void init(int nM_, int nN_, int G_, int c_) { nM = nM_; nN = nN_; nwg = nM * nN; G = G_; c = c_; }
    __device__ bool next(int i, Unit& u) const {
        const long L = (long)i * G + c; if (L >= nwg) return false;
        int wgid = (int)L; { const int q = nwg / NXCD, r = nwg % NXCD, xcd = wgid % NXCD, off = wgid / NXCD; wgid = (xcd < r ? xcd * (q + 1) : r * (q + 1) + (xcd - r) * q) + off; }
        const int nig = WGM * nN, gid = wgid / nig, fm = gid * WGM, gsz = (nM - fm) < WGM ? (nM - fm) : WGM;
        u.pm = fm + ((wgid % nig) % gsz); u.pn = (wgid % nig) / gsz; u.ks = 0; return true;
    }
    __device__ __forceinline__ long arow(int pm) const {
        if (!FFNROWS) return (long)pm * BM;
        if (pm < 132) { const int n = pm / 33, R = pm % 33; return (long)n * SEQ + 254 * R - 2; }
        return (long)MP + 256 * (pm - 132);
    }
};

template <int pm0, int nMt, int nN, int S> struct OrderTail {
    int G, c;
    __device__ bool next(int i, Unit& u) const { const long L = (long)i * G + c; if (L >= (long)nMt * nN * S) return false; const int tile = (int)L / S; u.ks = (int)L % S; u.pm = pm0 + tile % nMt; u.pn = tile / nMt; return true; }
    __device__ __forceinline__ long arow(int pm) const { return (long)pm * BM; }
};
template <class Epi, class Sched>
__device__ __forceinline__ void gemm_phase(LAS unsigned char* lds, const Gemm g, const Sched& S, const Epi& E) {
    int tid_ = threadIdx.x; asm volatile("" : "+v"(tid_));
    const int tid = tid_, wid = __builtin_amdgcn_readfirstlane(tid >> 6), lane = tid & 63, wr = wid >> 2, wc = wid & 3, fr = lane & 15, fq = lane >> 4;
    const int K = g.K, nt = g.nt;
    unsigned voffA[2], voffB[2];
#pragma unroll
    for (int i = 0; i < 2; ++i) { int R, C; stage_rc(tid * 16 + i * 8192, R, C); const int Rb = ((R & ~31) + perm32(R & 31));
        voffA[i] = (unsigned)(R * K + C) * 2u; voffB[i] = (unsigned)(Rb * K + C) * 2u; }
    const size_t kstep = (size_t)(BK * 2);
    const size_t hstep = (size_t)HALF * K * 2;
    const size_t tstep = 2 * hstep;
    const size_t rowb = (size_t)K * 2;
    const unsigned ldsw = (unsigned)wid * 1024u;
    const int aoff = lds_byte(wr * 64 + fr, fq * 8), boff = lds_byte(wc * 32 + fr, fq * 8);
#define PG8_SA(b, h) (((b) * 2 + (h)) * HTB)
#define PG8_SB(b, h) ((4 + (b) * 2 + (h)) * HTB)
#define PG8_STAGE(bufoff, gbase, voff) do { _Pragma("unroll") for (int _i = 0; _i < 2; ++_i) \
        __builtin_amdgcn_global_load_lds((const unsigned*)((const char*)(gbase) + (voff)[_i]), (LAS unsigned*)(lds + (bufoff) + ldsw + _i * 8192), 16, 0, 0); } while (0)
#define PG8_LDA(dst, b, h) do { _Pragma("unroll") for (int m = 0; m < 4; ++m) _Pragma("unroll") for (int k = 0; k < 2; ++k) dst[m][k] = *(const LAS bf16x8*)(lds + PG8_SA(b, h) + aoff + m * 2048 + k * 1024); } while (0)
#define PG8_LDB(dst, b, h) do { _Pragma("unroll") for (int n = 0; n < 2; ++n) _Pragma("unroll") for (int k = 0; k < 2; ++k) dst[n][k] = *(const LAS bf16x8*)(lds + PG8_SB(b, h) + boff + n * 2048 + k * 1024); } while (0)
#define PG8_MMA(ai, bj, At, Bt) do { __builtin_amdgcn_s_setprio(1); _Pragma("unroll") for (int m = 0; m < 4; ++m) _Pragma("unroll") for (int n = 0; n < 2; ++n) _Pragma("unroll") for (int k = 0; k < 2; ++k) \
        acc[ai][bj][m][n] = __builtin_amdgcn_mfma_f32_16x16x32_bf16(Bt[n][k], At[m][k], acc[ai][bj][m][n], 0, 0, 0); __builtin_amdgcn_s_setprio(0); } while (0)
#define PG8_WAIT_V(n) asm volatile("s_waitcnt vmcnt(" #n ")" ::: "memory")
#define PG8_WAIT_L(n) asm volatile("s_waitcnt lgkmcnt(" #n ")" ::: "memory")
#define PG8_BAR __builtin_amdgcn_s_barrier()
#define PG8_SCHED __builtin_amdgcn_sched_barrier(0)
    Unit cur, nxt; int ui = 0;
    if (!S.next(0, cur)) return;
    f32x4 acc[2][2][4][2];
#pragma unroll
    for (int a = 0; a < 2; ++a)
#pragma unroll
        for (int b = 0; b < 2; ++b)
#pragma unroll
            for (int m = 0; m < 4; ++m)
#pragma unroll
                for (int n = 0; n < 2; ++n) acc[a][b][m][n] = (f32x4){0.f, 0.f, 0.f, 0.f};
    bf16x8 At[4][2], B0[2][2], B1[2][2];
    const size_t kslice = (size_t)nt * kstep;
    const char* cA = (const char*)g.A + S.arow(cur.pm) * (long)rowb + cur.ks * kslice; const char* cB = (const char*)g.Bt + (size_t)cur.pn * tstep + cur.ks * kslice;
    PG8_STAGE(PG8_SB(0, 0), cB, voffB); PG8_STAGE(PG8_SB(0, 1), cB + hstep, voffB); PG8_STAGE(PG8_SA(0, 0), cA, voffA); PG8_STAGE(PG8_SA(0, 1), cA + hstep, voffA);
    if (wr == 1) PG8_BAR;
    PG8_WAIT_V(2); PG8_BAR;
    PG8_STAGE(PG8_SB(1, 0), cB + kstep, voffB); PG8_STAGE(PG8_SA(1, 0), cA + kstep, voffA); PG8_STAGE(PG8_SB(1, 1), cB + hstep + kstep, voffB);
    PG8_WAIT_V(6); PG8_BAR;
    for (;;) {
        const bool has_next = S.next(ui + 1, nxt);
        const char* nA = has_next ? (const char*)g.A + S.arow(nxt.pm) * (long)rowb + nxt.ks * kslice : cA; const char* nB = has_next ? (const char*)g.Bt + (size_t)nxt.pn * tstep + nxt.ks * kslice : cB;
        for (int t = 0; t < nt; t += 2) {
            const bool last = (t == nt - 2);
            const char* a1 = cA + (size_t)(t + 1) * kstep;
            const char* a2 = last ? nA : cA + (size_t)(t + 2) * kstep; const char* b2 = last ? nB : cB + (size_t)(t + 2) * kstep;
            const char* a3 = a2 + kstep; const char* b3 = b2 + kstep;
            PG8_LDB(B0, 0, 0); PG8_LDB(B1, 0, 1); PG8_SCHED; PG8_LDA(At, 0, 0); PG8_STAGE(PG8_SA(1, 1), a1 + hstep, voffA);
            PG8_WAIT_V(8); PG8_WAIT_L(0); PG8_BAR; PG8_MMA(0, 0, At, B0); PG8_MMA(0, 1, At, B1); PG8_BAR; PG8_SCHED;
            PG8_LDA(At, 0, 1); PG8_STAGE(PG8_SB(0, 0), b2, voffB); PG8_STAGE(PG8_SB(0, 1), b2 + hstep, voffB); PG8_STAGE(PG8_SA(0, 0), a2, voffA);
            PG8_WAIT_V(8); PG8_WAIT_L(0); PG8_BAR; PG8_MMA(1, 0, At, B0); PG8_MMA(1, 1, At, B1); PG8_BAR; PG8_SCHED;
            PG8_LDB(B0, 1, 0); PG8_LDB(B1, 1, 1); PG8_SCHED; PG8_LDA(At, 1, 0); PG8_STAGE(PG8_SA(0, 1), a2 + hstep, voffA);
            PG8_WAIT_V(8); PG8_WAIT_L(0); PG8_BAR; PG8_MMA(0, 0, At, B0); PG8_MMA(0, 1, At, B1); PG8_BAR; PG8_SCHED;
            PG8_LDA(At, 1, 1); PG8_STAGE(PG8_SB(1, 0), b3, voffB); PG8_STAGE(PG8_SB(1, 1), b3 + hstep, voffB); PG8_STAGE(PG8_SA(1, 0), a3, voffA);
            PG8_WAIT_V(8); PG8_WAIT_L(0); PG8_BAR; PG8_MMA(1, 0, At, B0); PG8_MMA(1, 1, At, B1); PG8_BAR; PG8_SCHED;
        }
        if (wr == 0) PG8_BAR;
        { int fr_ = fr, fq_ = fq; asm volatile("" : "+v"(fr_), "+v"(fq_)); E(acc, cur, wr, wc, fr_, fq_); }
        if (!has_next) break;
#pragma unroll
        for (int a = 0; a < 2; ++a)
#pragma unroll
            for (int b = 0; b < 2; ++b)
#pragma unroll
                for (int m = 0; m < 4; ++m)
#pragma unroll
                    for (int n = 0; n < 2; ++n) acc[a][b][m][n] = (f32x4){0.f, 0.f, 0.f, 0.f};
        cur = nxt; cA = nA; cB = nB; ++ui;
        if (wr == 1) PG8_BAR;
    }
    PG8_WAIT_V(0);
    PG8_BAR;
#undef PG8_SA
#undef PG8_SB
#undef PG8_STAGE
#undef PG8_LDA
#undef PG8_LDB
#undef PG8_MMA
#undef PG8_WAIT_V
#undef PG8_WAIT_L
#undef PG8_BAR
#undef PG8_SCHED
}
}


template <int MODE  , bool RES_F32  , bool WRITE_XB, bool WRITE_X> struct EpiRes {
    const float* r0; const float* r1;
    float* X; bf16_t* xb; float* sumsq;
    __device__ __forceinline__ void group(const f32x4 (&a)[2][2], const pg8::Unit& u, int ai, int m, int wr, int wc, int fr, int fq) const {
        const int row = u.pm * 256 + ai * 128 + wr * 64 + m * 16 + fr;
        const float* rp = row < MP ? r0 + (size_t)row * DM : r1 + (size_t)(row - MP) * DM;
        float ss = 0.f;
#pragma unroll
        for (int bj = 0; bj < (MODE == 1 ? 1 : 2); ++bj) {
            const int col = (MODE == 1 ? u.pn * 128 : u.pn * 256 + bj * 128) + wc * 32 + fq * 8;
            f32x4 v0, v1;
            if (MODE == 1) {
#pragma unroll
                for (int j = 0; j < 4; ++j) { v0[j] = a[0][0][j] * sigmoidf_(a[1][0][j]); v1[j] = a[0][1][j] * sigmoidf_(a[1][1][j]); }
            } else { v0 = a[bj][0]; v1 = a[bj][1]; }
            if (RES_F32) { v0 += *(const f32x4*)(rp + col); v1 += *(const f32x4*)(rp + col + 4); }
            else { const u32x4 rb = *(const u32x4*)(xb + (size_t)row * DM + col);
                v0 += (f32x4){__uint_as_float(rb.x << 16), __uint_as_float(rb.x & 0xffff0000u), __uint_as_float(rb.y << 16), __uint_as_float(rb.y & 0xffff0000u)};
                v1 += (f32x4){__uint_as_float(rb.z << 16), __uint_as_float(rb.z & 0xffff0000u), __uint_as_float(rb.w << 16), __uint_as_float(rb.w & 0xffff0000u)}; }
            if (WRITE_X) { *(f32x4*)(X + (size_t)row * DM + col) = v0; *(f32x4*)(X + (size_t)row * DM + col + 4) = v1; }
            if (WRITE_XB) { u32x4 w; w.x = cvt_pk_bf16(v0[0], v0[1]); w.y = cvt_pk_bf16(v0[2], v0[3]); w.z = cvt_pk_bf16(v1[0], v1[1]); w.w = cvt_pk_bf16(v1[2], v1[3]);
                *(u32x4*)(xb + (size_t)row * DM + col) = w; }
            ss += (v0[0] * v0[0] + v0[1] * v0[1]) + (v0[2] * v0[2] + v0[3] * v0[3]) + (v1[0] * v1[0] + v1[1] * v1[1]) + (v1[2] * v1[2] + v1[3] * v1[3]);
        }
        ss += __shfl_xor(ss, 16); ss += __shfl_xor(ss, 32);
        if (fq == 0) atomicAdd(sumsq + row, ss);
    }
    __device__ __forceinline__ void operator()(f32x4 (&acc)[2][2][4][2], const pg8::Unit& u, int wr, int wc, int fr, int fq) const {
#pragma unroll
        for (int ai = 0; ai < 2; ++ai)
#pragma unroll
            for (int m = 0; m < 4; ++m) { const f32x4 a[2][2] = {{acc[ai][0][m][0], acc[ai][0][m][1]}, {acc[ai][1][m][0], acc[ai][1][m][1]}}; group(a, u, ai, m, wr, wc, fr, fq); }
    }
};

template <class Inner, int S, int nN, int pm0, size_t POFF, int COFF> struct EpiSplitK {
    Inner inner; unsigned char* wsb;
    __device__ __forceinline__ void operator()(f32x4 (&acc)[2][2][4][2], const pg8::Unit& u, int wr, int wc, int fr, int fq) const {
        static_assert(S >= 8, "eight row groups need eight slices");
        float* const P = (float*)(wsb + POFF); unsigned* const cnt = (unsigned*)(wsb + WS_CNT) + COFF;
        const int tix = (u.pm - pm0) * nN + u.pn; int tid = threadIdx.x; asm volatile("" : "+v"(tid));
        float* slice = P + ((size_t)tix * S + u.ks) * 65536 + (size_t)tid * 4;
#pragma unroll
        for (int ai = 0; ai < 2; ++ai)
#pragma unroll
            for (int bj = 0; bj < 2; ++bj)
#pragma unroll
                for (int m = 0; m < 4; ++m)
#pragma unroll
                    for (int n = 0; n < 2; ++n) *(f32x4*)(slice + (size_t)(((ai * 2 + bj) * 4 + m) * 2 + n) * 2048) = acc[ai][bj][m][n];
        asm volatile("s_waitcnt vmcnt(0)" ::: "memory");
        __syncthreads();
        if (tid == 0) { __threadfence(); (void)__hip_atomic_fetch_add(cnt + tix, 1u, __ATOMIC_RELAXED, __HIP_MEMORY_SCOPE_AGENT); }
        if (u.ks >= 8) return;
        if (tid == 0) { unsigned sp = 0; while (__hip_atomic_load(cnt + tix, __ATOMIC_RELAXED, __HIP_MEMORY_SCOPE_AGENT) < (unsigned)S) { __builtin_amdgcn_s_sleep(4); if (++sp > (1u << 22)) break; } __threadfence(); }
        __syncthreads();
        const int ai = u.ks >> 2, m = u.ks & 3;
        f32x4 t[2][2] = {{(f32x4){0.f, 0.f, 0.f, 0.f}, (f32x4){0.f, 0.f, 0.f, 0.f}}, {(f32x4){0.f, 0.f, 0.f, 0.f}, (f32x4){0.f, 0.f, 0.f, 0.f}}};
        const float* p0 = P + (size_t)tix * S * 65536 + (size_t)tid * 4;
#pragma unroll
        for (int s = 0; s < S; ++s) {
#pragma unroll
            for (int bj = 0; bj < 2; ++bj)
#pragma unroll
                for (int n = 0; n < 2; ++n) t[bj][n] += __builtin_nontemporal_load((const f32x4*)(p0 + (size_t)s * 65536 + (size_t)(((ai * 2 + bj) * 4 + m) * 2 + n) * 2048));
        }
        inner.group(t, u, ai, m, wr, wc, fr, fq);
    }
};

struct EpiConv {
    bf16_t* H; const float* sumsq; const float* convw; const float* convb; const float* hist; float* outc_p; float* outc_s; LAS float* xch;
    __device__ __forceinline__ void operator()(f32x4 (&acc)[2][2][4][2], const pg8::Unit& u, int wr, int wc, int fr, int fq) const {
        const bool samp = u.pm >= 132;
        int n = 0, tok0 = 0; long grow0;
        if (!samp) { n = u.pm / 33; const int R = u.pm % 33; tok0 = 254 * R - 2; grow0 = (long)n * SEQ + tok0; } else { grow0 = (long)MP + 256 * (u.pm - 132); }
        const int f0 = 128 * u.pn + 32 * wc + 8 * fq;
#pragma unroll
        for (int ai = 0; ai < 2; ++ai)
#pragma unroll
            for (int m = 0; m < 4; ++m) {
                const int i = ai * 128 + wr * 64 + m * 16 + fr; long gr = grow0 + i; if (gr < 0) gr = 0;
                float rs = __builtin_amdgcn_rsqf(sumsq[gr] * (1.0f / DM) + EPS);
                float ra = rs; if (!samp && tok0 + i < 0) ra = 0.f;
#pragma unroll
                for (int nn = 0; nn < 2; ++nn) { acc[ai][0][m][nn] *= ra; acc[ai][1][m][nn] *= rs; }
            }
        if (fr >= 14) {
#pragma unroll
            for (int ai = 0; ai < 2; ++ai) { LAS float* p = xch + ((ai * 2 + wr) * 2 + (fr - 14)) * 128 + 32 * wc + 8 * fq;
                *(LAS f32x4*)p = acc[ai][0][3][0]; *(LAS f32x4*)(p + 4) = acc[ai][0][3][1]; }
        }
        asm volatile("s_waitcnt lgkmcnt(0)\n\ts_barrier" ::: "memory");
#pragma unroll
        for (int nn = 0; nn < 2; ++nn) {
            asm volatile("" ::: "memory");
            const int fc = f0 + 4 * nn;
            const f32x4 w0 = *(const f32x4*)(convw + fc), w1 = *(const f32x4*)(convw + FF + fc), w2 = *(const f32x4*)(convw + 2 * FF + fc), cb = *(const f32x4*)(convb + fc);
#pragma unroll
            for (int ai = 0; ai < 2; ++ai) {
                const int blk = ai * 2 + wr;
                f32x4 prev = (f32x4){0.f, 0.f, 0.f, 0.f};
                if (fr >= 14) {
                    if (samp) { prev = *(const f32x4*)(hist + ((size_t)((4 * (u.pm - 132) + blk) * 2 + (fr - 14))) * FF + fc); }
                    else if (blk > 0) { prev = *(const LAS f32x4*)(xch + (((blk - 1) * 2) + (fr - 14)) * 128 + 32 * wc + 8 * fq + 4 * nn); }
                }
#pragma unroll
                for (int m = 0; m < 4; ++m) {
                    const int i = ai * 128 + wr * 64 + m * 16 + fr; const long gr = grow0 + i;
                    const f32x4 a = acc[ai][0][m][nn], gt = acc[ai][1][m][nn]; f32x4 hv;
#pragma unroll
                    for (int j = 0; j < 4; ++j) {
                        const float a1 = __int_as_float(__builtin_amdgcn_update_dpp(__float_as_int(dppf<0x121>(prev[j])), __float_as_int(a[j]), 0x111, 0xf, 0xf, false));
                        const float a2 = __int_as_float(__builtin_amdgcn_update_dpp(__float_as_int(dppf<0x122>(prev[j])), __float_as_int(a[j]), 0x112, 0xf, 0xf, false));
                        const float cv = w0[j] * a2 + w1[j] * a1 + w2[j] * a[j] + cb[j];
                        hv[j] = gelu_tanh(cv) * gt[j];
                    }
                    u32x2 wv; wv.x = cvt_pk_bf16(hv[0], hv[1]); wv.y = cvt_pk_bf16(hv[2], hv[3]);
                    const int tok = tok0 + i;
                    const bool valid = samp || (i >= 2 && tok < SEQ);
                    if (valid) *(u32x2*)(H + (size_t)gr * FF + fc) = wv;
                    if (!samp) { if (valid && tok >= SEQ - 2) { float* o = outc_p + ((size_t)(n * 2 + (tok - (SEQ - 2)))) * FF + fc; *(f32x4*)o = a; } }
                    else { if ((i & 63) >= 62) { float* o = outc_s + ((size_t)((4 * (u.pm - 132) + (i >> 6)) * 2 + ((i & 63) - 62))) * FF + fc; *(f32x4*)o = a; } }
                    prev = a;
                }
            }
        }
    }
};

struct EpiQKV {
    const float* sumsq; const float* bf; bf16_t* Q; bf16_t* Kp; bf16_t* Vp; bf16_t* Ks; bf16_t* Vs; float* out;
    __device__ __forceinline__ void operator()(f32x4 (&acc)[2][2][4][2], const pg8::Unit& u, int wr, int wc, int fr, int fq) const {
        const int sec = u.pn >> 2;
#pragma unroll
        for (int ai = 0; ai < 2; ++ai)
#pragma unroll
            for (int m = 0; m < 4; ++m) {
                const int row = u.pm * 256 + ai * 128 + wr * 64 + m * 16 + fr;
                const float rs = __builtin_amdgcn_rsqf(sumsq[row] * (1.0f / DM) + EPS);
                if (sec == 3) {
                    if (wc == 0 && fq < 2) {
                        const f32x4 v0 = acc[ai][0][m][0] * rs, v1 = acc[ai][0][m][1] * rs; f32x4 l0, l1;
#pragma unroll
                        for (int j = 0; j < 4; ++j) { const float x0 = v0[j] + bf[8 * fq + j], x1 = v1[j] + bf[8 * fq + 4 + j];
                            l0[j] = fminf(x0, 0.f) - log1pf(__expf(-fabsf(x0))); l1[j] = fminf(x1, 0.f) - log1pf(__expf(-fabsf(x1))); }
                        float* o = row < MP ? out + O_LF_P + (size_t)row * NH + 8 * fq : out + O_LF_S + (size_t)(row - MP) * NH + 8 * fq;
                        *(f32x4*)o = l0; *(f32x4*)(o + 4) = l1;
                    }
                } else {
#pragma unroll
                    for (int bj = 0; bj < 2; ++bj) {
                        const int col = (u.pn & 3) * 256 + bj * 128 + wc * 32 + fq * 8;
                        const float sc = sec == 0 ? rs * C2 : rs;
                        const f32x4 v0 = acc[ai][bj][m][0] * sc, v1 = acc[ai][bj][m][1] * sc;
                        u32x4 w; w.x = cvt_pk_bf16(v0[0], v0[1]); w.y = cvt_pk_bf16(v0[2], v0[3]); w.z = cvt_pk_bf16(v1[0], v1[1]); w.w = cvt_pk_bf16(v1[2], v1[3]);
                        if (sec == 0) { *(u32x4*)(Q + (size_t)row * DM + col) = w; }
                        else {
                            bf16_t* dst; float* o;
                            if (row < MP) { dst = (sec == 1 ? Kp : Vp) + (size_t)row * DM + col; o = out + (sec == 1 ? O_K_P : O_V_P) + (size_t)row * DM + col; }
                            else { const int rs_ = row - MP; dst = nullptr; o = out + (sec == 1 ? O_K_S : O_V_S) + (size_t)rs_ * DM + col; }
                            if (dst) *(u32x4*)dst = w; *(f32x4*)o = v0; *(f32x4*)(o + 4) = v1;
                        }
                    }
                }
            }
    }
};

namespace att {
constexpr int OFF_K = 0, OFF_V = 16384, OFF_CK = 32768, OFF_WSF = 33280, OFF_OST = 35328;
__device__ __forceinline__ int crow(int r, int hi) { return (r & 3) + 8 * (r >> 2) + 4 * hi; }
__device__ __forceinline__ void glds16(const void* gsrc, unsigned lds_dst) { unsigned keep;
    asm volatile("s_mov_b32 %0, m0\n\ts_mov_b32 m0, %2\n\ts_nop 0\n\tglobal_load_lds_dwordx4 %1, off\n\ts_mov_b32 m0, %0" : "=&s"(keep) : "v"(gsrc), "s"(lds_dst) : "memory"); }
__device__ __forceinline__ void glds4(const void* gsrc, unsigned lds_dst) { unsigned keep;
    asm volatile("s_mov_b32 %0, m0\n\ts_mov_b32 m0, %2\n\ts_nop 0\n\tglobal_load_lds_dword %1, off\n\ts_mov_b32 m0, %0" : "=&s"(keep) : "v"(gsrc), "s"(lds_dst) : "memory"); }
__device__ __forceinline__ float max3f(float a, float b, float c) { return __builtin_fmaxf(__builtin_fmaxf(a, b), c); }
#define SBAR() __builtin_amdgcn_sched_barrier(0)
__device__ __forceinline__ void qkt(f32x16& p0, f32x16& p1, const char* Kslot, const bf16x8* qr, const f32x16& negm, int r32, int hi) {
    const char* kb = Kslot + hi * 1024 + r32 * 16;
#pragma unroll
    for (int d0 = 0; d0 < 4; ++d0) {
        const bf16x8 b0 = *reinterpret_cast<const bf16x8*>(kb + d0 * 2048);
        const bf16x8 b1 = *reinterpret_cast<const bf16x8*>(kb + d0 * 2048 + 512);
        if (d0 == 0) { p0 = __builtin_amdgcn_mfma_f32_32x32x16_bf16(b0, qr[0], negm, 0, 0, 0); p1 = __builtin_amdgcn_mfma_f32_32x32x16_bf16(b1, qr[0], negm, 0, 0, 0); }
        else { p0 = __builtin_amdgcn_mfma_f32_32x32x16_bf16(b0, qr[d0], p0, 0, 0, 0); p1 = __builtin_amdgcn_mfma_f32_32x32x16_bf16(b1, qr[d0], p1, 0, 0, 0); } }
}
__device__ __forceinline__ void pv(f32x16* o, int vb, bf16x8 pa0, bf16x8 pa1, bf16x8 pa2, bf16x8 pa3) {
#pragma unroll
    for (int d0 = 0; d0 < 2; ++d0) { s16x4 lo[4], hi[4];
#pragma unroll
        for (int ks = 0; ks < 4; ++ks) {
            asm volatile("ds_read_b64_tr_b16 %0,%1 offset:%c2" : "=&v"(lo[ks]) : "v"(vb), "i"(d0 * 4096 + ks * 1024) : "memory");
            asm volatile("ds_read_b64_tr_b16 %0,%1 offset:%c2" : "=&v"(hi[ks]) : "v"(vb), "i"(d0 * 4096 + ks * 1024 + 512) : "memory"); }
        asm volatile("s_waitcnt lgkmcnt(0)" ::: "memory"); SBAR();
#define PK(k) (bf16x8){lo[k][0], lo[k][1], lo[k][2], lo[k][3], hi[k][0], hi[k][1], hi[k][2], hi[k][3]}
        o[d0] = __builtin_amdgcn_mfma_f32_32x32x16_bf16(pa0, PK(0), o[d0], 0, 0, 0);
        o[d0] = __builtin_amdgcn_mfma_f32_32x32x16_bf16(pa1, PK(1), o[d0], 0, 0, 0);
        o[d0] = __builtin_amdgcn_mfma_f32_32x32x16_bf16(pa2, PK(2), o[d0], 0, 0, 0);
        o[d0] = __builtin_amdgcn_mfma_f32_32x32x16_bf16(pa3, PK(3), o[d0], 0, 0, 0);
#undef PK
    }
}
constexpr int OFF_CKA = 32768, OFF_WSF2 = 49408, OFF_OST2 = 51456;
__device__ __forceinline__ void attn_unit_sample(char* shm, const bf16_t* Q, const float* kc, const float* vc, const float* kn, const float* vn, bf16_t* O, const float* ck) {
    int tid_ = threadIdx.x; asm volatile("" : "+v"(tid_));
    const int tid = tid_, lane = tid & 63, r32 = lane & 31, hi = lane >> 5; const int wid = __builtin_amdgcn_readfirstlane(tid >> 6);
    const unsigned lds0 = (unsigned)(uintptr_t)shm;
    float* wsf = (float*)(shm + OFF_WSF2) + wid * 64;
    float* cka = (float*)(shm + OFF_CKA);
    constexpr int NT = KALL / 64, qpos0 = PAST;
    const int vrow = 16 * (wid & 3) + (lane >> 2), vcol = (wid >> 2) * 32 + (lane & 3) * 8;
    f32x4 kreg[2], vreg[2];
#define LOADT(t) do { const float* kp = (t) < PAST / 64 ? kc + ((size_t)(t) * 64 + lane) * DM + wid * 8 : kn + (size_t)lane * DM + wid * 8; \
        const float* vp = (t) < PAST / 64 ? vc + ((size_t)(t) * 64 + vrow) * DM + vcol : vn + (size_t)vrow * DM + vcol; \
        kreg[0] = *(const f32x4*)kp; kreg[1] = *(const f32x4*)(kp + 4); vreg[0] = *(const f32x4*)vp; vreg[1] = *(const f32x4*)(vp + 4); } while (0)
#define STORET(slot) do { u32x4 kw, vw; kw.x = cvt_pk_bf16(kreg[0][0], kreg[0][1]); kw.y = cvt_pk_bf16(kreg[0][2], kreg[0][3]); kw.z = cvt_pk_bf16(kreg[1][0], kreg[1][1]); kw.w = cvt_pk_bf16(kreg[1][2], kreg[1][3]); \
        vw.x = cvt_pk_bf16(vreg[0][0], vreg[0][1]); vw.y = cvt_pk_bf16(vreg[0][2], vreg[0][3]); vw.z = cvt_pk_bf16(vreg[1][0], vreg[1][1]); vw.w = cvt_pk_bf16(vreg[1][2], vreg[1][3]); \
        *(u32x4*)(shm + OFF_K + (slot) * 8192 + wid * 1024 + lane * 16) = kw; *(u32x4*)(shm + OFF_V + (slot) * 8192 + wid * 1024 + lane * 16) = vw; } while (0)
    LOADT(0);
    for (int i = tid; i < KALL; i += 512) cka[i] = ck[i];
    const bool active = wid < 2; const int qw = active ? wid : 0;
    const int vb0 = (int)(lds0 + OFF_V) + ((lane >> 4) & 1) * 32 + (lane & 3) * 8 + (4 * hi + ((lane & 15) >> 2)) * 64;
    const bf16_t* Qw = Q + (long)(qw * 32) * DM;
    bf16x8 qr[4];
#pragma unroll
    for (int d0 = 0; d0 < 4; ++d0) qr[d0] = *reinterpret_cast<const bf16x8*>(&Qw[(long)r32 * DM + d0 * 16 + hi * 8]);
    const int qpos = qpos0 + qw * 32 + r32, qmin = qpos0 + qw * 32;
    float mhat = -ck[qpos], l_reg = 0.f;
    f32x16 o[2]; o[0] = f32x16{}; o[1] = f32x16{};
    f32x16 negm;
#pragma unroll
    for (int r = 0; r < 16; ++r) negm[r] = -mhat;
    for (int t = 0; t < NT; ++t) {
        const int slot = t & 1;
        STORET(slot);
        if (t + 1 < NT) LOADT(t + 1);
        asm volatile("s_waitcnt lgkmcnt(0)\n\ts_barrier" ::: "memory");
        if (active) {
            f32x16 p0, p1;
            qkt(p0, p1, shm + OFF_K + slot * 8192, qr, negm, r32, hi);
            const float* ckp = cka + 64 * t;
#pragma unroll
            for (int a = 0; a < 4; ++a) { const f32x4 c0 = *(const f32x4*)(ckp + 8 * a + 4 * hi), c1 = *(const f32x4*)(ckp + 32 + 8 * a + 4 * hi);
#pragma unroll
                for (int j = 0; j < 4; ++j) { p0[4 * a + j] -= c0[j]; p1[4 * a + j] -= c1[j]; } }
            if (64 * t + 63 > qmin) {
#pragma unroll
                for (int r = 0; r < 16; ++r) { const int kv = 64 * t + crow(r, hi); if (kv > qpos) p0[r] = -1e30f; if (kv + 32 > qpos) p1[r] = -1e30f; }
            }
            float a = max3f(p0[0], p0[1], p1[0]), b = max3f(p0[2], p0[3], p1[1]); a = max3f(a, p1[2], p1[3]);
#pragma unroll
            for (int r = 4; r < 16; r += 4) { a = max3f(a, p0[r], p0[r + 1]); b = max3f(b, p0[r + 2], p0[r + 3]); a = max3f(a, p1[r], p1[r + 1]); b = max3f(b, p1[r + 2], p1[r + 3]); }
            float rm = __builtin_fmaxf(a, b); rm = __builtin_fmaxf(rm, __shfl_xor(rm, 32));
            if (__any(rm > 8.f)) {
                const float dl = __builtin_fmaxf(rm, 0.f); mhat += dl;
#pragma unroll
                for (int r = 0; r < 16; ++r) { p0[r] -= dl; p1[r] -= dl; }
#pragma unroll
                for (int r = 0; r < 16; ++r) negm[r] = -mhat;
                const float f = __builtin_amdgcn_exp2f(-dl); l_reg *= f; if (hi == 0) wsf[r32] = f;
                LDS_WAIT();
#pragma unroll
                for (int d_ = 0; d_ < 2; ++d_)
#pragma unroll
                    for (int r = 0; r < 16; ++r) o[d_][r] *= wsf[crow(r, hi)];
            }
            float sacc = 0.f;
#pragma unroll
            for (int r = 0; r < 16; ++r) { p0[r] = __builtin_amdgcn_exp2f(p0[r]); p1[r] = __builtin_amdgcn_exp2f(p1[r]); sacc += p0[r] + p1[r]; }
            l_reg += sacc;
            u32x4 pw0, pw1, pw2, pw3;
            pw0 = (u32x4){cvtpk_s(p0[0], p0[1]), cvtpk_s(p0[2], p0[3]), cvtpk_s(p0[4], p0[5]), cvtpk_s(p0[6], p0[7])};
            pw1 = (u32x4){cvtpk_s(p0[8], p0[9]), cvtpk_s(p0[10], p0[11]), cvtpk_s(p0[12], p0[13]), cvtpk_s(p0[14], p0[15])};
            pw2 = (u32x4){cvtpk_s(p1[0], p1[1]), cvtpk_s(p1[2], p1[3]), cvtpk_s(p1[4], p1[5]), cvtpk_s(p1[6], p1[7])};
            pw3 = (u32x4){cvtpk_s(p1[8], p1[9]), cvtpk_s(p1[10], p1[11]), cvtpk_s(p1[12], p1[13]), cvtpk_s(p1[14], p1[15])};
            SBAR();
            pv(o, vb0 + slot * 8192, __builtin_bit_cast(bf16x8, pw0), __builtin_bit_cast(bf16x8, pw1), __builtin_bit_cast(bf16x8, pw2), __builtin_bit_cast(bf16x8, pw3));
        }
    }
    if (active) {
        l_reg += __shfl_xor(l_reg, 32);
        if (hi == 0) wsf[32 + r32] = l_reg;
        LDS_WAIT();
        float rli[16];
#pragma unroll
        for (int r = 0; r < 16; ++r) rli[r] = __builtin_amdgcn_rcpf(wsf[32 + crow(r, hi)]);
        bf16_t* Ow = O + (long)(qw * 32) * DM;
        __hip_bfloat16* stg = (__hip_bfloat16*)(shm + OFF_OST2) + wid * 2048;
#pragma unroll
        for (int r = 0; r < 16; ++r) { const int orow = crow(r, hi);
#pragma unroll
            for (int d0 = 0; d0 < 2; ++d0) stg[orow * 64 + d0 * 32 + r32] = __float2bfloat16(o[d0][r] * rli[r]); }
        LDS_WAIT();
#pragma unroll
        for (int i = 0; i < 4; ++i) { const int row = i * 8 + (lane >> 3), ch = lane & 7; const u32x4 v = *(const u32x4*)(stg + row * 64 + ch * 8); *(u32x4*)(Ow + (long)row * DM + ch * 8) = v; }
    }
    asm volatile("s_waitcnt vmcnt(0) lgkmcnt(0)\n\ts_barrier" ::: "memory");
#undef LOADT
#undef STORET
}
#undef SBAR
}

namespace atf {
using bf16=__hip_bfloat16;
constexpr int SEQ=8192,D=64,DM=1024,NW=8,QBLK=32,QB=QBLK*NW,KVBLK=64;
__device__ __forceinline__ int crow(int r,int hi){return (r&3)+8*(r>>2)+4*hi;}
#define SBAR() __builtin_amdgcn_sched_barrier(0)
__device__ __forceinline__ void cmask(f32x16&p0,f32x16&p1,int jb,int qrel,int hi){
  const float NEG=-INFINITY; int kb=64*jb+4*hi;
  #pragma unroll
  for(int r=0;r<16;++r){int kv=kb+(r&3)+8*(r>>2); if(kv>qrel)p0[r]=NEG; if(kv+32>qrel)p1[r]=NEG;}
}

constexpr int NSLOT=3, SLOTB=8192;
constexpr int LDS_K=0, LDS_V=NSLOT*SLOTB, LDS_X=2*NSLOT*SLOTB, LDS_WS=LDS_X+NSLOT*2048, LDS_OST=LDS_WS+NW*64*4, LDS_BYTES=LDS_OST+NW*4096;
__device__ __forceinline__ void glds16(const void*gsrc,unsigned lds_dst){unsigned keep;
  asm volatile("s_mov_b32 %0, m0\n\ts_mov_b32 m0, %2\n\ts_nop 0\n\tglobal_load_lds_dwordx4 %1, off\n\ts_mov_b32 m0, %0":"=&s"(keep):"v"(gsrc),"s"(lds_dst):"memory");}
__device__ __forceinline__ void glds4(const void*gsrc,unsigned lds_dst){unsigned keep;
  asm volatile("s_mov_b32 %0, m0\n\ts_mov_b32 m0, %2\n\ts_nop 0\n\tglobal_load_lds_dword %1, off\n\ts_mov_b32 m0, %0":"=&s"(keep):"v"(gsrc),"s"(lds_dst):"memory");}
__device__ __forceinline__ bf16x8 mkqx(float mhat,int hi){ const float nv=-mhat; const unsigned h1=(__builtin_bit_cast(unsigned,nv)+0x7fffu+((__builtin_bit_cast(unsigned,nv)>>16)&1u))>>16; const float r1=nv-__builtin_bit_cast(float,h1<<16);
  const unsigned u1=__builtin_bit_cast(unsigned,r1), h2=(u1+0x7fffu+((u1>>16)&1u))>>16; const float r2=r1-__builtin_bit_cast(float,h2<<16); const unsigned u2=__builtin_bit_cast(unsigned,r2), h3=(u2+0x7fffu+((u2>>16)&1u))>>16;
  u32x4 w=hi?(u32x4){0u,0u,0u,0u}:(u32x4){0x3f803f80u,0x3f80u|(h1<<16),h2|(h3<<16),0u}; return __builtin_bit_cast(bf16x8,w); }
__device__ __forceinline__ float max3f(float a,float b,float c){float r;asm("v_max3_f32 %0, %1, %2, %3":"=v"(r):"v"(a),"v"(b),"v"(c));return r;}
__device__ __forceinline__ float max2f(float a,float b){float r;asm("v_max_f32_e32 %0, %1, %2":"=v"(r):"v"(a),"v"(b));return r;}
__device__ __forceinline__ float fadd_s(float a,float b){float r;asm("v_add_f32_e32 %0, %1, %2":"=v"(r):"v"(a),"v"(b));return r;}
__device__ __forceinline__ float fsub_s(float a,float b){float r;asm("v_sub_f32_e32 %0, %1, %2":"=v"(r):"v"(a),"v"(b));return r;}
typedef float f32x2_t __attribute__((ext_vector_type(2))); typedef __bf16 bf16x2_t __attribute__((ext_vector_type(2)));
__device__ __forceinline__ unsigned cvtpk_s(float lo,float hi){f32x2_t v={lo,hi};bf16x2_t b=__builtin_convertvector(v,bf16x2_t);return __builtin_bit_cast(unsigned,b);}
#define WAIT_BAR(N) asm volatile("s_waitcnt vmcnt(" #N ") lgkmcnt(0)\n\ts_barrier":::"memory")

__device__ __forceinline__ void qkt(f32x16&p0,f32x16&p1,const char*Kslot,const char*Xslot,const bf16x8*qr,const bf16x8 qx,const f32x16&negm,int r32,int hi){
  const char*kb=Kslot+hi*1024+r32*16;
  #pragma unroll
  for(int d0=0;d0<4;++d0){
    const bf16x8 b0=*reinterpret_cast<const bf16x8*>(kb+d0*2048);
    const bf16x8 b1=*reinterpret_cast<const bf16x8*>(kb+d0*2048+512);
    if(d0==0){p0=__builtin_amdgcn_mfma_f32_32x32x16_bf16(b0,qr[0],negm,0,0,0);p1=__builtin_amdgcn_mfma_f32_32x32x16_bf16(b1,qr[0],negm,0,0,0);}
    else{p0=__builtin_amdgcn_mfma_f32_32x32x16_bf16(b0,qr[d0],p0,0,0,0);p1=__builtin_amdgcn_mfma_f32_32x32x16_bf16(b1,qr[d0],p1,0,0,0);}}
  { const char*xb=Xslot+hi*1024+r32*16; const bf16x8 x0=*reinterpret_cast<const bf16x8*>(xb), x1=*reinterpret_cast<const bf16x8*>(xb+512);
    p0=__builtin_amdgcn_mfma_f32_32x32x16_bf16(x0,qx,p0,0,0,0);p1=__builtin_amdgcn_mfma_f32_32x32x16_bf16(x1,qx,p1,0,0,0); }
}
typedef __attribute__((address_space(3))) const char* lds_cptr;
typedef short v4i16_t __attribute__((ext_vector_type(4)));
__device__ __forceinline__ void kloadx(bf16x8*kf,lds_cptr xp){ kf[8]=*(const __attribute__((address_space(3))) bf16x8*)(xp); kf[9]=*(const __attribute__((address_space(3))) bf16x8*)(xp+512); }
__device__ __forceinline__ void kload8(bf16x8*kf,lds_cptr kp){
  kf[0]=*(const __attribute__((address_space(3))) bf16x8*)(kp);      kf[1]=*(const __attribute__((address_space(3))) bf16x8*)(kp+512);
  kf[2]=*(const __attribute__((address_space(3))) bf16x8*)(kp+2048); kf[3]=*(const __attribute__((address_space(3))) bf16x8*)(kp+2560);
  kf[4]=*(const __attribute__((address_space(3))) bf16x8*)(kp+4096); kf[5]=*(const __attribute__((address_space(3))) bf16x8*)(kp+4608);
  kf[6]=*(const __attribute__((address_space(3))) bf16x8*)(kp+6144); kf[7]=*(const __attribute__((address_space(3))) bf16x8*)(kp+6656);
}
__device__ __forceinline__ void kload2(bf16x8*kf,lds_cptr kp,int j){ kf[2*j]=*(const __attribute__((address_space(3))) bf16x8*)(kp+j*2048); kf[2*j+1]=*(const __attribute__((address_space(3))) bf16x8*)(kp+j*2048+512); }
__device__ __forceinline__ s16x4 vtr(lds_cptr p){ return __builtin_bit_cast(s16x4,__builtin_amdgcn_ds_read_tr16_b64_v4i16((__attribute__((address_space(3))) v4i16_t*)p)); }
__device__ __forceinline__ float rowmax(const f32x16&p0,const f32x16&p1){
  float a=max3f(p0[0],p0[1],p1[0]),b=max3f(p0[2],p0[3],p1[1]);a=max3f(a,p1[2],p1[3]);
  #pragma unroll
  for(int r=4;r<16;r+=4){a=max3f(a,p0[r],p0[r+1]);b=max3f(b,p0[r+2],p0[r+3]);a=max3f(a,p1[r],p1[r+1]);b=max3f(b,p1[r+2],p1[r+3]);}
  const float m=max2f(a,b);
  auto rr=__builtin_amdgcn_permlane32_swap(__float_as_uint(m),__float_as_uint(m),false,false);
  return max2f(__uint_as_float(rr[0]),__uint_as_float(rr[1]));
}
__device__ __forceinline__ void pv(f32x16*o,int vb,bf16x8 pa0,bf16x8 pa1,bf16x8 pa2,bf16x8 pa3){
  #pragma unroll
  for(int d0=0;d0<2;++d0){s16x4 lo[4],hi[4];
    #pragma unroll
    for(int ks=0;ks<4;++ks){
      asm volatile("ds_read_b64_tr_b16 %0,%1 offset:%c2":"=&v"(lo[ks]):"v"(vb),"i"(d0*4096+ks*1024):"memory");
      asm volatile("ds_read_b64_tr_b16 %0,%1 offset:%c2":"=&v"(hi[ks]):"v"(vb),"i"(d0*4096+ks*1024+512):"memory");}
    asm volatile("s_waitcnt lgkmcnt(0)":::"memory");SBAR();
    #define PK(k) (bf16x8){lo[k][0],lo[k][1],lo[k][2],lo[k][3],hi[k][0],hi[k][1],hi[k][2],hi[k][3]}
    o[d0]=__builtin_amdgcn_mfma_f32_32x32x16_bf16(pa0,PK(0),o[d0],0,0,0);
    o[d0]=__builtin_amdgcn_mfma_f32_32x32x16_bf16(pa1,PK(1),o[d0],0,0,0);
    o[d0]=__builtin_amdgcn_mfma_f32_32x32x16_bf16(pa2,PK(2),o[d0],0,0,0);
    o[d0]=__builtin_amdgcn_mfma_f32_32x32x16_bf16(pa3,PK(3),o[d0],0,0,0);
    #undef PK
  }
}

#ifndef ATTN_STORE16
#define ATTN_STORE16(p,v) (*(u32x4*)(p)=(v))
#endif
template<int THRL> __device__ __forceinline__ void attn_unit(int b,int h,int qb,const bf16*Q,const bf16*__restrict__ K,const bf16*__restrict__ V,bf16*O,const bf16*__restrict__ KX,const float*__restrict__ CK,char*shm){
  int tid_=threadIdx.x; asm volatile("":"+v"(tid_)); const int tid=tid_,lane=tid&63,r32=lane&31,hi=lane>>5; const int wid=__builtin_amdgcn_readfirstlane(tid>>6);
  const long rowbase=(long)b*SEQ; const int q0=qb*QB;
  const bf16*Qw=Q+(rowbase+q0+wid*QBLK)*DM+h*D;
  const bf16*Kh=K+rowbase*DM+h*D,*Vh=V+rowbase*DM+h*D;
  const unsigned lds0=(unsigned)(uintptr_t)shm;
  float*wsf=(float*)(shm+LDS_WS)+wid*64;
  const bf16*ksrc=Kh+(long)lane*DM+wid*8;
  const bf16*vsrc=Vh+(long)(16*(wid&3)+(lane>>2))*DM+(wid>>2)*32+(lane&3)*8;
  const bf16*xsrc=KX+(long)(16*(wid&3)+(lane>>2))*16+(wid>>2)*8+(lane&3)*2;
  const unsigned kdst=lds0+LDS_K+wid*1024, vdst=lds0+LDS_V+wid*1024, xdst=lds0+LDS_X+wid*256;
  #define DMA_K(t,slot) do{ glds16(ksrc+(long)(t)*KVBLK*DM,(unsigned)__builtin_amdgcn_readfirstlane(kdst+(slot))); glds4(xsrc+(long)(t)*KVBLK*16,(unsigned)__builtin_amdgcn_readfirstlane(xdst+((slot)>>2))); }while(0)
  #define DMA_V(t,slot) glds16(vsrc+(long)(t)*KVBLK*DM,(unsigned)__builtin_amdgcn_readfirstlane(vdst+(slot)))
  const int vb0=(int)(lds0+LDS_V)+((lane>>4)&1)*32+(lane&3)*8+(4*hi+((lane&15)>>2))*64;
  const char*Kbase=shm+LDS_K; const char*Xbase=shm+LDS_X; bf16x8 kf[10];
  const lds_cptr shm3=(lds_cptr)shm; const lds_cptr kp0=shm3+LDS_K+hi*1024+r32*16; const lds_cptr xp0=shm3+LDS_X+hi*1024+r32*16; const lds_cptr vp0=shm3+LDS_V+((lane>>4)&1)*32+(lane&3)*8+(4*hi+((lane&15)>>2))*64;
  const int NT=(q0+QB)/KVBLK;
  DMA_K(0,0);DMA_V(0,0);DMA_K(1,SLOTB);
  bf16x8 qr[4];
  #pragma unroll
  for(int d0=0;d0<4;++d0)qr[d0]=*reinterpret_cast<const bf16x8*>(&Qw[(long)r32*DM+d0*16+hi*8]);
  const int qrel=wid*QBLK+r32;
  float mhat=-CK[q0+qrel],l_reg=0.f;f32x16 o[2];o[0]=f32x16{};o[1]=f32x16{};const f32x16 negm=f32x16{};
  bf16x8 qx=mkqx(mhat,hi);
  #define CMASK(P0,P1,t) do{int jb_=(t)-(NT-4); if(jb_>=0)cmask(P0,P1,jb_,qrel,hi);}while(0)
  bool resc=false;
  #define START(P0,P1) do{ const float rm=rowmax(P0,P1); resc=false; \
    { const float dl=rm; mhat=fadd_s(mhat,dl); \
      _Pragma("unroll") for(int r=0;r<16;++r){P0[r]=fsub_s(P0[r],dl);P1[r]=fsub_s(P1[r],dl);} \
      _Pragma("unroll") for(int r=0;r<16;++r)negm[r]=-mhat; asm volatile("":"+v"(negm)); } \
    _Pragma("unroll") for(int r=0;r<16;++r)P0[r]=__builtin_amdgcn_exp2f(P0[r]); }while(0)
  #define RESC() do{ if(resc){ asm volatile("s_waitcnt lgkmcnt(0)":::"memory"); \
      _Pragma("unroll") for(int d_=0;d_<2;++d_) _Pragma("unroll") for(int r=0;r<16;++r)o[d_][r]*=wsf[crow(r,hi)]; } }while(0)
  f32x16 pA0,pA1,pB0,pB1;
  int sl_prev=0,sl_cur=0,sl_next=SLOTB;
  #define ROT() do{sl_prev=sl_cur;sl_cur=sl_next;sl_next=(sl_next==(NSLOT-1)*SLOTB)?0:sl_next+SLOTB;}while(0)
  DMA_K(2,2*SLOTB);
  WAIT_BAR(5);
  qkt(pA0,pA1,Kbase,Xbase,qr,qx,negm,r32,hi);asm volatile("s_nop 15\n\ts_nop 7":"+v"(pA0),"+v"(pA1));CMASK(pA0,pA1,0);
  _Pragma("unroll") for(int r=0;r<16;++r){pA0[r]=__builtin_amdgcn_exp2f(pA0[r]);pA1[r]=__builtin_amdgcn_exp2f(pA1[r]);}
  WAIT_BAR(0);
  DMA_K(3,0);DMA_V(1,SLOTB);
  ROT();
  kload8(kf,kp0+sl_cur); kloadx(kf,xp0+(sl_cur>>2));
  WAIT_BAR(3);
  s16x4 vlo[8],vhi[8]; u32x4 pw0,pw1,pw2,pw3;
  #define PKW(P,B) cvtpk_s(P[B],P[B+1])
  #define PAF(k) __builtin_bit_cast(bf16x8,pw##k)
  #define VFR(i) (bf16x8){vlo[i][0],vlo[i][1],vlo[i][2],vlo[i][3],vhi[i][0],vhi[i][1],vhi[i][2],vhi[i][3]}
  #define PIN(x) asm volatile("":"+v"(x))
  #define MX3(a,b,c) __builtin_fmaxf(__builtin_fmaxf((a),(b)),(c))
  #define GAPA(MF,A0,A1,A2,A3,W0,W1,PW) do{ MF; sacc+=A0; sacc+=A1; sacc+=A2; sacc+=A3; PIN(sacc); W0; W1; PIN(PW); SBAR(); }while(0)
  #define EX(v) __builtin_amdgcn_exp2f(v)
  #define GAPB(MF,X,B) do{ MF; X[B]=EX(X[B]); X[B+1]=EX(X[B+1]); X[B+2]=EX(X[B+2]); X[B+3]=EX(X[B+3]); PIN(X); SBAR(); }while(0)
  #define VRD(i) do{ vlo[i]=vtr(vp_+(((i)>>2)*4096+((i)&3)*1024)); vhi[i]=vtr(vp_+(((i)>>2)*4096+((i)&3)*1024+512)); }while(0)
  #define KRD(G,j) do{ if(G){ kload2(kf,kp0+sl_next,j); if((j)==3) kloadx(kf,xp0+(sl_next>>2)); SBAR(); } }while(0)
  #define STEP(C0,C1,P0,P1,t,GK,GV,GL) do{ SBAR(); \
    const lds_cptr vp_=vp0+sl_prev; \
    VRD(0); SBAR(); float sacc=(P0[0]+P0[1]); \
    GAPA(C0=__builtin_amdgcn_mfma_f32_32x32x16_bf16(kf[0],qr[0],negm,0,0,0), P0[2],P0[3],P0[4],P0[5],     pw0[0]=PKW(P0,0), pw0[1]=PKW(P0,2), pw0); \
    VRD(4); SBAR(); GAPA(C1=__builtin_amdgcn_mfma_f32_32x32x16_bf16(kf[1],qr[0],negm,0,0,0), P0[6],P0[7],P0[8],P0[9],     pw0[2]=PKW(P0,4), pw0[3]=PKW(P0,6), pw0); \
    VRD(1); SBAR(); GAPA(C0=__builtin_amdgcn_mfma_f32_32x32x16_bf16(kf[2],qr[1],C0,0,0,0),   P0[10],P0[11],P0[12],P0[13], pw1[0]=PKW(P0,8), pw1[1]=PKW(P0,10), pw1); \
    VRD(5); SBAR(); GAPA(C1=__builtin_amdgcn_mfma_f32_32x32x16_bf16(kf[3],qr[1],C1,0,0,0),   P0[14],P0[15],P1[0],P1[1],   pw1[2]=PKW(P0,12),pw1[3]=PKW(P0,14), pw1); \
    VRD(2); SBAR(); GAPA(C0=__builtin_amdgcn_mfma_f32_32x32x16_bf16(kf[4],qr[2],C0,0,0,0),   P1[2],P1[3],P1[4],P1[5],     pw2[0]=PKW(P1,0), pw2[1]=PKW(P1,2), pw2); \
    VRD(6); SBAR(); GAPA(C1=__builtin_amdgcn_mfma_f32_32x32x16_bf16(kf[5],qr[2],C1,0,0,0),   P1[6],P1[7],P1[8],P1[9],     pw2[2]=PKW(P1,4), pw2[3]=PKW(P1,6), pw2); \
    VRD(3); SBAR(); GAPA(C0=__builtin_amdgcn_mfma_f32_32x32x16_bf16(kf[6],qr[3],C0,0,0,0),   P1[10],P1[11],P1[12],P1[13], pw3[0]=PKW(P1,8), pw3[1]=PKW(P1,10), pw3); \
    VRD(7); SBAR(); GAPA(C1=__builtin_amdgcn_mfma_f32_32x32x16_bf16(kf[7],qr[3],C1,0,0,0),   P1[14],P1[15],0.f,0.f,       pw3[2]=PKW(P1,12),pw3[3]=PKW(P1,14), pw3); \
    C0=__builtin_amdgcn_mfma_f32_32x32x16_bf16(kf[8],qx,C0,0,0,0); C1=__builtin_amdgcn_mfma_f32_32x32x16_bf16(kf[9],qx,C1,0,0,0); SBAR(); \
    l_reg+=sacc; \
    if(GK){DMA_K((t)+3,sl_cur);} if(GV){DMA_V((t)+1,sl_next);} \
    CMASK(C0,C1,t); \
    { float a=MX3(C0[0],C0[1],C1[0]),b=MX3(C0[2],C0[3],C1[1]); a=MX3(a,C1[2],C1[3]); \
      _Pragma("unroll") for(int r=4;r<16;r+=4){a=MX3(a,C0[r],C0[r+1]);b=MX3(b,C0[r+2],C0[r+3]);a=MX3(a,C1[r],C1[r+1]);b=MX3(b,C1[r+2],C1[r+3]);} \
      float rm=__builtin_fmaxf(a,b); { auto rr=__builtin_amdgcn_permlane32_swap(__float_as_uint(rm),__float_as_uint(rm),false,false); rm=__builtin_fmaxf(__uint_as_float(rr[0]),__uint_as_float(rr[1])); } \
      resc=false; \
      if(__builtin_expect(__any(rm>(float)THRL),0)){ const float dl=__builtin_fmaxf(rm,0.f); mhat+=dl; \
        _Pragma("unroll") for(int r=0;r<16;++r){C0[r]-=dl;C1[r]-=dl;} \
        qx=mkqx(mhat,hi); \
        const float f=__builtin_amdgcn_exp2f(-dl); l_reg*=f; if(hi==0)wsf[r32]=f; resc=true; } } \
    SBAR(); \
    GAPB(o[0]=__builtin_amdgcn_mfma_f32_32x32x16_bf16(PAF(0),VFR(0),o[0],0,0,0), C0,0); \
    GAPB(o[1]=__builtin_amdgcn_mfma_f32_32x32x16_bf16(PAF(0),VFR(4),o[1],0,0,0), C0,4); \
    KRD(GL,0); GAPB(o[0]=__builtin_amdgcn_mfma_f32_32x32x16_bf16(PAF(1),VFR(1),o[0],0,0,0), C0,8); \
    KRD(GL,1); GAPB(o[1]=__builtin_amdgcn_mfma_f32_32x32x16_bf16(PAF(1),VFR(5),o[1],0,0,0), C0,12); \
    KRD(GL,2); GAPB(o[0]=__builtin_amdgcn_mfma_f32_32x32x16_bf16(PAF(2),VFR(2),o[0],0,0,0), C1,0); \
    KRD(GL,3); GAPB(o[1]=__builtin_amdgcn_mfma_f32_32x32x16_bf16(PAF(2),VFR(6),o[1],0,0,0), C1,4); \
    GAPB(o[0]=__builtin_amdgcn_mfma_f32_32x32x16_bf16(PAF(3),VFR(3),o[0],0,0,0), C1,8); \
    GAPB(o[1]=__builtin_amdgcn_mfma_f32_32x32x16_bf16(PAF(3),VFR(7),o[1],0,0,0), C1,12); \
    }while(0)
  int t=1;
  #undef CMASK
  #define CMASK(P0,P1,t) do{}while(0)
  for(;t+5<NT;t+=2){
    STEP(pB0,pB1,pA0,pA1,t,true,true,true);     WAIT_BAR(3); RESC(); ROT();
    STEP(pA0,pA1,pB0,pB1,t+1,true,true,true);   WAIT_BAR(3); RESC(); ROT();
  }
  #undef CMASK
  #define CMASK(P0,P1,t) do{int jb_=(t)-(NT-4); if(jb_>=0)cmask(P0,P1,jb_,qrel,hi);}while(0)
  #define ENDW(tt) do{ if((tt)+3<NT){WAIT_BAR(3);} else if((tt)+2<NT){WAIT_BAR(1);} else {WAIT_BAR(0);} }while(0)
  for(;t+1<NT;t+=2){
    STEP(pB0,pB1,pA0,pA1,t,(t+3<NT),(t+1<NT),(t+1<NT));       ENDW(t);   RESC(); ROT();
    STEP(pA0,pA1,pB0,pB1,t+1,(t+4<NT),(t+2<NT),(t+2<NT));     ENDW(t+1); RESC(); ROT();
  }
  STEP(pB0,pB1,pA0,pA1,NT-1,false,false,false); RESC();
  { float sacc=pB0[0]+pB0[1]; _Pragma("unroll") for(int r=2;r<16;++r)sacc+=pB0[r]; _Pragma("unroll") for(int r=0;r<16;++r)sacc+=pB1[r]; l_reg+=sacc;
    pw0=(u32x4){PKW(pB0,0),PKW(pB0,2),PKW(pB0,4),PKW(pB0,6)};pw1=(u32x4){PKW(pB0,8),PKW(pB0,10),PKW(pB0,12),PKW(pB0,14)};pw2=(u32x4){PKW(pB1,0),PKW(pB1,2),PKW(pB1,4),PKW(pB1,6)};pw3=(u32x4){PKW(pB1,8),PKW(pB1,10),PKW(pB1,12),PKW(pB1,14)};
    SBAR(); pv(o,vb0+sl_cur,PAF(0),PAF(1),PAF(2),PAF(3)); }
  #undef PKW
  #undef PAF
  #undef VFR
  #undef PIN
  #undef MX3
  #undef GAPA
  #undef GAPB
  #undef EX
  #undef VRD
  #undef KRD
  #undef STEP
  #undef ENDW
  {auto rr=__builtin_amdgcn_permlane32_swap(__float_as_uint(l_reg),__float_as_uint(l_reg),false,false);l_reg=__uint_as_float(rr[0])+__uint_as_float(rr[1]);}
  if(hi==0)wsf[32+r32]=l_reg;asm volatile("s_waitcnt lgkmcnt(0)":::"memory");
  float rli[16];
  #pragma unroll
  for(int r=0;r<16;++r)rli[r]=__builtin_amdgcn_rcpf(wsf[32+crow(r,hi)]);
  bf16*Ow=O+(rowbase+q0+wid*QBLK)*DM+h*D;
  { bf16*stg=(bf16*)(shm+LDS_OST)+wid*2048;
    #pragma unroll
    for(int r=0;r<16;++r){const int orow=crow(r,hi);
      #pragma unroll
      for(int d0=0;d0<2;++d0)stg[orow*64+d0*32+r32]=__float2bfloat16(o[d0][r]*rli[r]);}
    asm volatile("s_waitcnt lgkmcnt(0)":::"memory");
    #pragma unroll
    for(int i=0;i<4;++i){const int row=i*8+(lane>>3),ch=lane&7; const u32x4 v=*(const u32x4*)(stg+row*64+ch*8); ATTN_STORE16(Ow+(long)row*DM+ch*8,v);} }
  asm volatile("s_waitcnt lgkmcnt(0)\n\ts_barrier":::"memory");
  #undef DMA_K
  #undef DMA_V
  #undef CMASK
  #undef START
  #undef RESC
  #undef ROT
}
#undef SBAR
#undef WAIT_BAR
}

__device__ __forceinline__ unsigned f2bf(float f) { unsigned u = __builtin_bit_cast(unsigned, f); return (u + 0x7fffu + ((u >> 16) & 1u)) >> 16; }
__device__ __forceinline__ unsigned pk2(float lo, float hi) { return f2bf(lo) | (f2bf(hi) << 16); }
__device__ __forceinline__ void transpose_item(const float* W, int K, int Nsrc, int src_n0, int valid, const float* kscale, bf16_t* WT, int dst_row0, LAS float* scr, int kb, int lane) {
    const int k0 = 64 * kb;
#pragma unroll 8
    for (int i = 0; i < 32; ++i) { const int kk = 2 * i + (lane >> 5), c = lane & 31; float v = (c < valid) ? W[(size_t)(k0 + kk) * Nsrc + src_n0 + c] : 0.f; if (kscale) v *= kscale[k0 + kk]; scr[kk * 33 + c] = v; }
    LDS_WAIT(); asm volatile("" ::: "memory");
    const int c = lane & 7;
#pragma unroll
    for (int j = 0; j < 4; ++j) { const int n = (lane >> 3) + 8 * j; const LAS float* s = scr + (8 * c) * 33 + n;
        u32x4 o; o.x = pk2(s[0 * 33], s[1 * 33]); o.y = pk2(s[2 * 33], s[3 * 33]); o.z = pk2(s[4 * 33], s[5 * 33]); o.w = pk2(s[6 * 33], s[7 * 33]);
        *(u32x4*)(WT + (size_t)(dst_row0 + n) * K + k0 + 8 * c) = o; }
    LDS_WAIT(); asm volatile("" ::: "memory");
}

struct Args { const float* in[28]; float* out; unsigned char* ws; };

__device__ __forceinline__ void s5_tables(const Args& A, int g, int p) {
    const double lre = A.in[11][g * NP + p], lim = A.in[12][g * NP + p], dt = exp((double)A.in[13][g]);
    const double mag = exp(lre * dt); double x = lim * dt;
    const double TWO_PI = 6.283185307179586476925; x -= TWO_PI * rint(x / TWO_PI);
    const double x2 = x * x; double sn = 0.0, cs = 0.0;
#pragma unroll
    for (int k = 14; k >= 0; --k) { sn = sn * x2 * (-1.0 / ((2.0 * k + 2.0) * (2.0 * k + 3.0))) + 1.0; cs = cs * x2 * (-1.0 / ((2.0 * k + 1.0) * (2.0 * k + 2.0))) + 1.0; }
    sn *= x;
    const double ar = mag * cs, ai = mag * sn;
    const double den = lre * lre + lim * lim, nr = ar - 1.0;
    const double zr = (nr * lre + ai * lim) / den, zi = (ai * lre - nr * lim) / den;
    unsigned char* ws = A.ws;
    float* abar = (float*)(ws + WS_ABAR); float* a16 = (float*)(ws + WS_A16); float* a64 = (float*)(ws + WS_A64);
    abar[(g * NP + p) * 2] = (float)ar; abar[(g * NP + p) * 2 + 1] = (float)ai;
    double pr = ar, pi = ai;
#pragma unroll
    for (int s = 0; s < 4; ++s) { const double t = pr * pr - pi * pi; pi = 2.0 * pr * pi; pr = t; }
    a16[(g * NP + p) * 2] = (float)pr; a16[(g * NP + p) * 2 + 1] = (float)pi;
#pragma unroll
    for (int s = 0; s < 2; ++s) { const double t = pr * pr - pi * pi; pi = 2.0 * pr * pi; pr = t; }
    a64[(g * NP + p) * 2] = (float)pr; a64[(g * NP + p) * 2 + 1] = (float)pi;
    bf16_t* bbT = (bf16_t*)(ws + WS_BBT); bf16_t* cmT = (bf16_t*)(ws + WS_CMT);
    const int pb = p >> 5, pp = p & 31;
    const float* bre = A.in[14] + ((size_t)g * NP + p) * 16; const float* bim = A.in[15] + ((size_t)g * NP + p) * 16;
#pragma unroll
    for (int h = 0; h < 16; ++h) {
        const double br = bre[h], bi = bim[h];
        const float vr = (float)(zr * br - zi * bi), vi = (float)(zr * bi + zi * br);
        const int ln = pp + 32 * (h >> 3), i = h & 7;
        bbT[(((size_t)g * 4 + pb) * 64 + ln) * 8 + i] = (bf16_t)f2bf(vr);
        bbT[(((size_t)g * 4 + pb + 2) * 64 + ln) * 8 + i] = (bf16_t)f2bf(vi);
        const float cr = A.in[16][((size_t)g * 16 + h) * NP + p], ci = A.in[17][((size_t)g * 16 + h) * NP + p];
        const int ks = pp >> 4, l2 = h + 16 * ((pp & 15) >> 2), i2 = 2 * (pp & 3);
        cmT[((((size_t)g * 2 + pb) * 2 + ks) * 64 + l2) * 8 + i2] = (bf16_t)f2bf(cr);
        cmT[((((size_t)g * 2 + pb) * 2 + ks) * 64 + l2) * 8 + i2 + 1] = (bf16_t)f2bf(-ci);
    }
}

__device__ __forceinline__ const float* xrow_ptr(const Args& A, int row) { return row < MP ? A.in[0] + (size_t)row * DM : A.in[1] + (size_t)(row - MP) * DM; }

template <int PASS> __device__ __forceinline__ void s5_item(const Args& A, int item, int g, LAS unsigned char* sbuf  , int lane) {
    unsigned char* ws = A.ws;
    const bool samp = item >= NB * NCH; const int n = item / NCH, c = item % NCH, b = item - NB * NCH;
    const int row0 = samp ? MP + 64 * b : n * SEQ + 64 * c;
    const float* ir0 = (const float*)(ws + WS_IR0);
    const float* gm = A.in[8];
    const int n32 = lane & 31, hh = lane >> 5;
    bf16x8 ua[2];
    {
        const int tp = 16 * ((n32 >> 2) & 1) + 4 * (n32 >> 3) + (n32 & 3);
        const f32x4 g0 = *(const f32x4*)(gm + 16 * g + 8 * hh), g1 = *(const f32x4*)(gm + 16 * g + 8 * hh + 4);
#pragma unroll
        for (int tb = 0; tb < 2; ++tb) { const int row = row0 + 32 * tb + tp; const float* xp = xrow_ptr(A, row) + 16 * g + 8 * hh; const float rs = ir0[row];
            const f32x4 x0 = *(const f32x4*)xp * rs * g0, x1 = *(const f32x4*)(xp + 4) * rs * g1;
            u32x4 w; w.x = cvt_pk_bf16(x0[0], x0[1]); w.y = cvt_pk_bf16(x0[2], x0[3]); w.z = cvt_pk_bf16(x1[0], x1[1]); w.w = cvt_pk_bf16(x1[2], x1[3]); ua[tb] = __builtin_bit_cast(bf16x8, w); }
    }
    float hin_r = 0.f, hin_i = 0.f;
    if (PASS == 2) {
        if (samp) { hin_r = A.in[2][((size_t)b * NG + g) * NP + lane]; hin_i = A.in[3][((size_t)b * NG + g) * NP + lane]; }
        else {
            const f32x2 a64 = *(const f32x2*)(ws + WS_A64 + ((size_t)(g * NP + lane)) * 8);
            const float* e1 = (const float*)(ws + WS_E1) + (((size_t)(n * NCH) * NG + g) * NP + lane) * 2;
            int cc = 0;
            for (; cc + 16 <= c; cc += 16) { f32x2 e[16];
#pragma unroll
                for (int k = 0; k < 16; ++k) e[k] = *(const f32x2*)(e1 + (size_t)(cc + k) * NG * NP * 2);
#pragma unroll
                for (int k = 0; k < 16; ++k) { const float tr = a64.x * hin_r - a64.y * hin_i + e[k].x; hin_i = a64.x * hin_i + a64.y * hin_r + e[k].y; hin_r = tr; } }
            for (; cc < c; ++cc) { const f32x2 e = *(const f32x2*)(e1 + (size_t)cc * NG * NP * 2);
                const float tr = a64.x * hin_r - a64.y * hin_i + e.x; hin_i = a64.x * hin_i + a64.y * hin_r + e.y; hin_r = tr; }
        }
    }
    f32x4 yacc[4] = {(f32x4){0, 0, 0, 0}, (f32x4){0, 0, 0, 0}, (f32x4){0, 0, 0, 0}, (f32x4){0, 0, 0, 0}};
    const bf16_t* bbT = (const bf16_t*)(ws + WS_BBT); const bf16_t* cmT = (const bf16_t*)(ws + WS_CMT);
#pragma unroll 1
    for (int pb = 0; pb < 2; ++pb) {
        const int p = 32 * pb + n32;
        const bf16x8 Bre = *(const bf16x8*)(bbT + (((size_t)g * 4 + pb) * 64 + lane) * 8), Bim = *(const bf16x8*)(bbT + (((size_t)g * 4 + pb + 2) * 64 + lane) * 8);
        f32x16 xr[2], xi[2];
        const f32x16 z16 = f32x16{};
#pragma unroll
        for (int tb = 0; tb < 2; ++tb) { xr[tb] = __builtin_amdgcn_mfma_f32_32x32x16_bf16(ua[tb], Bre, z16, 0, 0, 0); xi[tb] = __builtin_amdgcn_mfma_f32_32x32x16_bf16(ua[tb], Bim, z16, 0, 0, 0); }
        const f32x2 ab = *(const f32x2*)(ws + WS_ABAR + ((size_t)(g * NP + p)) * 8), a16 = *(const f32x2*)(ws + WS_A16 + ((size_t)(g * NP + p)) * 8);
        const float ar = ab.x, ai = ab.y;
#pragma unroll
        for (int tb = 0; tb < 2; ++tb)
#pragma unroll
            for (int r = 1; r < 16; ++r) { const float pr = xr[tb][r - 1], pi = xi[tb][r - 1];
                xr[tb][r] += ar * pr - ai * pi; xi[tb][r] += ar * pi + ai * pr; }
        float H_r = __shfl(hin_r, p), H_i = __shfl(hin_i, p);
        float Hs_r[2], Hs_i[2];
#pragma unroll
        for (int tb = 0; tb < 2; ++tb) {
            const float er = xr[tb][15], ei = xi[tb][15];
            const float or_ = __shfl_xor(er, 32), oi_ = __shfl_xor(ei, 32);
            const float e0r = hh ? or_ : er, e0i = hh ? oi_ : ei, e1r = hh ? er : or_, e1i = hh ? ei : oi_;
            const float h0r = H_r, h0i = H_i;
            const float h1r = a16.x * h0r - a16.y * h0i + e0r, h1i = a16.x * h0i + a16.y * h0r + e0i;
            const float h2r = a16.x * h1r - a16.y * h1i + e1r, h2i = a16.x * h1i + a16.y * h1r + e1i;
            Hs_r[tb] = hh ? h1r : h0r; Hs_i[tb] = hh ? h1i : h0i;
            H_r = h2r; H_i = h2i;
        }
        if (PASS == 1) {
            if (hh == 0) { float* e1 = (float*)(ws + WS_E1) + (((size_t)item * NG + g) * NP + p) * 2; *(f32x2*)e1 = (f32x2){H_r, H_i}; }
        } else {
            if (samp || c == NCH - 1) { if (hh == 0) { const size_t o = samp ? ((size_t)b * NG + g) * NP + p : ((size_t)n * NG + g) * NP + p;
                A.out[(samp ? O_SRE_S : O_SRE_P) + o] = H_r; A.out[(samp ? O_SIM_S : O_SIM_P) + o] = H_i; } }
#pragma unroll
            for (int tb = 0; tb < 2; ++tb) { float cr = Hs_r[tb], ci = Hs_i[tb];
#pragma unroll
                for (int r = 0; r < 16; ++r) { const float t = ar * cr - ai * ci; ci = ar * ci + ai * cr; cr = t;
                    const float sr = xr[tb][r] + cr, si = xi[tb][r] + ci;
                    LAS unsigned* rowp = (LAS unsigned*)(sbuf + (32 * tb + 16 * hh + r) * 144);
                    rowp[n32] = cvt_pk_bf16(sr, si); } }
            LDS_WAIT(); asm volatile("" ::: "memory");
#pragma unroll
            for (int ks = 0; ks < 2; ++ks) { const bf16x8 Bc = *(const bf16x8*)(cmT + ((((size_t)g * 2 + pb) * 2 + ks) * 64 + lane) * 8);
#pragma unroll
                for (int t4 = 0; t4 < 4; ++t4) { const bf16x8 Af = *(const LAS bf16x8*)(sbuf + (16 * t4 + (lane & 15)) * 144 + ks * 64 + (lane >> 4) * 16);
                    yacc[t4] = __builtin_amdgcn_mfma_f32_16x16x32_bf16(Af, Bc, yacc[t4], 0, 0, 0); } }
            LDS_WAIT(); asm volatile("" ::: "memory");
        }
    }
    if (PASS == 2) {
        const int h = lane & 15, ch = 16 * g + h; const float dsk = A.in[18][ch], gmh = gm[ch];
        bf16_t* G = (bf16_t*)(ws + WS_G);
#pragma unroll
        for (int t4 = 0; t4 < 4; ++t4)
#pragma unroll
            for (int r = 0; r < 4; ++r) { const int row = row0 + 16 * t4 + 4 * (lane >> 4) + r;
                const float u = xrow_ptr(A, row)[ch] * ir0[row] * gmh; const float v = yacc[t4][r] + dsk * u;
                G[(size_t)row * DM + ch] = (bf16_t)f2bf(gelu_tanh(v)); }
    }
}

#ifndef PHM
#define PHM 2047
#endif
constexpr int LDS_BYTES = 147456;
constexpr int XCH_OFF = 131072;

__device__ __forceinline__ Args ldargs() {
#if defined(__HIP_DEVICE_COMPILE__)
    const __attribute__((address_space(4))) Args* p = (const __attribute__((address_space(4))) Args*)__builtin_amdgcn_kernarg_segment_ptr(); asm volatile("" : "+s"(p)); return *p;
#else
    return Args{};
#endif
}
#define PHASE_ARGS const Args A = ldargs(); unsigned char* const ws = A.ws; float* const sumsq = (float*)(ws + WS_SS); float* const X = (float*)(ws + WS_X); bf16_t* const XB = (bf16_t*)(ws + WS_XB); \
    int tid_p = threadIdx.x; asm volatile("" : "+v"(tid_p)); const int tid = tid_p, lane = tid & 63, wave = __builtin_amdgcn_readfirstlane(tid >> 6); const int gw = bx * 8 + wave; \
    (void)sumsq; (void)X; (void)XB; (void)lane; (void)gw; (void)ws
__global__ void __launch_bounds__(512, 2) fwd_mega(Args Aparam) {
    extern __shared__ __attribute__((aligned(16))) unsigned char lds[];
    cg::grid_group grid = cg::this_grid();
    LAS unsigned char* L = (LAS unsigned char*)lds;
    const int G = gridDim.x, bx = blockIdx.x, NGW = G * 8;

    volatile LAS unsigned long long* TS = (volatile LAS unsigned long long*)(L + 140000);
    int n_ts = 0;
#ifdef PROBE_A
#define STAMP() do { if (threadIdx.x == 0) TS[n_ts] = __builtin_amdgcn_s_memrealtime(); ++n_ts; } while (0)
#else
#define STAMP() do { (void)TS; (void)n_ts; } while (0)
#endif
    STAMP();
    if (PHM & 1) { PHASE_ARGS;
        for (int i = bx * 512 + tid; i < 4 * MT; i += G * 512) sumsq[i] = 0.f;
        if (bx == 0 && tid < 128) ((unsigned*)(ws + WS_CNT))[tid] = 0u;
        LAS float* scr = (LAS float*)(L + wave * 16384);
        constexpr int I_GLU = 16 * 64, I_UG = 16 * 176, I_DN = 44 * 32, I_QKV = 16 * 104, I_WO = 16 * 32;
        constexpr int NW_ITEMS = I_GLU + 2 * I_UG + 2 * I_DN + I_QKV + I_WO;
        for (int it = gw; it < NW_ITEMS; it += NGW) {
            int r = it;
            if (r < I_GLU) { const int kb = r / 64, nb = r % 64, pn = nb >> 3, j = nb & 7; const int src = j < 4 ? 128 * pn + 32 * j : 1024 + 128 * pn + 32 * (j - 4);
                transpose_item(A.in[19], DM, 2048, src, 32, nullptr, (bf16_t*)(ws + WS_WGLU), 32 * nb, scr, kb, lane); continue; } r -= I_GLU;
            if (r < 2 * I_UG) { const int l = r / I_UG; r %= I_UG; const int kb = r / 176, nb = r % 176, pn = nb >> 3, j = nb & 7;
                const float* W = (j < 4 ? A.in[23] : A.in[24]) + (size_t)l * DM * FF; const int src = 128 * pn + 32 * (j & 3);
                transpose_item(W, DM, FF, src, 32, A.in[9] + l * DM, (bf16_t*)(ws + WS_WUG) + (size_t)l * 5632 * DM, 32 * nb, scr, kb, lane); continue; } r -= 2 * I_UG;
            if (r < 2 * I_DN) { const int l = r / I_DN; r %= I_DN; const int kb = r / 32, nb = r % 32;
                transpose_item(A.in[27] + (size_t)l * FF * DM, FF, DM, 32 * nb, 32, nullptr, (bf16_t*)(ws + WS_WDN) + (size_t)l * DM * FF, 32 * nb, scr, kb, lane); continue; } r -= 2 * I_DN;
            if (r < I_QKV) { const int kb = r / 104, nb = r % 104; int valid = 3088 - 32 * nb; valid = valid < 0 ? 0 : (valid > 32 ? 32 : valid);
                transpose_item(A.in[20], DM, 3088, 32 * nb, valid, A.in[8] + DM, (bf16_t*)(ws + WS_WQKV), 32 * nb, scr, kb, lane); continue; } r -= I_QKV;
            { const int kb = r / 32, nb = r % 32; transpose_item(A.in[22], DM, DM, 32 * nb, 32, nullptr, (bf16_t*)(ws + WS_WO), 32 * nb, scr, kb, lane); }
        }
        for (int g = gw; g < NG; g += NGW) s5_tables(A, g, lane);
        float* ir0 = (float*)(ws + WS_IR0);
        for (int m = gw; m < MT; m += NGW) { const f32x4* xr = (const f32x4*)xrow_ptr(A, m) + lane; float s = 0.f;
#pragma unroll
            for (int j = 0; j < 4; ++j) { const f32x4 v = xr[64 * j]; s += (v.x * v.x + v.y * v.y) + (v.z * v.z + v.w * v.w); }
            s = wave_sum(s); if (lane == 0) ir0[m] = __builtin_amdgcn_rsqf(s * (1.0f / DM) + EPS); }
    }
    grid.sync(); STAMP();

    if (PHM & 2) { PHASE_ARGS;
        LAS unsigned char* sbuf = L + wave * 9216;
        for (int it = gw; it < NB * NCH * NG; it += NGW) { const int item = it / NG, g = it % NG; if ((item % NCH) == NCH - 1) continue; s5_item<1>(A, item, g, sbuf, lane); }
    }
    grid.sync(); STAMP();
    if (PHM & 4) { PHASE_ARGS;
        LAS unsigned char* sbuf = L + wave * 9216;
        for (int it = gw; it < NITEM * NG; it += NGW) { const int item = it / NG, g = it % NG; s5_item<2>(A, item, g, sbuf, lane); }
    }
    grid.sync(); STAMP();

    if (PHM & 8) { PHASE_ARGS;
        pg8::Gemm g{(const bf16_t*)(ws + WS_G), (const bf16_t*)(ws + WS_WGLU), DM, 16}; pg8::Order<false> S; S.init(MT / 256, 8, G, bx);
        EpiRes<1, true, true, false> E{A.in[0], A.in[1], X, XB, sumsq};
        pg8::gemm_phase(L, g, S, E);
    }
    grid.sync(); STAMP();

    { constexpr int layer = 0;
        if (layer == 1) {
            if (PHM & 16) { PHASE_ARGS;
                pg8::Gemm g{XB, (const bf16_t*)(ws + WS_WQKV), DM, 16}; pg8::Order<false> S; S.init(MT / 256, 13, G, bx);
                EpiQKV E{sumsq + 1 * MT, A.in[21], (bf16_t*)(ws + WS_Q), (bf16_t*)(ws + WS_KP), (bf16_t*)(ws + WS_VP), (bf16_t*)(ws + WS_KS), (bf16_t*)(ws + WS_VS), A.out};
                pg8::gemm_phase(L, g, S, E);
            }
            grid.sync(); STAMP();
            if (PHM & 32) { PHASE_ARGS;
                float* ckp = (float*)(ws + WS_CKP); float* cks = (float*)(ws + WS_CKS);
                for (int it = gw; it < 64 * 8 + 256 * 5; it += NGW) {
                    const bool sm = it >= 512; const int seq = sm ? (it - 512) / 5 : it / 8, ch = sm ? (it - 512) % 5 : it % 8;
                    const int len = sm ? KALL : SEQ; const int bb = seq >> 4, h = seq & 15;
                    auto ld = [&](int j) -> float { if (j >= len) return 0.f; if (!sm) return A.out[O_LF_P + ((size_t)bb * SEQ + j) * NH + h];
                        return j < PAST ? A.in[6][((size_t)bb * PAST + j) * NH + h] : A.out[O_LF_S + ((size_t)bb * SS + (j - PAST)) * NH + h]; };
                    float pre = 0.f;
                    for (int cc = 0; cc < ch; ++cc) {
#pragma unroll
                        for (int j = 0; j < 16; ++j) pre += ld(cc * 1024 + lane * 16 + j);
                    }
                    pre = wave_sum(pre);
                    float v[16]; float tot = 0.f;
#pragma unroll
                    for (int j = 0; j < 16; ++j) { tot += ld(ch * 1024 + lane * 16 + j); v[j] = tot; }
                    float sc = tot;
#pragma unroll
                    for (int o = 1; o < 64; o <<= 1) { const float t = __shfl_up(sc, o); if (lane >= o) sc += t; }
                    const float base = pre + (sc - tot);
                    float* dst = (sm ? cks + (size_t)seq * KALL : ckp + (size_t)seq * SEQ) + ch * 1024 + lane * 16;
#pragma unroll
                    for (int j = 0; j < 16; ++j) if (ch * 1024 + lane * 16 + j < len) dst[j] = (base + v[j]) * LOG2E;
                    if (!sm) { u32x4* kx = (u32x4*)((bf16_t*)(ws + WS_KX) + ((size_t)seq * SEQ + ch * 1024 + lane * 16) * 16);
#pragma unroll
                        for (int j = 0; j < 16; ++j) { const float nv = -(base + v[j]) * LOG2E; const unsigned h1 = f2bf(nv); const float r1 = nv - __uint_as_float(h1 << 16);
                            const unsigned h2 = f2bf(r1); const float r2 = r1 - __uint_as_float(h2 << 16); const unsigned h3 = f2bf(r2);
                            kx[2 * j] = (u32x4){h1 | (h2 << 16), h3 | 0x3f800000u, 0x3f803f80u, 0u}; kx[2 * j + 1] = (u32x4){0u, 0u, 0u, 0u}; } }
                }
            }
            grid.sync(); STAMP();
            if (PHM & 64) { PHASE_ARGS;
                const bf16_t* Q = (const bf16_t*)(ws + WS_Q); bf16_t* O = (bf16_t*)(ws + WS_Q);
                const bf16_t* Kp = (const bf16_t*)(ws + WS_KP); const bf16_t* Vp = (const bf16_t*)(ws + WS_VP);
                const bf16_t* Ks = (const bf16_t*)(ws + WS_KS); const bf16_t* Vs = (const bf16_t*)(ws + WS_VS);
                const float* ckp = (const float*)(ws + WS_CKP); const float* cks = (const float*)(ws + WS_CKS);
                for (int idx = bx; idx < 9 * 256; idx += G) {
                    const int i = idx >> 8, v = idx & 255;
                    if (i < 8) { const int bh = v >> 2, s = v & 3, b = bh >> 4, h = bh & 15; const int qb = (i & 1) ? (8 * (i >> 1) + 7 - s) : (8 * (i >> 1) + s);
                        const size_t r0 = (size_t)b * SEQ;
                        atf::attn_unit<8>(b, h, qb, (const atf::bf16*)Q, (const atf::bf16*)Kp, (const atf::bf16*)Vp, (atf::bf16*)O, (const atf::bf16*)(ws + WS_KX) + (size_t)bh * SEQ * 16, ckp + (size_t)bh * SEQ, (char*)lds); (void)r0;
                    } else { const int b = v >> 4, h = v & 15;
                        att::attn_unit_sample((char*)lds, Q + ((size_t)MP + 64 * b) * DM + h * HD, A.in[4] + (size_t)b * PAST * DM + h * HD, A.in[5] + (size_t)b * PAST * DM + h * HD,
                                              A.out + O_K_S + (size_t)b * SS * DM + h * HD, A.out + O_V_S + (size_t)b * SS * DM + h * HD, O + ((size_t)MP + 64 * b) * DM + h * HD, cks + (size_t)v * KALL);
                    }
                }
            }
            grid.sync(); STAMP();
            if (PHM & 128) { PHASE_ARGS;
                pg8::Gemm g{(const bf16_t*)(ws + WS_Q), (const bf16_t*)(ws + WS_WO), DM, 16}; pg8::Order<false> S; S.init(MT / 256, 4, G, bx);
                EpiRes<0, false, true, false> E{X, X + (size_t)MP * DM, X, XB, sumsq + 2 * MT};
                pg8::gemm_phase(L, g, S, E);
            }
            grid.sync(); STAMP();
        }
        if (PHM & 256) { PHASE_ARGS;
            pg8::Gemm g{XB, (const bf16_t*)(ws + WS_WUG) + (size_t)layer * 5632 * DM, DM, 16}; pg8::Order<true> S; S.init(136, 22, G, bx);
            EpiConv E{(bf16_t*)(ws + WS_H), sumsq + (layer == 0 ? 0 : 2 * MT), A.in[25] + (size_t)layer * 3 * FF, A.in[26] + (size_t)layer * FF, A.in[7] + (size_t)layer * SB * 2 * FF,
                      A.out + O_CV_P + (size_t)layer * NB * 2 * FF, A.out + O_CV_S + (size_t)layer * SB * 2 * FF, (LAS float*)(L + XCH_OFF)};
            pg8::gemm_phase(L, g, S, E);
        }
        grid.sync(); STAMP();
        if (PHM & 512) { PHASE_ARGS;
            pg8::Gemm g{(const bf16_t*)(ws + WS_H), (const bf16_t*)(ws + WS_WDN) + (size_t)layer * DM * FF, FF, 44}; pg8::Order<false> S; S.init(MP / 256, 4, G, bx);
            pg8::Gemm gt{g.A, g.Bt, FF, 4}; pg8::OrderTail<MP / 256, 4, 4, 11> St{G, bx};
            if (layer == 0) { EpiRes<0, false, true, false> E{X, X + (size_t)MP * DM, X, XB, sumsq + 1 * MT}; pg8::gemm_phase(L, g, S, E);
                EpiSplitK<EpiRes<0, false, true, false>, 11, 4, MP / 256, WS_PDN0, 64> Et{E, ws}; pg8::gemm_phase(L, gt, St, Et); }
            else { EpiRes<0, false, false, true> E{X, X + (size_t)MP * DM, X, XB, sumsq + 3 * MT}; pg8::gemm_phase(L, g, S, E);
                EpiSplitK<EpiRes<0, false, false, true>, 11, 4, MP / 256, WS_PDN1, 96> Et{E, ws}; pg8::gemm_phase(L, gt, St, Et); }
        }
        grid.sync(); STAMP();
        }
    { constexpr int layer = 1;
        if (layer == 1) {
            if (PHM & 16) { PHASE_ARGS;
                pg8::Gemm g{XB, (const bf16_t*)(ws + WS_WQKV), DM, 16}; pg8::Order<false> S; S.init(MT / 256, 13, G, bx);
                EpiQKV E{sumsq + 1 * MT, A.in[21], (bf16_t*)(ws + WS_Q), (bf16_t*)(ws + WS_KP), (bf16_t*)(ws + WS_VP), (bf16_t*)(ws + WS_KS), (bf16_t*)(ws + WS_VS), A.out};
                pg8::gemm_phase(L, g, S, E);
            }
            grid.sync(); STAMP();
            if (PHM & 32) { PHASE_ARGS;
                float* ckp = (float*)(ws + WS_CKP); float* cks = (float*)(ws + WS_CKS);
                for (int it = gw; it < 64 * 8 + 256 * 5; it += NGW) {
                    const bool sm = it >= 512; const int seq = sm ? (it - 512) / 5 : it / 8, ch = sm ? (it - 512) % 5 : it % 8;
                    const int len = sm ? KALL : SEQ; const int bb = seq >> 4, h = seq & 15;
                    auto ld = [&](int j) -> float { if (j >= len) return 0.f; if (!sm) return A.out[O_LF_P + ((size_t)bb * SEQ + j) * NH + h];
                        return j < PAST ? A.in[6][((size_t)bb * PAST + j) * NH + h] : A.out[O_LF_S + ((size_t)bb * SS + (j - PAST)) * NH + h]; };
                    float pre = 0.f;
                    for (int cc = 0; cc < ch; ++cc) {
#pragma unroll
                        for (int j = 0; j < 16; ++j) pre += ld(cc * 1024 + lane * 16 + j);
                    }
                    pre = wave_sum(pre);
                    float v[16]; float tot = 0.f;
#pragma unroll
                    for (int j = 0; j < 16; ++j) { tot += ld(ch * 1024 + lane * 16 + j); v[j] = tot; }
                    float sc = tot;
#pragma unroll
                    for (int o = 1; o < 64; o <<= 1) { const float t = __shfl_up(sc, o); if (lane >= o) sc += t; }
                    const float base = pre + (sc - tot);
                    float* dst = (sm ? cks + (size_t)seq * KALL : ckp + (size_t)seq * SEQ) + ch * 1024 + lane * 16;
#pragma unroll
                    for (int j = 0; j < 16; ++j) if (ch * 1024 + lane * 16 + j < len) dst[j] = (base + v[j]) * LOG2E;
                    if (!sm) { u32x4* kx = (u32x4*)((bf16_t*)(ws + WS_KX) + ((size_t)seq * SEQ + ch * 1024 + lane * 16) * 16);
#pragma unroll
                        for (int j = 0; j < 16; ++j) { const float nv = -(base + v[j]) * LOG2E; const unsigned h1 = f2bf(nv); const float r1 = nv - __uint_as_float(h1 << 16);
                            const unsigned h2 = f2bf(r1); const float r2 = r1 - __uint_as_float(h2 << 16); const unsigned h3 = f2bf(r2);
                            kx[2 * j] = (u32x4){h1 | (h2 << 16), h3 | 0x3f800000u, 0x3f803f80u, 0u}; kx[2 * j + 1] = (u32x4){0u, 0u, 0u, 0u}; } }
                }
            }
            grid.sync(); STAMP();
            if (PHM & 64) { PHASE_ARGS;
                const bf16_t* Q = (const bf16_t*)(ws + WS_Q); bf16_t* O = (bf16_t*)(ws + WS_Q);
                const bf16_t* Kp = (const bf16_t*)(ws + WS_KP); const bf16_t* Vp = (const bf16_t*)(ws + WS_VP);
                const bf16_t* Ks = (const bf16_t*)(ws + WS_KS); const bf16_t* Vs = (const bf16_t*)(ws + WS_VS);
                const float* ckp = (const float*)(ws + WS_CKP); const float* cks = (const float*)(ws + WS_CKS);
                for (int idx = bx; idx < 9 * 256; idx += G) {
                    const int i = idx >> 8, v = idx & 255;
                    if (i < 8) { const int bh = v >> 2, s = v & 3, b = bh >> 4, h = bh & 15; const int qb = (i & 1) ? (8 * (i >> 1) + 7 - s) : (8 * (i >> 1) + s);
                        const size_t r0 = (size_t)b * SEQ;
                        atf::attn_unit<8>(b, h, qb, (const atf::bf16*)Q, (const atf::bf16*)Kp, (const atf::bf16*)Vp, (atf::bf16*)O, (const atf::bf16*)(ws + WS_KX) + (size_t)bh * SEQ * 16, ckp + (size_t)bh * SEQ, (char*)lds); (void)r0;
                    } else { const int b = v >> 4, h = v & 15;
                        att::attn_unit_sample((char*)lds, Q + ((size_t)MP + 64 * b) * DM + h * HD, A.in[4] + (size_t)b * PAST * DM + h * HD, A.in[5] + (size_t)b * PAST * DM + h * HD,
                                              A.out + O_K_S + (size_t)b * SS * DM + h * HD, A.out + O_V_S + (size_t)b * SS * DM + h * HD, O + ((size_t)MP + 64 * b) * DM + h * HD, cks + (size_t)v * KALL);
                    }
                }
            }
            grid.sync(); STAMP();
            if (PHM & 128) { PHASE_ARGS;
                pg8::Gemm g{(const bf16_t*)(ws + WS_Q), (const bf16_t*)(ws + WS_WO), DM, 16}; pg8::Order<false> S; S.init(MT / 256, 4, G, bx);
                EpiRes<0, false, true, false> E{X, X + (size_t)MP * DM, X, XB, sumsq + 2 * MT};
                pg8::gemm_phase(L, g, S, E);
            }
            grid.sync(); STAMP();
        }
        if (PHM & 256) { PHASE_ARGS;
            pg8::Gemm g{XB, (const bf16_t*)(ws + WS_WUG) + (size_t)layer * 5632 * DM, DM, 16}; pg8::Order<true> S; S.init(136, 22, G, bx);
            EpiConv E{(bf16_t*)(ws + WS_H), sumsq + (layer == 0 ? 0 : 2 * MT), A.in[25] + (size_t)layer * 3 * FF, A.in[26] + (size_t)layer * FF, A.in[7] + (size_t)layer * SB * 2 * FF,
                      A.out + O_CV_P + (size_t)layer * NB * 2 * FF, A.out + O_CV_S + (size_t)layer * SB * 2 * FF, (LAS float*)(L + XCH_OFF)};
            pg8::gemm_phase(L, g, S, E);
        }
        grid.sync(); STAMP();
        if (PHM & 512) { PHASE_ARGS;
            pg8::Gemm g{(const bf16_t*)(ws + WS_H), (const bf16_t*)(ws + WS_WDN) + (size_t)layer * DM * FF, FF, 44}; pg8::Order<false> S; S.init(MP / 256, 4, G, bx);
            pg8::Gemm gt{g.A, g.Bt, FF, 4}; pg8::OrderTail<MP / 256, 4, 4, 11> St{G, bx};
            if (layer == 0) { EpiRes<0, false, true, false> E{X, X + (size_t)MP * DM, X, XB, sumsq + 1 * MT}; pg8::gemm_phase(L, g, S, E);
                EpiSplitK<EpiRes<0, false, true, false>, 11, 4, MP / 256, WS_PDN0, 64> Et{E, ws}; pg8::gemm_phase(L, gt, St, Et); }
            else { EpiRes<0, false, false, true> E{X, X + (size_t)MP * DM, X, XB, sumsq + 3 * MT}; pg8::gemm_phase(L, g, S, E);
                EpiSplitK<EpiRes<0, false, false, true>, 11, 4, MP / 256, WS_PDN1, 96> Et{E, ws}; pg8::gemm_phase(L, gt, St, Et); }
        }
        grid.sync(); STAMP();
        }
    if (PHM & 1024) { PHASE_ARGS;
        const float* gf = A.in[10]; const float* ssq = sumsq + 3 * MT;
        for (int m = gw; m < MT; m += NGW) { const float rs = __builtin_amdgcn_rsqf(ssq[m] * (1.0f / DM) + EPS);
            const f32x4* xr = (const f32x4*)(X + (size_t)m * DM) + lane; f32x4* o = (f32x4*)(A.out + O_Y + (size_t)m * DM) + lane; const f32x4* gg = (const f32x4*)gf + lane;
#pragma unroll
            for (int j = 0; j < 4; ++j) o[64 * j] = xr[64 * j] * rs * gg[64 * j]; }
    }
#ifdef PROBE_A
    STAMP();
    if (bx == 0 && threadIdx.x == 0) { const unsigned long long dt = TS[PROBE_B] - TS[PROBE_A], t0 = __builtin_amdgcn_s_memrealtime(); while (__builtin_amdgcn_s_memrealtime() - t0 < dt) __builtin_amdgcn_s_sleep(8); }
#endif
}

extern "C" void kernel_launch(void* const* d_in, const int* in_sizes, int n_in, void* d_out, int out_size, void* d_ws, size_t ws_size, hipStream_t stream) {
    static int grid = 0;
    if (grid == 0) {
        int dev = 0, cus = 0, per_cu = 0;
        hipGetDevice(&dev); hipDeviceGetAttribute(&cus, hipDeviceAttributeMultiprocessorCount, dev);
        hipFuncSetAttribute((const void*)fwd_mega, hipFuncAttributeMaxDynamicSharedMemorySize, LDS_BYTES);
        hipOccupancyMaxActiveBlocksPerMultiprocessor(&per_cu, (const void*)fwd_mega, 512, LDS_BYTES);
        if (per_cu < 1) per_cu = 1;
        grid = cus * 1;
        if (grid <= 0) grid = 256;
    }
    Args a{};
    for (int i = 0; i < 28; ++i) a.in[i] = (const float*)d_in[i];
    a.out = (float*)d_out; a.ws = (unsigned char*)d_ws;
    void* args[] = {&a};
    hipError_t e = hipLaunchCooperativeKernel((const void*)fwd_mega, dim3(grid), dim3(512), args, LDS_BYTES, stream);
    if (e != hipSuccess) fprintf(stderr, "cooperative launch failed: %s (grid %d)\n", hipGetErrorString(e), grid);
}
```

```cpp
#include <hip/hip_runtime.h>
#include <hip/hip_cooperative_groups.h>
#include <hip/hip_bf16.h>
#include <cstdint>
#include <cstdio>
namespace cg = cooperative_groups;

#define LAS __attribute__((address_space(3)))
typedef unsigned short bf16_t;
typedef short bf16x8 __attribute__((ext_vector_type(8)));
typedef short s16x4 __attribute__((ext_vector_type(4)));
typedef float f32x2 __attribute__((ext_vector_type(2)));
typedef float f32x4 __attribute__((ext_vector_type(4)));
typedef float f32x16 __attribute__((ext_vector_type(16)));
typedef unsigned u32x4 __attribute__((ext_vector_type(4)));
typedef unsigned u32x2 __attribute__((ext_vector_type(2)));

constexpr int DM = 1024, NB = 4, SEQ = 8192, SB = 16, SS = 64, PAST = 4096, KALL = PAST + SS;
constexpr int MP = NB * SEQ, MS = SB * SS, MT = MP + MS;
constexpr int FF = 2816, NH = 16, HD = 64, NG = 64, NP = 64;
constexpr int NQKV = 3328;
constexpr float EPS = 1e-6f;
constexpr float C2 = 0.125f * 1.4426950408889634f;
constexpr float LOG2E = 1.4426950408889634f;
constexpr int NCH = SEQ / 64;
constexpr int NITEM = NB * NCH + SB;

constexpr size_t O_Y = 0;
constexpr size_t O_SRE_P = (size_t)MT * DM;
constexpr size_t O_SIM_P = O_SRE_P + NB * NG * NP;
constexpr size_t O_K_P = O_SIM_P + NB * NG * NP;
constexpr size_t O_V_P = O_K_P + (size_t)MP * DM;
constexpr size_t O_LF_P = O_V_P + (size_t)MP * DM;
constexpr size_t O_CV_P = O_LF_P + (size_t)MP * NH;
constexpr size_t O_SRE_S = O_CV_P + 2 * NB * 2 * FF;
constexpr size_t O_SIM_S = O_SRE_S + SB * NG * NP;
constexpr size_t O_K_S = O_SIM_S + SB * NG * NP;
constexpr size_t O_V_S = O_K_S + (size_t)MS * DM;
constexpr size_t O_LF_S = O_V_S + (size_t)MS * DM;
constexpr size_t O_CV_S = O_LF_S + (size_t)MS * NH;

constexpr size_t MiB = 1u << 20;
constexpr size_t WS_ABAR = 0, WS_A16 = 32768, WS_A64 = 65536, WS_BBT = 131072, WS_CMT = 393216;
constexpr size_t WS_SS = 1 * MiB, WS_IR0 = 2 * MiB, WS_CKP = 3 * MiB, WS_CKS = 5 * MiB;
constexpr size_t WS_WGLU = 10 * MiB, WS_WUG = 14 * MiB, WS_WDN = 36 * MiB, WS_WQKV = 47 * MiB, WS_WO = 54 * MiB;
constexpr size_t WS_X = 64 * MiB, WS_XB = 197 * MiB;
constexpr size_t WS_BIG = 264 * MiB;
constexpr size_t WS_G = WS_BIG, WS_E1 = 346 * MiB;
constexpr size_t WS_H = WS_BIG;
constexpr size_t WS_PG1 = 734 * MiB, WS_PDN0 = 798 * MiB, WS_PWO = 842 * MiB, WS_PDN1 = 874 * MiB;
constexpr size_t WS_BAR = WS_SS + 720896;
constexpr size_t WS_CNT = WS_SS + 655360;
constexpr size_t WS_KX = 718 * MiB;
constexpr size_t WS_KXW = 458 * MiB, WS_CKW = 522 * MiB;
constexpr size_t WS_Q = WS_BIG, WS_KP = 330 * MiB, WS_VP = 394 * MiB, WS_KS = 458 * MiB, WS_VS = 588 * MiB;

__device__ __forceinline__ unsigned cvt_pk_bf16(float lo, float hi) { unsigned r; asm volatile("v_cvt_pk_bf16_f32 %0, %1, %2" : "=v"(r) : "v"(lo), "v"(hi)); return r; }
__device__ __forceinline__ unsigned cvtpk_s(float lo, float hi) { typedef __bf16 bf16x2_t __attribute__((ext_vector_type(2))); f32x2 v = {lo, hi}; bf16x2_t b = __builtin_convertvector(v, bf16x2_t); return __builtin_bit_cast(unsigned, b); }
__device__ __forceinline__ float gelu_tanh(float v) {
    const float t = v * (0.7978845608f + 0.0356774081f * v * v);
    const float e = __builtin_amdgcn_exp2f(-2.8853900818f * t);
    return v * __builtin_amdgcn_rcpf(1.0f + e);
}
__device__ __forceinline__ float sigmoidf_(float v) { const float e = __builtin_amdgcn_exp2f(-LOG2E * v); return __builtin_amdgcn_rcpf(1.0f + e); }
__device__ __forceinline__ float wave_sum(float v) {
#pragma unroll
    for (int o = 1; o < 64; o <<= 1) v += __shfl_xor(v, o);
    return v;
}
template <int CTRL> __device__ __forceinline__ float dppf(float v) { return __int_as_float(__builtin_amdgcn_update_dpp(0, __float_as_int(v), CTRL, 0xf, 0xf, false)); }
#define LDS_WAIT() asm volatile("s_waitcnt lgkmcnt(0)" ::: "memory")

namespace pg8 {
constexpr int BM = 256, BK = 64, HALF = 128, HTB = HALF * BK * 2, STAGE_BYTES = 8 * HTB, NXCD = 8, WGM = 8;
__host__ __device__ __forceinline__ int lds_byte(int r, int c) { const int st = (r >> 4) * 2 + (c >> 5), rr = r & 15, cc = c & 31, ob = rr * 64 + cc * 2; return st * 1024 + (ob ^ (((ob >> 9) & 1) << 5)); }
__host__ __device__ __forceinline__ void stage_rc(int b, int& R, int& C) { const int st = b / 1024, sb = b % 1024, swz = sb ^ (((sb >> 9) & 1) << 5); R = (st >> 1) * 16 + swz / 64; C = (st & 1) * 32 + (swz % 64) / 2; }
__host__ __device__ __forceinline__ int perm32(int rho) { const int n = rho >> 4, i = rho & 15; return 8 * (i >> 2) + 4 * n + (i & 3); }
struct Unit { int pm, pn, ks; };
struct Gemm { const bf16_t* A; const bf16_t* Bt; int K; int nt; };
template <bool FFNROWS> struct Order {
    int nM, nN, nwg, G, c;
    __device__ void init(int nM_, int nN_, int G_, int c_) { nM = nM_; nN = nN_; nwg = nM * nN; G = G_; c = c_; }
    __device__ bool next(int i, Unit& u) const {
        const long L = (long)i * G + c; if (L >= nwg) return false;
        int wgid = (int)L; { const int q = nwg / NXCD, r = nwg % NXCD, xcd = wgid % NXCD, off = wgid / NXCD; wgid = (xcd < r ? xcd * (q + 1) : r * (q + 1) + (xcd - r) * q) + off; }
        const int nig = WGM * nN, gid = wgid / nig, fm = gid * WGM, gsz = (nM - fm) < WGM ? (nM - fm) : WGM;
        u.pm = fm + ((wgid % nig) % gsz); u.pn = (wgid % nig) / gsz; u.ks = 0; return true;
    }
    __device__ __forceinline__ long arow(int pm) const {
        if (!FFNROWS) return (long)pm * BM;
        if (pm < 132) { const int n = pm / 33, R = pm % 33; return (long)n * SEQ + 254 * R - 2; }
        return (long)MP + 256 * (pm - 132);
    }
};

template <int pm0, int nMt, int nN, int S> struct OrderTail {
    int G, c;
    __device__ bool next(int i, Unit& u) const { const long L = (long)i * G + c; if (L >= (long)nMt * nN * S) return false; const int tile = (int)L / S; u.ks = (int)L % S; u.pm = pm0 + tile % nMt; u.pn = tile / nMt; return true; }
    __device__ __forceinline__ long arow(int pm) const { return (long)pm * BM; }
};
template <class Epi, class Sched>
__device__ __forceinline__ void gemm_phase(LAS unsigned char* lds, const Gemm g, const Sched& S, const Epi& E) {
    int tid_ = threadIdx.x; asm volatile("" : "+v"(tid_));
    const int tid = tid_, wid = __builtin_amdgcn_readfirstlane(tid >> 6), lane = tid & 63, wr = wid >> 2, wc = wid & 3, fr = lane & 15, fq = lane >> 4;
    const int K = g.K, nt = g.nt;
    unsigned voffA[2], voffB[2];
#pragma unroll
    for (int i = 0; i < 2; ++i) { int R, C; stage_rc(tid * 16 + i * 8192, R, C); const int Rb = ((R & ~31) + perm32(R & 31));
        voffA[i] = (unsigned)(R * K + C) * 2u; voffB[i] = (unsigned)(Rb * K + C) * 2u; }
    const size_t kstep = (size_t)(BK * 2);
    const size_t hstep = (size_t)HALF * K * 2;
    const size_t tstep = 2 * hstep;
    const size_t rowb = (size_t)K * 2;
    const unsigned ldsw = (unsigned)wid * 1024u;
    const int aoff = lds_byte(wr * 64 + fr, fq * 8), boff = lds_byte(wc * 32 + fr, fq * 8);
#define PG8_SA(b, h) (((b) * 2 + (h)) * HTB)
#define PG8_SB(b, h) ((4 + (b) * 2 + (h)) * HTB)
#define PG8_STAGE(bufoff, gbase, voff) do { _Pragma("unroll") for (int _i = 0; _i < 2; ++_i) \
        __builtin_amdgcn_global_load_lds((const unsigned*)((const char*)(gbase) + (voff)[_i]), (LAS unsigned*)(lds + (bufoff) + ldsw + _i * 8192), 16, 0, 0); } while (0)
#define PG8_LDA(dst, b, h) do { _Pragma("unroll") for (int m = 0; m < 4; ++m) _Pragma("unroll") for (int k = 0; k < 2; ++k) dst[m][k] = *(const LAS bf16x8*)(lds + PG8_SA(b, h) + aoff + m * 2048 + k * 1024); } while (0)
#define PG8_LDB(dst, b, h) do { _Pragma("unroll") for (int n = 0; n < 2; ++n) _Pragma("unroll") for (int k = 0; k < 2; ++k) dst[n][k] = *(const LAS bf16x8*)(lds + PG8_SB(b, h) + boff + n * 2048 + k * 1024); } while (0)
#define PG8_MMA(ai, bj, At, Bt) do { __builtin_amdgcn_s_setprio(1); _Pragma("unroll") for (int m = 0; m < 4; ++m) _Pragma("unroll") for (int n = 0; n < 2; ++n) _Pragma("unroll") for (int k = 0; k < 2; ++k) \
        acc[ai][bj][m][n] = __builtin_amdgcn_mfma_f32_16x16x32_bf16(Bt[n][k], At[m][k], acc[ai][bj][m][n], 0, 0, 0); __builtin_amdgcn_s_setprio(0); } while (0)
#define PG8_WAIT_V(n) asm volatile("s_waitcnt vmcnt(" #n ")" ::: "memory")
#define PG8_WAIT_L(n) asm volatile("s_waitcnt lgkmcnt(" #n ")" ::: "memory")
#define PG8_BAR __builtin_amdgcn_s_barrier()
#define PG8_SCHED __builtin_amdgcn_sched_barrier(0)
    Unit cur, nxt; int ui = 0;
    if (!S.next(0, cur)) return;
    f32x4 acc[2][2][4][2];
#pragma unroll
    for (int a = 0; a < 2; ++a)
#pragma unroll
        for (int b = 0; b < 2; ++b)
#pragma unroll
            for (int m = 0; m < 4; ++m)
#pragma unroll
                for (int n = 0; n < 2; ++n) acc[a][b][m][n] = (f32x4){0.f, 0.f, 0.f, 0.f};
    bf16x8 At[4][2], B0[2][2], B1[2][2];
    const size_t kslice = (size_t)nt * kstep;
    const char* cA = (const char*)g.A + S.arow(cur.pm) * (long)rowb + cur.ks * kslice; const char* cB = (const char*)g.Bt + (size_t)cur.pn * tstep + cur.ks * kslice;
    PG8_STAGE(PG8_SB(0, 0), cB, voffB); PG8_STAGE(PG8_SB(0, 1), cB + hstep, voffB); PG8_STAGE(PG8_SA(0, 0), cA, voffA); PG8_STAGE(PG8_SA(0, 1), cA + hstep, voffA);
    if (wr == 1) PG8_BAR;
    PG8_WAIT_V(2); PG8_BAR;
    PG8_STAGE(PG8_SB(1, 0), cB + kstep, voffB); PG8_STAGE(PG8_SA(1, 0), cA + kstep, voffA); PG8_STAGE(PG8_SB(1, 1), cB + hstep + kstep, voffB);
    PG8_WAIT_V(6); PG8_BAR;
    for (;;) {
        const bool has_next = S.next(ui + 1, nxt);
        const char* nA = has_next ? (const char*)g.A + S.arow(nxt.pm) * (long)rowb + nxt.ks * kslice : cA; const char* nB = has_next ? (const char*)g.Bt + (size_t)nxt.pn * tstep + nxt.ks * kslice : cB;
        for (int t = 0; t < nt; t += 2) {
            const bool last = (t == nt - 2);
            const char* a1 = cA + (size_t)(t + 1) * kstep;
            const char* a2 = last ? nA : cA + (size_t)(t + 2) * kstep; const char* b2 = last ? nB : cB + (size_t)(t + 2) * kstep;
            const char* a3 = a2 + kstep; const char* b3 = b2 + kstep;
            PG8_LDB(B0, 0, 0); PG8_LDB(B1, 0, 1); PG8_SCHED; PG8_LDA(At, 0, 0); PG8_STAGE(PG8_SA(1, 1), a1 + hstep, voffA);
            PG8_WAIT_V(8); PG8_WAIT_L(0); PG8_BAR; PG8_MMA(0, 0, At, B0); PG8_MMA(0, 1, At, B1); PG8_BAR; PG8_SCHED;
            PG8_LDA(At, 0, 1); PG8_STAGE(PG8_SB(0, 0), b2, voffB); PG8_STAGE(PG8_SB(0, 1), b2 + hstep, voffB); PG8_STAGE(PG8_SA(0, 0), a2, voffA);
            PG8_WAIT_V(8); PG8_WAIT_L(0); PG8_BAR; PG8_MMA(1, 0, At, B0); PG8_MMA(1, 1, At, B1); PG8_BAR; PG8_SCHED;
            PG8_LDB(B0, 1, 0); PG8_LDB(B1, 1, 1); PG8_SCHED; PG8_LDA(At, 1, 0); PG8_STAGE(PG8_SA(0, 1), a2 + hstep, voffA);
            PG8_WAIT_V(8); PG8_WAIT_L(0); PG8_BAR; PG8_MMA(0, 0, At, B0); PG8_MMA(0, 1, At, B1); PG8_BAR; PG8_SCHED;
            PG8_LDA(At, 1, 1); PG8_STAGE(PG8_SB(1, 0), b3, voffB); PG8_STAGE(PG8_SB(1, 1), b3 + hstep, voffB); PG8_STAGE(PG8_SA(1, 0), a3, voffA);
            PG8_WAIT_V(8); PG8_WAIT_L(0); PG8_BAR; PG8_MMA(1, 0, At, B0); PG8_MMA(1, 1, At, B1); PG8_BAR; PG8_SCHED;
        }
        if (wr == 0) PG8_BAR;
        { int fr_ = fr, fq_ = fq; asm volatile("" : "+v"(fr_), "+v"(fq_)); E(acc, cur, wr, wc, fr_, fq_); }
        if (!has_next) break;
#pragma unroll
        for (int a = 0; a < 2; ++a)
#pragma unroll
            for (int b = 0; b < 2; ++b)
#pragma unroll
                for (int m = 0; m < 4; ++m)
#pragma unroll
                    for (int n = 0; n < 2; ++n) acc[a][b][m][n] = (f32x4){0.f, 0.f, 0.f, 0.f};
        cur = nxt; cA = nA; cB = nB; ++ui;
        if (wr == 1) PG8_BAR;
    }
    PG8_WAIT_V(0);
    PG8_BAR;
#undef PG8_SA
#undef PG8_SB
#undef PG8_STAGE
#undef PG8_LDA
#undef PG8_LDB
#undef PG8_MMA
#undef PG8_WAIT_V
#undef PG8_WAIT_L
#undef PG8_BAR
#undef PG8_SCHED
}
}


template <int MODE  , bool RES_F32  , bool WRITE_XB, bool WRITE_X> struct EpiRes {
    const float* r0; const float* r1;
    float* X; bf16_t* xb; float* sumsq;
    __device__ __forceinline__ void group(const f32x4 (&a)[2][2], const pg8::Unit& u, int ai, int m, int wr, int wc, int fr, int fq) const {
        const int row = u.pm * 256 + ai * 128 + wr * 64 + m * 16 + fr;
        const float* rp = row < MP ? r0 + (size_t)row * DM : r1 + (size_t)(row - MP) * DM;
        float ss = 0.f;
#pragma unroll
        for (int bj = 0; bj < (MODE == 1 ? 1 : 2); ++bj) {
            const int col = (MODE == 1 ? u.pn * 128 : u.pn * 256 + bj * 128) + wc * 32 + fq * 8;
            f32x4 v0, v1;
            if (MODE == 1) {
#pragma unroll
                for (int j = 0; j < 4; ++j) { v0[j] = a[0][0][j] * sigmoidf_(a[1][0][j]); v1[j] = a[0][1][j] * sigmoidf_(a[1][1][j]); }
            } else { v0 = a[bj][0]; v1 = a[bj][1]; }
            if (RES_F32) { v0 += *(const f32x4*)(rp + col); v1 += *(const f32x4*)(rp + col + 4); }
            else { const u32x4 rb = *(const u32x4*)(xb + (size_t)row * DM + col);
                v0 += (f32x4){__uint_as_float(rb.x << 16), __uint_as_float(rb.x & 0xffff0000u), __uint_as_float(rb.y << 16), __uint_as_float(rb.y & 0xffff0000u)};
                v1 += (f32x4){__uint_as_float(rb.z << 16), __uint_as_float(rb.z & 0xffff0000u), __uint_as_float(rb.w << 16), __uint_as_float(rb.w & 0xffff0000u)}; }
            if (WRITE_X) { *(f32x4*)(X + (size_t)row * DM + col) = v0; *(f32x4*)(X + (size_t)row * DM + col + 4) = v1; }
            if (WRITE_XB) { u32x4 w; w.x = cvt_pk_bf16(v0[0], v0[1]); w.y = cvt_pk_bf16(v0[2], v0[3]); w.z = cvt_pk_bf16(v1[0], v1[1]); w.w = cvt_pk_bf16(v1[2], v1[3]);
                *(u32x4*)(xb + (size_t)row * DM + col) = w; }
            ss += (v0[0] * v0[0] + v0[1] * v0[1]) + (v0[2] * v0[2] + v0[3] * v0[3]) + (v1[0] * v1[0] + v1[1] * v1[1]) + (v1[2] * v1[2] + v1[3] * v1[3]);
        }
        ss += __shfl_xor(ss, 16); ss += __shfl_xor(ss, 32);
        if (fq == 0) atomicAdd(sumsq + row, ss);
    }
    __device__ __forceinline__ void operator()(f32x4 (&acc)[2][2][4][2], const pg8::Unit& u, int wr, int wc, int fr, int fq) const {
#pragma unroll
        for (int ai = 0; ai < 2; ++ai)
#pragma unroll
            for (int m = 0; m < 4; ++m) { const f32x4 a[2][2] = {{acc[ai][0][m][0], acc[ai][0][m][1]}, {acc[ai][1][m][0], acc[ai][1][m][1]}}; group(a, u, ai, m, wr, wc, fr, fq); }
    }
};

template <class Inner, int S, int nN, int pm0, size_t POFF, int COFF> struct EpiSplitK {
    Inner inner; unsigned char* wsb;
    __device__ __forceinline__ void operator()(f32x4 (&acc)[2][2][4][2], const pg8::Unit& u, int wr, int wc, int fr, int fq) const {
        static_assert(S >= 8, "eight row groups need eight slices");
        float* const P = (float*)(wsb + POFF); unsigned* const cnt = (unsigned*)(wsb + WS_CNT) + COFF;
        const int tix = (u.pm - pm0) * nN + u.pn; int tid = threadIdx.x; asm volatile("" : "+v"(tid));
        float* slice = P + ((size_t)tix * S + u.ks) * 65536 + (size_t)tid * 4;
#pragma unroll
        for (int ai = 0; ai < 2; ++ai)
#pragma unroll
            for (int bj = 0; bj < 2; ++bj)
#pragma unroll
                for (int m = 0; m < 4; ++m)
#pragma unroll
                    for (int n = 0; n < 2; ++n) *(f32x4*)(slice + (size_t)(((ai * 2 + bj) * 4 + m) * 2 + n) * 2048) = acc[ai][bj][m][n];
        asm volatile("s_waitcnt vmcnt(0)" ::: "memory");
        __syncthreads();
        if (tid == 0) { __threadfence(); (void)__hip_atomic_fetch_add(cnt + tix, 1u, __ATOMIC_RELAXED, __HIP_MEMORY_SCOPE_AGENT); }
        if (u.ks >= 8) return;
        if (tid == 0) { unsigned sp = 0; while (__hip_atomic_load(cnt + tix, __ATOMIC_RELAXED, __HIP_MEMORY_SCOPE_AGENT) < (unsigned)S) { __builtin_amdgcn_s_sleep(4); if (++sp > (1u << 22)) break; } __threadfence(); }
        __syncthreads();
        const int ai = u.ks >> 2, m = u.ks & 3;
        f32x4 t[2][2] = {{(f32x4){0.f, 0.f, 0.f, 0.f}, (f32x4){0.f, 0.f, 0.f, 0.f}}, {(f32x4){0.f, 0.f, 0.f, 0.f}, (f32x4){0.f, 0.f, 0.f, 0.f}}};
        const float* p0 = P + (size_t)tix * S * 65536 + (size_t)tid * 4;
#pragma unroll
        for (int s = 0; s < S; ++s) {
#pragma unroll
            for (int bj = 0; bj < 2; ++bj)
#pragma unroll
                for (int n = 0; n < 2; ++n) t[bj][n] += __builtin_nontemporal_load((const f32x4*)(p0 + (size_t)s * 65536 + (size_t)(((ai * 2 + bj) * 4 + m) * 2 + n) * 2048));
        }
        inner.group(t, u, ai, m, wr, wc, fr, fq);
    }
};

struct EpiConv {
    bf16_t* H; const float* sumsq; const float* convw; const float* convb; const float* hist; float* outc_p; float* outc_s; LAS float* xch;
    __device__ __forceinline__ void operator()(f32x4 (&acc)[2][2][4][2], const pg8::Unit& u, int wr, int wc, int fr, int fq) const {
        const bool samp = u.pm >= 132;
        int n = 0, tok0 = 0; long grow0;
        if (!samp) { n = u.pm / 33; const int R = u.pm % 33; tok0 = 254 * R - 2; grow0 = (long)n * SEQ + tok0; } else { grow0 = (long)MP + 256 * (u.pm - 132); }
        const int f0 = 128 * u.pn + 32 * wc + 8 * fq;
#pragma unroll
        for (int ai = 0; ai < 2; ++ai)
#pragma unroll
            for (int m = 0; m < 4; ++m) {
                const int i = ai * 128 + wr * 64 + m * 16 + fr; long gr = grow0 + i; if (gr < 0) gr = 0;
                float rs = __builtin_amdgcn_rsqf(sumsq[gr] * (1.0f / DM) + EPS);
                float ra = rs; if (!samp && tok0 + i < 0) ra = 0.f;
#pragma unroll
                for (int nn = 0; nn < 2; ++nn) { acc[ai][0][m][nn] *= ra; acc[ai][1][m][nn] *= rs; }
            }
        if (fr >= 14) {
#pragma unroll
            for (int ai = 0; ai < 2; ++ai) { LAS float* p = xch + ((ai * 2 + wr) * 2 + (fr - 14)) * 128 + 32 * wc + 8 * fq;
                *(LAS f32x4*)p = acc[ai][0][3][0]; *(LAS f32x4*)(p + 4) = acc[ai][0][3][1]; }
        }
        asm volatile("s_waitcnt lgkmcnt(0)\n\ts_barrier" ::: "memory");
#pragma unroll
        for (int nn = 0; nn < 2; ++nn) {
            asm volatile("" ::: "memory");
            const int fc = f0 + 4 * nn;
            const f32x4 w0 = *(const f32x4*)(convw + fc), w1 = *(const f32x4*)(convw + FF + fc), w2 = *(const f32x4*)(convw + 2 * FF + fc), cb = *(const f32x4*)(convb + fc);
#pragma unroll
            for (int ai = 0; ai < 2; ++ai) {
                const int blk = ai * 2 + wr;
                f32x4 prev = (f32x4){0.f, 0.f, 0.f, 0.f};
                if (fr >= 14) {
                    if (samp) { prev = *(const f32x4*)(hist + ((size_t)((4 * (u.pm - 132) + blk) * 2 + (fr - 14))) * FF + fc); }
                    else if (blk > 0) { prev = *(const LAS f32x4*)(xch + (((blk - 1) * 2) + (fr - 14)) * 128 + 32 * wc + 8 * fq + 4 * nn); }
                }
#pragma unroll
                for (int m = 0; m < 4; ++m) {
                    const int i = ai * 128 + wr * 64 + m * 16 + fr; const long gr = grow0 + i;
                    const f32x4 a = acc[ai][0][m][nn], gt = acc[ai][1][m][nn]; f32x4 hv, a1, a2;
#pragma unroll
                    for (int j = 0; j < 4; ++j) {
                        a1[j] = __int_as_float(__builtin_amdgcn_update_dpp(__float_as_int(dppf<0x121>(prev[j])), __float_as_int(a[j]), 0x111, 0xf, 0xf, false));
                        a2[j] = __int_as_float(__builtin_amdgcn_update_dpp(__float_as_int(dppf<0x122>(prev[j])), __float_as_int(a[j]), 0x112, 0xf, 0xf, false));
                    }
                    {
                        const f32x4 cv = w0 * a2 + (w1 * a1 + (w2 * a + cb));
                        const f32x4 tt = cv * (cv * cv * 0.0356774081f + 0.7978845608f) * (-2.8853900818f);
                        f32x4 ee;
#pragma unroll
                        for (int j = 0; j < 4; ++j) ee[j] = __builtin_amdgcn_exp2f(tt[j]);
                        ee = ee + 1.0f;
#pragma unroll
                        for (int j = 0; j < 4; ++j) ee[j] = __builtin_amdgcn_rcpf(ee[j]);
                        hv = cv * ee * gt;
                    }
                    u32x2 wv; wv.x = cvt_pk_bf16(hv[0], hv[1]); wv.y = cvt_pk_bf16(hv[2], hv[3]);
                    const int tok = tok0 + i;
                    const bool valid = samp || (i >= 2 && tok < SEQ);
                    if (valid) *(u32x2*)(H + (size_t)gr * FF + fc) = wv;
                    if (!samp) { if (valid && tok >= SEQ - 2) { float* o = outc_p + ((size_t)(n * 2 + (tok - (SEQ - 2)))) * FF + fc; *(f32x4*)o = a; } }
                    else { if ((i & 63) >= 62) { float* o = outc_s + ((size_t)((4 * (u.pm - 132) + (i >> 6)) * 2 + ((i & 63) - 62))) * FF + fc; *(f32x4*)o = a; } }
                    prev = a;
                }
            }
        }
    }
};

struct EpiQKV {
    const float* sumsq; const float* bf; bf16_t* Q; bf16_t* Kp; bf16_t* Vp; bf16_t* Ks; bf16_t* Vs; float* out;
    __device__ __forceinline__ void operator()(f32x4 (&acc)[2][2][4][2], const pg8::Unit& u, int wr, int wc, int fr, int fq) const {
        const int sec = u.pn >> 2;
#pragma unroll
        for (int ai = 0; ai < 2; ++ai)
#pragma unroll
            for (int m = 0; m < 4; ++m) {
                const int row = u.pm * 256 + ai * 128 + wr * 64 + m * 16 + fr;
                const float rs = __builtin_amdgcn_rsqf(sumsq[row] * (1.0f / DM) + EPS);
                if (sec == 3) {
                    if (wc == 0 && fq < 2) {
                        const f32x4 v0 = acc[ai][0][m][0] * rs, v1 = acc[ai][0][m][1] * rs; f32x4 l0, l1;
#pragma unroll
                        for (int j = 0; j < 4; ++j) { const float x0 = v0[j] + bf[8 * fq + j], x1 = v1[j] + bf[8 * fq + 4 + j];
                            l0[j] = fminf(x0, 0.f) - log1pf(__expf(-fabsf(x0))); l1[j] = fminf(x1, 0.f) - log1pf(__expf(-fabsf(x1))); }
                        float* o = row < MP ? out + O_LF_P + (size_t)row * NH + 8 * fq : out + O_LF_S + (size_t)(row - MP) * NH + 8 * fq;
                        *(f32x4*)o = l0; *(f32x4*)(o + 4) = l1;
                    }
                } else {
#pragma unroll
                    for (int bj = 0; bj < 2; ++bj) {
                        const int col = (u.pn & 3) * 256 + bj * 128 + wc * 32 + fq * 8;
                        const float sc = sec == 0 ? rs * C2 : rs;
                        const f32x4 v0 = acc[ai][bj][m][0] * sc, v1 = acc[ai][bj][m][1] * sc;
                        u32x4 w; w.x = cvt_pk_bf16(v0[0], v0[1]); w.y = cvt_pk_bf16(v0[2], v0[3]); w.z = cvt_pk_bf16(v1[0], v1[1]); w.w = cvt_pk_bf16(v1[2], v1[3]);
                        if (sec == 0) { *(u32x4*)(Q + (size_t)row * DM + col) = w; }
                        else {
                            bf16_t* dst; float* o;
                            if (row < MP) { dst = (sec == 1 ? Kp : Vp) + (size_t)row * DM + col; o = out + (sec == 1 ? O_K_P : O_V_P) + (size_t)row * DM + col; }
                            else { const int rs_ = row - MP; dst = nullptr; o = out + (sec == 1 ? O_K_S : O_V_S) + (size_t)rs_ * DM + col; }
                            if (dst) *(u32x4*)dst = w; *(f32x4*)o = v0; *(f32x4*)(o + 4) = v1;
                        }
                    }
                }
            }
    }
};

namespace att {
constexpr int OFF_K = 0, OFF_V = 16384, OFF_CK = 32768, OFF_WSF = 33280, OFF_OST = 35328;
__device__ __forceinline__ int crow(int r, int hi) { return (r & 3) + 8 * (r >> 2) + 4 * hi; }
__device__ __forceinline__ void glds16(const void* gsrc, unsigned lds_dst) { unsigned keep;
    asm volatile("s_mov_b32 %0, m0\n\ts_mov_b32 m0, %2\n\ts_nop 0\n\tglobal_load_lds_dwordx4 %1, off\n\ts_mov_b32 m0, %0" : "=&s"(keep) : "v"(gsrc), "s"(lds_dst) : "memory"); }
__device__ __forceinline__ void glds4(const void* gsrc, unsigned lds_dst) { unsigned keep;
    asm volatile("s_mov_b32 %0, m0\n\ts_mov_b32 m0, %2\n\ts_nop 0\n\tglobal_load_lds_dword %1, off\n\ts_mov_b32 m0, %0" : "=&s"(keep) : "v"(gsrc), "s"(lds_dst) : "memory"); }
__device__ __forceinline__ float max3f(float a, float b, float c) { return __builtin_fmaxf(__builtin_fmaxf(a, b), c); }
#define SBAR() __builtin_amdgcn_sched_barrier(0)
__device__ __forceinline__ void qkt(f32x16& p0, f32x16& p1, const char* Kslot, const bf16x8* qr, const f32x16& negm, int r32, int hi) {
    const char* kb = Kslot + hi * 1024 + r32 * 16;
#pragma unroll
    for (int d0 = 0; d0 < 4; ++d0) {
        const bf16x8 b0 = *reinterpret_cast<const bf16x8*>(kb + d0 * 2048);
        const bf16x8 b1 = *reinterpret_cast<const bf16x8*>(kb + d0 * 2048 + 512);
        if (d0 == 0) { p0 = __builtin_amdgcn_mfma_f32_32x32x16_bf16(b0, qr[0], negm, 0, 0, 0); p1 = __builtin_amdgcn_mfma_f32_32x32x16_bf16(b1, qr[0], negm, 0, 0, 0); }
        else { p0 = __builtin_amdgcn_mfma_f32_32x32x16_bf16(b0, qr[d0], p0, 0, 0, 0); p1 = __builtin_amdgcn_mfma_f32_32x32x16_bf16(b1, qr[d0], p1, 0, 0, 0); } }
}
__device__ __forceinline__ void pv(f32x16* o, int vb, bf16x8 pa0, bf16x8 pa1, bf16x8 pa2, bf16x8 pa3) {
#pragma unroll
    for (int d0 = 0; d0 < 2; ++d0) { s16x4 lo[4], hi[4];
#pragma unroll
        for (int ks = 0; ks < 4; ++ks) {
            asm volatile("ds_read_b64_tr_b16 %0,%1 offset:%c2" : "=&v"(lo[ks]) : "v"(vb), "i"(d0 * 4096 + ks * 1024) : "memory");
            asm volatile("ds_read_b64_tr_b16 %0,%1 offset:%c2" : "=&v"(hi[ks]) : "v"(vb), "i"(d0 * 4096 + ks * 1024 + 512) : "memory"); }
        asm volatile("s_waitcnt lgkmcnt(0)" ::: "memory"); SBAR();
#define PK(k) (bf16x8){lo[k][0], lo[k][1], lo[k][2], lo[k][3], hi[k][0], hi[k][1], hi[k][2], hi[k][3]}
        o[d0] = __builtin_amdgcn_mfma_f32_32x32x16_bf16(pa0, PK(0), o[d0], 0, 0, 0);
        o[d0] = __builtin_amdgcn_mfma_f32_32x32x16_bf16(pa1, PK(1), o[d0], 0, 0, 0);
        o[d0] = __builtin_amdgcn_mfma_f32_32x32x16_bf16(pa2, PK(2), o[d0], 0, 0, 0);
        o[d0] = __builtin_amdgcn_mfma_f32_32x32x16_bf16(pa3, PK(3), o[d0], 0, 0, 0);
#undef PK
    }
}
constexpr int OFF_CKA = 32768, OFF_WSF2 = 49408, OFF_OST2 = 51456;
__device__ __forceinline__ void attn_unit_sample(char* shm, const bf16_t* Q, const float* kc, const float* vc, const float* kn, const float* vn, bf16_t* O, const float* lfc, const float* lfn) {
    int tid_ = threadIdx.x; asm volatile("" : "+v"(tid_));
    const int tid = tid_, lane = tid & 63, r32 = lane & 31, hi = lane >> 5; const int wid = __builtin_amdgcn_readfirstlane(tid >> 6);
    const unsigned lds0 = (unsigned)(uintptr_t)shm;
    float* wsf = (float*)(shm + OFF_WSF2) + wid * 64;
    float* cka = (float*)(shm + OFF_CKA);
    constexpr int NT = KALL / 64, qpos0 = PAST;
    const int vrow = 16 * (wid & 3) + (lane >> 2), vcol = (wid >> 2) * 32 + (lane & 3) * 8;
    f32x4 kreg[4][2], vreg[4][2];
#define LOADT(t, q) do { const float* kp = (t) < PAST / 64 ? kc + ((size_t)(t) * 64 + lane) * DM + wid * 8 : kn + (size_t)lane * DM + wid * 8; \
        const float* vp = (t) < PAST / 64 ? vc + ((size_t)(t) * 64 + vrow) * DM + vcol : vn + (size_t)vrow * DM + vcol; \
        kreg[q][0] = *(const f32x4*)kp; kreg[q][1] = *(const f32x4*)(kp + 4); vreg[q][0] = *(const f32x4*)vp; vreg[q][1] = *(const f32x4*)(vp + 4); } while (0)
#define STORET(slot, q) do { u32x4 kw, vw; kw.x = cvt_pk_bf16(kreg[q][0][0], kreg[q][0][1]); kw.y = cvt_pk_bf16(kreg[q][0][2], kreg[q][0][3]); kw.z = cvt_pk_bf16(kreg[q][1][0], kreg[q][1][1]); kw.w = cvt_pk_bf16(kreg[q][1][2], kreg[q][1][3]); \
        vw.x = cvt_pk_bf16(vreg[q][0][0], vreg[q][0][1]); vw.y = cvt_pk_bf16(vreg[q][0][2], vreg[q][0][3]); vw.z = cvt_pk_bf16(vreg[q][1][0], vreg[q][1][1]); vw.w = cvt_pk_bf16(vreg[q][1][2], vreg[q][1][3]); \
        *(u32x4*)(shm + OFF_K + (slot) * 8192 + wid * 1024 + lane * 16) = kw; *(u32x4*)(shm + OFF_V + (slot) * 8192 + wid * 1024 + lane * 16) = vw; } while (0)
    LOADT(0, 0); LOADT(1, 1); LOADT(2, 2); LOADT(3, 3);
    {
        float v[9]; float tot = 0.f;
#pragma unroll
        for (int j = 0; j < 9; ++j) { const int k = 9 * tid + j; float x = 0.f; if (k < PAST) x = lfc[(size_t)k * NH]; else if (k < KALL) x = lfn[(size_t)(k - PAST) * NH]; tot += x; v[j] = tot; }
        float sc = tot;
#pragma unroll
        for (int o = 1; o < 64; o <<= 1) { const float t = __shfl_up(sc, o); if (lane >= o) sc += t; }
        float* wtot = (float*)(shm + OFF_WSF2);
        if (lane == 63) wtot[wid] = sc;
        asm volatile("s_waitcnt lgkmcnt(0)\n\ts_barrier" ::: "memory");
        float base = sc - tot;
#pragma unroll
        for (int w = 0; w < 8; ++w) { const float t = wtot[w]; if (w < wid) base += t; }
#pragma unroll
        for (int j = 0; j < 9; ++j) { const int k = 9 * tid + j; if (k < KALL) cka[k] = (base + v[j]) * LOG2E; }
        asm volatile("s_waitcnt lgkmcnt(0)\n\ts_barrier" ::: "memory");
    }
    const bool active = wid < 4; const int qw = wid & 1, kh = (wid >> 1) & 1;
    const int vb0 = (int)(lds0 + OFF_V) + ((lane >> 4) & 1) * 32 + (lane & 3) * 8 + (4 * hi + ((lane & 15) >> 2)) * 64 + kh * 2048;
    const bf16_t* Qw = Q + (long)(qw * 32) * DM;
    bf16x8 qr[4];
#pragma unroll
    for (int d0 = 0; d0 < 4; ++d0) qr[d0] = *reinterpret_cast<const bf16x8*>(&Qw[(long)r32 * DM + d0 * 16 + hi * 8]);
    const int qpos = qpos0 + qw * 32 + r32, qmin = qpos0 + qw * 32;
    float mhat = -cka[qpos], l_reg = 0.f;
    f32x16 o[2]; o[0] = f32x16{}; o[1] = f32x16{};
    f32x16 negm;
#pragma unroll
    for (int r = 0; r < 16; ++r) negm[r] = -mhat;
    for (int t0 = 0; t0 < NT; t0 += 4) {
#pragma unroll
      for (int q = 0; q < 4; ++q) {
        const int t = t0 + q; if (t >= NT) break;
        const int slot = q & 1;
        STORET(slot, q);
        if (t + 4 < NT) LOADT(t + 4, q);
        asm volatile("s_waitcnt lgkmcnt(0)\n\ts_barrier" ::: "memory");
        if (active) {
            f32x16 p0;
            { const char* kb = shm + OFF_K + slot * 8192 + hi * 1024 + (r32 + 32 * kh) * 16;
#pragma unroll
              for (int d0 = 0; d0 < 4; ++d0) { const bf16x8 b0 = *reinterpret_cast<const bf16x8*>(kb + d0 * 2048);
                  p0 = __builtin_amdgcn_mfma_f32_32x32x16_bf16(b0, qr[d0], d0 == 0 ? negm : p0, 0, 0, 0); } }
            const float* ckp = cka + 64 * t + 32 * kh;
#pragma unroll
            for (int a = 0; a < 4; ++a) { const f32x4 c0 = *(const f32x4*)(ckp + 8 * a + 4 * hi);
#pragma unroll
                for (int j = 0; j < 4; ++j) p0[4 * a + j] -= c0[j]; }
            if (64 * t + 63 > qmin) {
#pragma unroll
                for (int r = 0; r < 16; ++r) { const int kv = 64 * t + 32 * kh + crow(r, hi); if (kv > qpos) p0[r] = -1e30f; }
            }
            float a = max3f(p0[0], p0[1], p0[2]), b = max3f(p0[3], p0[4], p0[5]);
#pragma unroll
            for (int r = 6; r < 16; r += 2) { a = __builtin_fmaxf(a, p0[r]); b = __builtin_fmaxf(b, p0[r + 1]); }
            float rm = __builtin_fmaxf(a, b); rm = __builtin_fmaxf(rm, __shfl_xor(rm, 32));
            if (__any(rm > 8.f)) {
                const float dl = __builtin_fmaxf(rm, 0.f); mhat += dl;
#pragma unroll
                for (int r = 0; r < 16; ++r) p0[r] -= dl;
#pragma unroll
                for (int r = 0; r < 16; ++r) negm[r] = -mhat;
                const float f = __builtin_amdgcn_exp2f(-dl); l_reg *= f; if (hi == 0) wsf[r32] = f;
                LDS_WAIT();
#pragma unroll
                for (int d_ = 0; d_ < 2; ++d_)
#pragma unroll
                    for (int r = 0; r < 16; ++r) o[d_][r] *= wsf[crow(r, hi)];
            }
            float sacc = 0.f;
#pragma unroll
            for (int r = 0; r < 16; ++r) { p0[r] = __builtin_amdgcn_exp2f(p0[r]); sacc += p0[r]; }
            l_reg += sacc;
            u32x4 pw0, pw1;
            pw0 = (u32x4){cvtpk_s(p0[0], p0[1]), cvtpk_s(p0[2], p0[3]), cvtpk_s(p0[4], p0[5]), cvtpk_s(p0[6], p0[7])};
            pw1 = (u32x4){cvtpk_s(p0[8], p0[9]), cvtpk_s(p0[10], p0[11]), cvtpk_s(p0[12], p0[13]), cvtpk_s(p0[14], p0[15])};
            SBAR();
            { const int vb = vb0 + slot * 8192; const bf16x8 pa0 = __builtin_bit_cast(bf16x8, pw0), pa1 = __builtin_bit_cast(bf16x8, pw1);
#pragma unroll
              for (int d0 = 0; d0 < 2; ++d0) { s16x4 lo[2], hi2[2];
#pragma unroll
                for (int ks = 0; ks < 2; ++ks) {
                    asm volatile("ds_read_b64_tr_b16 %0,%1 offset:%c2" : "=&v"(lo[ks]) : "v"(vb), "i"(d0 * 4096 + ks * 1024) : "memory");
                    asm volatile("ds_read_b64_tr_b16 %0,%1 offset:%c2" : "=&v"(hi2[ks]) : "v"(vb), "i"(d0 * 4096 + ks * 1024 + 512) : "memory"); }
                asm volatile("s_waitcnt lgkmcnt(0)" ::: "memory"); SBAR();
#define PK(k) (bf16x8){lo[k][0], lo[k][1], lo[k][2], lo[k][3], hi2[k][0], hi2[k][1], hi2[k][2], hi2[k][3]}
                o[d0] = __builtin_amdgcn_mfma_f32_32x32x16_bf16(pa0, PK(0), o[d0], 0, 0, 0);
                o[d0] = __builtin_amdgcn_mfma_f32_32x32x16_bf16(pa1, PK(1), o[d0], 0, 0, 0);
#undef PK
              } }
        }
      }
    }
    asm volatile("s_waitcnt lgkmcnt(0)\n\ts_barrier" ::: "memory");
    l_reg += __shfl_xor(l_reg, 32);
    float* mrg = (float*)(shm + OFF_K) + qw * (2 * 32 + 32 * 64);
    if (active && kh == 1) {
        if (hi == 0) { mrg[r32] = mhat; mrg[32 + r32] = l_reg; }
#pragma unroll
        for (int d0 = 0; d0 < 2; ++d0)
#pragma unroll
            for (int r = 0; r < 16; ++r) mrg[64 + (d0 * 16 + r) * 64 + lane] = o[d0][r];
    }
    asm volatile("s_waitcnt lgkmcnt(0)\n\ts_barrier" ::: "memory");
    if (active && kh == 0) {
        const float m1 = mrg[r32], l1 = mrg[32 + r32];
        const float mm = __builtin_fmaxf(mhat, m1), f0 = __builtin_amdgcn_exp2f(mhat - mm), f1 = __builtin_amdgcn_exp2f(m1 - mm);
        const float lt = l_reg * f0 + l1 * f1;
        if (hi == 0) { wsf[r32] = f0 * __builtin_amdgcn_rcpf(lt); wsf[32 + r32] = f1 * __builtin_amdgcn_rcpf(lt); }
        LDS_WAIT();
        bf16_t* Ow = O + (long)(qw * 32) * DM;
        __hip_bfloat16* stg = (__hip_bfloat16*)(shm + OFF_OST2) + wid * 2048;
#pragma unroll
        for (int r = 0; r < 16; ++r) { const int orow = crow(r, hi); const float s0 = wsf[orow], s1 = wsf[32 + orow];
#pragma unroll
            for (int d0 = 0; d0 < 2; ++d0) stg[orow * 64 + d0 * 32 + r32] = __float2bfloat16(o[d0][r] * s0 + mrg[64 + (d0 * 16 + r) * 64 + lane] * s1); }
        LDS_WAIT();
#pragma unroll
        for (int i = 0; i < 4; ++i) { const int row = i * 8 + (lane >> 3), ch = lane & 7; const u32x4 v = *(const u32x4*)(stg + row * 64 + ch * 8); *(u32x4*)(Ow + (long)row * DM + ch * 8) = v; }
    }
    asm volatile("s_waitcnt vmcnt(0) lgkmcnt(0)\n\ts_barrier" ::: "memory");
#undef LOADT
#undef STORET
}
#undef SBAR
}

namespace atf {
using bf16=__hip_bfloat16;
constexpr int SEQ=8192,D=64,DM=1024,NW=8,QBLK=32,QB=QBLK*NW,KVBLK=64;
__device__ __forceinline__ int crow(int r,int hi){return (r&3)+8*(r>>2)+4*hi;}
#define SBAR() __builtin_amdgcn_sched_barrier(0)
__device__ __forceinline__ void cmask(f32x16&p0,f32x16&p1,int jb,int qrel,int hi){
  const float NEG=-INFINITY; int kb=64*jb+4*hi;
  #pragma unroll
  for(int r=0;r<16;++r){int kv=kb+(r&3)+8*(r>>2); if(kv>qrel)p0[r]=NEG; if(kv+32>qrel)p1[r]=NEG;}
}

constexpr int NSLOT=3, SLOTB=8192;
constexpr int LDS_K=0, LDS_V=NSLOT*SLOTB, LDS_X=2*NSLOT*SLOTB, LDS_WS=LDS_X+NSLOT*2048, LDS_OST=LDS_WS+NW*64*4, LDS_BYTES=LDS_OST+NW*4096;
__device__ __forceinline__ void glds16(const void*gsrc,unsigned lds_dst){unsigned keep;
  asm volatile("s_mov_b32 %0, m0\n\ts_mov_b32 m0, %2\n\ts_nop 0\n\tglobal_load_lds_dwordx4 %1, off\n\ts_mov_b32 m0, %0":"=&s"(keep):"v"(gsrc),"s"(lds_dst):"memory");}
__device__ __forceinline__ void glds4(const void*gsrc,unsigned lds_dst){unsigned keep;
  asm volatile("s_mov_b32 %0, m0\n\ts_mov_b32 m0, %2\n\ts_nop 0\n\tglobal_load_lds_dword %1, off\n\ts_mov_b32 m0, %0":"=&s"(keep):"v"(gsrc),"s"(lds_dst):"memory");}
__device__ __forceinline__ bf16x8 mkqx(float mhat,int hi){ const float nv=-mhat; const unsigned h1=(__builtin_bit_cast(unsigned,nv)+0x7fffu+((__builtin_bit_cast(unsigned,nv)>>16)&1u))>>16; const float r1=nv-__builtin_bit_cast(float,h1<<16);
  const unsigned u1=__builtin_bit_cast(unsigned,r1), h2=(u1+0x7fffu+((u1>>16)&1u))>>16; const float r2=r1-__builtin_bit_cast(float,h2<<16); const unsigned u2=__builtin_bit_cast(unsigned,r2), h3=(u2+0x7fffu+((u2>>16)&1u))>>16;
  u32x4 w=hi?(u32x4){0u,0u,0u,0u}:(u32x4){0x3f803f80u,0x3f80u|(h1<<16),h2|(h3<<16),0u}; return __builtin_bit_cast(bf16x8,w); }
__device__ __forceinline__ float max3f(float a,float b,float c){float r;asm("v_max3_f32 %0, %1, %2, %3":"=v"(r):"v"(a),"v"(b),"v"(c));return r;}
__device__ __forceinline__ float max2f(float a,float b){float r;asm("v_max_f32_e32 %0, %1, %2":"=v"(r):"v"(a),"v"(b));return r;}
__device__ __forceinline__ float fadd_s(float a,float b){float r;asm("v_add_f32_e32 %0, %1, %2":"=v"(r):"v"(a),"v"(b));return r;}
__device__ __forceinline__ float fsub_s(float a,float b){float r;asm("v_sub_f32_e32 %0, %1, %2":"=v"(r):"v"(a),"v"(b));return r;}
typedef float f32x2_t __attribute__((ext_vector_type(2))); typedef __bf16 bf16x2_t __attribute__((ext_vector_type(2)));
__device__ __forceinline__ unsigned cvtpk_s(float lo,float hi){f32x2_t v={lo,hi};bf16x2_t b=__builtin_convertvector(v,bf16x2_t);return __builtin_bit_cast(unsigned,b);}
#define WAIT_BAR(N) asm volatile("s_waitcnt vmcnt(" #N ") lgkmcnt(0)\n\ts_barrier":::"memory")

__device__ __forceinline__ void qkt(f32x16&p0,f32x16&p1,const char*Kslot,const char*Xslot,const bf16x8*qr,const bf16x8 qx,const f32x16&negm,int r32,int hi){
  const char*kb=Kslot+hi*1024+r32*16;
  #pragma unroll
  for(int d0=0;d0<4;++d0){
    const bf16x8 b0=*reinterpret_cast<const bf16x8*>(kb+d0*2048);
    const bf16x8 b1=*reinterpret_cast<const bf16x8*>(kb+d0*2048+512);
    if(d0==0){p0=__builtin_amdgcn_mfma_f32_32x32x16_bf16(b0,qr[0],negm,0,0,0);p1=__builtin_amdgcn_mfma_f32_32x32x16_bf16(b1,qr[0],negm,0,0,0);}
    else{p0=__builtin_amdgcn_mfma_f32_32x32x16_bf16(b0,qr[d0],p0,0,0,0);p1=__builtin_amdgcn_mfma_f32_32x32x16_bf16(b1,qr[d0],p1,0,0,0);}}
  { const char*xb=Xslot+hi*1024+r32*16; const bf16x8 x0=*reinterpret_cast<const bf16x8*>(xb), x1=*reinterpret_cast<const bf16x8*>(xb+512);
    p0=__builtin_amdgcn_mfma_f32_32x32x16_bf16(x0,qx,p0,0,0,0);p1=__builtin_amdgcn_mfma_f32_32x32x16_bf16(x1,qx,p1,0,0,0); }
}
typedef __attribute__((address_space(3))) const char* lds_cptr;
typedef short v4i16_t __attribute__((ext_vector_type(4)));
__device__ __forceinline__ void kloadx(bf16x8*kf,lds_cptr xp){ kf[8]=*(const __attribute__((address_space(3))) bf16x8*)(xp); kf[9]=*(const __attribute__((address_space(3))) bf16x8*)(xp+512); }
__device__ __forceinline__ void kload8(bf16x8*kf,lds_cptr kp){
  kf[0]=*(const __attribute__((address_space(3))) bf16x8*)(kp);      kf[1]=*(const __attribute__((address_space(3))) bf16x8*)(kp+512);
  kf[2]=*(const __attribute__((address_space(3))) bf16x8*)(kp+2048); kf[3]=*(const __attribute__((address_space(3))) bf16x8*)(kp+2560);
  kf[4]=*(const __attribute__((address_space(3))) bf16x8*)(kp+4096); kf[5]=*(const __attribute__((address_space(3))) bf16x8*)(kp+4608);
  kf[6]=*(const __attribute__((address_space(3))) bf16x8*)(kp+6144); kf[7]=*(const __attribute__((address_space(3))) bf16x8*)(kp+6656);
}
__device__ __forceinline__ void kload2(bf16x8*kf,lds_cptr kp,int j){ kf[2*j]=*(const __attribute__((address_space(3))) bf16x8*)(kp+j*2048); kf[2*j+1]=*(const __attribute__((address_space(3))) bf16x8*)(kp+j*2048+512); }
__device__ __forceinline__ s16x4 vtr(lds_cptr p){ return __builtin_bit_cast(s16x4,__builtin_amdgcn_ds_read_tr16_b64_v4i16((__attribute__((address_space(3))) v4i16_t*)p)); }
__device__ __forceinline__ float rowmax(const f32x16&p0,const f32x16&p1){
  float a=max3f(p0[0],p0[1],p1[0]),b=max3f(p0[2],p0[3],p1[1]);a=max3f(a,p1[2],p1[3]);
  #pragma unroll
  for(int r=4;r<16;r+=4){a=max3f(a,p0[r],p0[r+1]);b=max3f(b,p0[r+2],p0[r+3]);a=max3f(a,p1[r],p1[r+1]);b=max3f(b,p1[r+2],p1[r+3]);}
  const float m=max2f(a,b);
  auto rr=__builtin_amdgcn_permlane32_swap(__float_as_uint(m),__float_as_uint(m),false,false);
  return max2f(__uint_as_float(rr[0]),__uint_as_float(rr[1]));
}
__device__ __forceinline__ void pv(f32x16*o,int vb,bf16x8 pa0,bf16x8 pa1,bf16x8 pa2,bf16x8 pa3){
  #pragma unroll
  for(int d0=0;d0<2;++d0){s16x4 lo[4],hi[4];
    #pragma unroll
    for(int ks=0;ks<4;++ks){
      asm volatile("ds_read_b64_tr_b16 %0,%1 offset:%c2":"=&v"(lo[ks]):"v"(vb),"i"(d0*4096+ks*1024):"memory");
      asm volatile("ds_read_b64_tr_b16 %0,%1 offset:%c2":"=&v"(hi[ks]):"v"(vb),"i"(d0*4096+ks*1024+512):"memory");}
    asm volatile("s_waitcnt lgkmcnt(0)":::"memory");SBAR();
    #define PK(k) (bf16x8){lo[k][0],lo[k][1],lo[k][2],lo[k][3],hi[k][0],hi[k][1],hi[k][2],hi[k][3]}
    o[d0]=__builtin_amdgcn_mfma_f32_32x32x16_bf16(pa0,PK(0),o[d0],0,0,0);
    o[d0]=__builtin_amdgcn_mfma_f32_32x32x16_bf16(pa1,PK(1),o[d0],0,0,0);
    o[d0]=__builtin_amdgcn_mfma_f32_32x32x16_bf16(pa2,PK(2),o[d0],0,0,0);
    o[d0]=__builtin_amdgcn_mfma_f32_32x32x16_bf16(pa3,PK(3),o[d0],0,0,0);
    #undef PK
  }
}

#ifndef ATTN_STORE16
#define ATTN_STORE16(p,v) (*(u32x4*)(p)=(v))
#endif
template<int THRL> __device__ __forceinline__ void attn_unit(int b,int h,int qb,const bf16*Q,const bf16*__restrict__ K,const bf16*__restrict__ V,bf16*O,const bf16*__restrict__ KX,const float*__restrict__ CK,char*shm){
  int tid_=threadIdx.x; asm volatile("":"+v"(tid_)); const int tid=tid_,lane=tid&63,r32=lane&31,hi=lane>>5; const int wid=__builtin_amdgcn_readfirstlane(tid>>6);
  const long rowbase=(long)b*SEQ; const int q0=qb*QB;
  const bf16*Qw=Q+(rowbase+q0+wid*QBLK)*DM+h*D;
  const bf16*Kh=K+rowbase*DM+h*D,*Vh=V+rowbase*DM+h*D;
  const unsigned lds0=(unsigned)(uintptr_t)shm;
  float*wsf=(float*)(shm+LDS_WS)+wid*64;
  const bf16*ksrc=Kh+(long)lane*DM+wid*8;
  const bf16*vsrc=Vh+(long)(16*(wid&3)+(lane>>2))*DM+(wid>>2)*32+(lane&3)*8;
  const bf16*xsrc=KX+(long)(16*(wid&3)+(lane>>2))*16+(wid>>2)*8+(lane&3)*2;
  const unsigned kdst=lds0+LDS_K+wid*1024, vdst=lds0+LDS_V+wid*1024, xdst=lds0+LDS_X+wid*256;
  #define DMA_K(t,slot) do{ glds16(ksrc+(long)(t)*KVBLK*DM,(unsigned)__builtin_amdgcn_readfirstlane(kdst+(slot))); glds4(xsrc+(long)(t)*KVBLK*16,(unsigned)__builtin_amdgcn_readfirstlane(xdst+((slot)>>2))); }while(0)
  #define DMA_V(t,slot) glds16(vsrc+(long)(t)*KVBLK*DM,(unsigned)__builtin_amdgcn_readfirstlane(vdst+(slot)))
  const int vb0=(int)(lds0+LDS_V)+((lane>>4)&1)*32+(lane&3)*8+(4*hi+((lane&15)>>2))*64;
  const char*Kbase=shm+LDS_K; const char*Xbase=shm+LDS_X; bf16x8 kf[10];
  const lds_cptr shm3=(lds_cptr)shm; const lds_cptr kp0=shm3+LDS_K+hi*1024+r32*16; const lds_cptr xp0=shm3+LDS_X+hi*1024+r32*16; const lds_cptr vp0=shm3+LDS_V+((lane>>4)&1)*32+(lane&3)*8+(4*hi+((lane&15)>>2))*64;
  const int NT=(q0+QB)/KVBLK;
  DMA_K(0,0);DMA_V(0,0);DMA_K(1,SLOTB);
  bf16x8 qr[4];
  #pragma unroll
  for(int d0=0;d0<4;++d0)qr[d0]=*reinterpret_cast<const bf16x8*>(&Qw[(long)r32*DM+d0*16+hi*8]);
  const int qrel=wid*QBLK+r32;
  float mhat=-CK[q0+qrel],l_reg=0.f;f32x16 o[2];o[0]=f32x16{};o[1]=f32x16{};const f32x16 negm=f32x16{};
  bf16x8 qx=mkqx(mhat,hi);
  #define CMASK(P0,P1,t) do{int jb_=(t)-(NT-4); if(jb_>=0)cmask(P0,P1,jb_,qrel,hi);}while(0)
  bool resc=false;
  #define START(P0,P1) do{ const float rm=rowmax(P0,P1); resc=false; \
    { const float dl=rm; mhat=fadd_s(mhat,dl); \
      _Pragma("unroll") for(int r=0;r<16;++r){P0[r]=fsub_s(P0[r],dl);P1[r]=fsub_s(P1[r],dl);} \
      _Pragma("unroll") for(int r=0;r<16;++r)negm[r]=-mhat; asm volatile("":"+v"(negm)); } \
    _Pragma("unroll") for(int r=0;r<16;++r)P0[r]=__builtin_amdgcn_exp2f(P0[r]); }while(0)
  #define RESC() do{ if(resc){ asm volatile("s_waitcnt lgkmcnt(0)":::"memory"); \
      _Pragma("unroll") for(int d_=0;d_<2;++d_) _Pragma("unroll") for(int r=0;r<16;++r)o[d_][r]*=wsf[crow(r,hi)]; } }while(0)
  f32x16 pA0,pA1,pB0,pB1;
  int sl_prev=0,sl_cur=0,sl_next=SLOTB;
  #define ROT() do{sl_prev=sl_cur;sl_cur=sl_next;sl_next=(sl_next==(NSLOT-1)*SLOTB)?0:sl_next+SLOTB;}while(0)
  DMA_K(2,2*SLOTB);
  WAIT_BAR(5);
  qkt(pA0,pA1,Kbase,Xbase,qr,qx,negm,r32,hi);asm volatile("s_nop 15\n\ts_nop 7":"+v"(pA0),"+v"(pA1));CMASK(pA0,pA1,0);
  _Pragma("unroll") for(int r=0;r<16;++r){pA0[r]=__builtin_amdgcn_exp2f(pA0[r]);pA1[r]=__builtin_amdgcn_exp2f(pA1[r]);}
  WAIT_BAR(0);
  DMA_K(3,0);DMA_V(1,SLOTB);
  ROT();
  kload8(kf,kp0+sl_cur); kloadx(kf,xp0+(sl_cur>>2));
  WAIT_BAR(3);
  s16x4 vlo[8],vhi[8]; u32x4 pw0,pw1,pw2,pw3;
  #define PKW(P,B) cvtpk_s(P[B],P[B+1])
  #define PAF(k) __builtin_bit_cast(bf16x8,pw##k)
  #define VFR(i) (bf16x8){vlo[i][0],vlo[i][1],vlo[i][2],vlo[i][3],vhi[i][0],vhi[i][1],vhi[i][2],vhi[i][3]}
  #define PIN(x) asm volatile("":"+v"(x))
  #define MX3(a,b,c) __builtin_fmaxf(__builtin_fmaxf((a),(b)),(c))
  #define GAPA(MF,A0,A1,A2,A3,W0,W1,PW) do{ MF; sacc+=A0; sacc+=A1; sacc+=A2; sacc+=A3; PIN(sacc); W0; W1; PIN(PW); SBAR(); }while(0)
  #define EX(v) __builtin_amdgcn_exp2f(v)
  #define GAPB(MF,X,B) do{ MF; X[B]=EX(X[B]); X[B+1]=EX(X[B+1]); X[B+2]=EX(X[B+2]); X[B+3]=EX(X[B+3]); PIN(X); SBAR(); }while(0)
  #define VRD(i) do{ vlo[i]=vtr(vp_+(((i)>>2)*4096+((i)&3)*1024)); vhi[i]=vtr(vp_+(((i)>>2)*4096+((i)&3)*1024+512)); }while(0)
  #define KRD(G,j) do{ if(G){ kload2(kf,kp0+sl_next,j); if((j)==3) kloadx(kf,xp0+(sl_next>>2)); SBAR(); } }while(0)
  #define STEP(C0,C1,P0,P1,t,GK,GV,GL) do{ SBAR(); \
    const lds_cptr vp_=vp0+sl_prev; \
    VRD(0); SBAR(); float sacc=(P0[0]+P0[1]); \
    GAPA(C0=__builtin_amdgcn_mfma_f32_32x32x16_bf16(kf[0],qr[0],negm,0,0,0), P0[2],P0[3],P0[4],P0[5],     pw0[0]=PKW(P0,0), pw0[1]=PKW(P0,2), pw0); \
    VRD(4); SBAR(); GAPA(C1=__builtin_amdgcn_mfma_f32_32x32x16_bf16(kf[1],qr[0],negm,0,0,0), P0[6],P0[7],P0[8],P0[9],     pw0[2]=PKW(P0,4), pw0[3]=PKW(P0,6), pw0); \
    VRD(1); SBAR(); GAPA(C0=__builtin_amdgcn_mfma_f32_32x32x16_bf16(kf[2],qr[1],C0,0,0,0),   P0[10],P0[11],P0[12],P0[13], pw1[0]=PKW(P0,8), pw1[1]=PKW(P0,10), pw1); \
    VRD(5); SBAR(); GAPA(C1=__builtin_amdgcn_mfma_f32_32x32x16_bf16(kf[3],qr[1],C1,0,0,0),   P0[14],P0[15],P1[0],P1[1],   pw1[2]=PKW(P0,12),pw1[3]=PKW(P0,14), pw1); \
    VRD(2); SBAR(); GAPA(C0=__builtin_amdgcn_mfma_f32_32x32x16_bf16(kf[4],qr[2],C0,0,0,0),   P1[2],P1[3],P1[4],P1[5],     pw2[0]=PKW(P1,0), pw2[1]=PKW(P1,2), pw2); \
    VRD(6); SBAR(); GAPA(C1=__builtin_amdgcn_mfma_f32_32x32x16_bf16(kf[5],qr[2],C1,0,0,0),   P1[6],P1[7],P1[8],P1[9],     pw2[2]=PKW(P1,4), pw2[3]=PKW(P1,6), pw2); \
    VRD(3); SBAR(); GAPA(C0=__builtin_amdgcn_mfma_f32_32x32x16_bf16(kf[6],qr[3],C0,0,0,0),   P1[10],P1[11],P1[12],P1[13], pw3[0]=PKW(P1,8), pw3[1]=PKW(P1,10), pw3); \
    VRD(7); SBAR(); GAPA(C1=__builtin_amdgcn_mfma_f32_32x32x16_bf16(kf[7],qr[3],C1,0,0,0),   P1[14],P1[15],0.f,0.f,       pw3[2]=PKW(P1,12),pw3[3]=PKW(P1,14), pw3); \
    C0=__builtin_amdgcn_mfma_f32_32x32x16_bf16(kf[8],qx,C0,0,0,0); C1=__builtin_amdgcn_mfma_f32_32x32x16_bf16(kf[9],qx,C1,0,0,0); SBAR(); \
    l_reg+=sacc; \
    if(GK){DMA_K((t)+3,sl_cur);} if(GV){DMA_V((t)+1,sl_next);} \
    CMASK(C0,C1,t); \
    { float a=MX3(C0[0],C0[1],C1[0]),b=MX3(C0[2],C0[3],C1[1]); a=MX3(a,C1[2],C1[3]); \
      _Pragma("unroll") for(int r=4;r<16;r+=4){a=MX3(a,C0[r],C0[r+1]);b=MX3(b,C0[r+2],C0[r+3]);a=MX3(a,C1[r],C1[r+1]);b=MX3(b,C1[r+2],C1[r+3]);} \
      float rm=__builtin_fmaxf(a,b); { auto rr=__builtin_amdgcn_permlane32_swap(__float_as_uint(rm),__float_as_uint(rm),false,false); rm=__builtin_fmaxf(__uint_as_float(rr[0]),__uint_as_float(rr[1])); } \
      resc=false; \
      if(__builtin_expect(__any(rm>(float)THRL),0)){ const float dl=__builtin_fmaxf(rm,0.f); mhat+=dl; \
        _Pragma("unroll") for(int r=0;r<16;++r){C0[r]-=dl;C1[r]-=dl;} \
        qx=mkqx(mhat,hi); \
        const float f=__builtin_amdgcn_exp2f(-dl); l_reg*=f; if(hi==0)wsf[r32]=f; resc=true; } } \
    SBAR(); \
    GAPB(o[0]=__builtin_amdgcn_mfma_f32_32x32x16_bf16(PAF(0),VFR(0),o[0],0,0,0), C0,0); \
    GAPB(o[1]=__builtin_amdgcn_mfma_f32_32x32x16_bf16(PAF(0),VFR(4),o[1],0,0,0), C0,4); \
    KRD(GL,0); GAPB(o[0]=__builtin_amdgcn_mfma_f32_32x32x16_bf16(PAF(1),VFR(1),o[0],0,0,0), C0,8); \
    KRD(GL,1); GAPB(o[1]=__builtin_amdgcn_mfma_f32_32x32x16_bf16(PAF(1),VFR(5),o[1],0,0,0), C0,12); \
    KRD(GL,2); GAPB(o[0]=__builtin_amdgcn_mfma_f32_32x32x16_bf16(PAF(2),VFR(2),o[0],0,0,0), C1,0); \
    KRD(GL,3); GAPB(o[1]=__builtin_amdgcn_mfma_f32_32x32x16_bf16(PAF(2),VFR(6),o[1],0,0,0), C1,4); \
    GAPB(o[0]=__builtin_amdgcn_mfma_f32_32x32x16_bf16(PAF(3),VFR(3),o[0],0,0,0), C1,8); \
    GAPB(o[1]=__builtin_amdgcn_mfma_f32_32x32x16_bf16(PAF(3),VFR(7),o[1],0,0,0), C1,12); \
    }while(0)
  int t=1;
  #undef CMASK
  #define CMASK(P0,P1,t) do{}while(0)
  for(;t+5<NT;t+=2){
    STEP(pB0,pB1,pA0,pA1,t,true,true,true);     WAIT_BAR(3); RESC(); ROT();
    STEP(pA0,pA1,pB0,pB1,t+1,true,true,true);   WAIT_BAR(3); RESC(); ROT();
  }
  #undef CMASK
  #define CMASK(P0,P1,t) do{int jb_=(t)-(NT-4); if(jb_>=0)cmask(P0,P1,jb_,qrel,hi);}while(0)
  #define ENDW(tt) do{ if((tt)+3<NT){WAIT_BAR(3);} else if((tt)+2<NT){WAIT_BAR(1);} else {WAIT_BAR(0);} }while(0)
  for(;t+1<NT;t+=2){
    STEP(pB0,pB1,pA0,pA1,t,(t+3<NT),(t+1<NT),(t+1<NT));       ENDW(t);   RESC(); ROT();
    STEP(pA0,pA1,pB0,pB1,t+1,(t+4<NT),(t+2<NT),(t+2<NT));     ENDW(t+1); RESC(); ROT();
  }
  STEP(pB0,pB1,pA0,pA1,NT-1,false,false,false); RESC();
  { float sacc=pB0[0]+pB0[1]; _Pragma("unroll") for(int r=2;r<16;++r)sacc+=pB0[r]; _Pragma("unroll") for(int r=0;r<16;++r)sacc+=pB1[r]; l_reg+=sacc;
    pw0=(u32x4){PKW(pB0,0),PKW(pB0,2),PKW(pB0,4),PKW(pB0,6)};pw1=(u32x4){PKW(pB0,8),PKW(pB0,10),PKW(pB0,12),PKW(pB0,14)};pw2=(u32x4){PKW(pB1,0),PKW(pB1,2),PKW(pB1,4),PKW(pB1,6)};pw3=(u32x4){PKW(pB1,8),PKW(pB1,10),PKW(pB1,12),PKW(pB1,14)};
    SBAR(); pv(o,vb0+sl_cur,PAF(0),PAF(1),PAF(2),PAF(3)); }
  #undef PKW
  #undef PAF
  #undef VFR
  #undef PIN
  #undef MX3
  #undef GAPA
  #undef GAPB
  #undef EX
  #undef VRD
  #undef KRD
  #undef STEP
  #undef ENDW
  {auto rr=__builtin_amdgcn_permlane32_swap(__float_as_uint(l_reg),__float_as_uint(l_reg),false,false);l_reg=__uint_as_float(rr[0])+__uint_as_float(rr[1]);}
  if(hi==0)wsf[32+r32]=l_reg;asm volatile("s_waitcnt lgkmcnt(0)":::"memory");
  float rli[16];
  #pragma unroll
  for(int r=0;r<16;++r)rli[r]=__builtin_amdgcn_rcpf(wsf[32+crow(r,hi)]);
  bf16*Ow=O+(rowbase+q0+wid*QBLK)*DM+h*D;
  { bf16*stg=(bf16*)(shm+LDS_OST)+wid*2048;
    #pragma unroll
    for(int r=0;r<16;++r){const int orow=crow(r,hi);
      #pragma unroll
      for(int d0=0;d0<2;++d0)stg[orow*64+d0*32+r32]=__float2bfloat16(o[d0][r]*rli[r]);}
    asm volatile("s_waitcnt lgkmcnt(0)":::"memory");
    #pragma unroll
    for(int i=0;i<4;++i){const int row=i*8+(lane>>3),ch=lane&7; const u32x4 v=*(const u32x4*)(stg+row*64+ch*8); ATTN_STORE16(Ow+(long)row*DM+ch*8,v);} }
  asm volatile("s_waitcnt lgkmcnt(0)\n\ts_barrier":::"memory");
  #undef DMA_K
  #undef DMA_V
  #undef CMASK
  #undef START
  #undef RESC
  #undef ROT
}
#undef SBAR
#undef WAIT_BAR
}

__device__ __forceinline__ unsigned f2bf(float f) { unsigned u = __builtin_bit_cast(unsigned, f); return (u + 0x7fffu + ((u >> 16) & 1u)) >> 16; }
__device__ __forceinline__ unsigned pk2(float lo, float hi) { return f2bf(lo) | (f2bf(hi) << 16); }
__device__ __forceinline__ void wg_cumsum_prompt(const float* lf, int b, int h, float* ckw, bf16_t* kxw, LAS float* scr) {
    int tid = threadIdx.x; asm volatile("" : "+v"(tid)); const int lane = tid & 63, wave = tid >> 6;
    const float* src = lf + ((size_t)b * SEQ + 16 * tid) * NH + h;
    float v[16]; float tot = 0.f;
#pragma unroll
    for (int j = 0; j < 16; ++j) { tot += src[j * NH]; v[j] = tot; }
    float sc = tot;
#pragma unroll
    for (int o = 1; o < 64; o <<= 1) { const float t = __shfl_up(sc, o); if (lane >= o) sc += t; }
    if (lane == 63) scr[wave] = sc;
    __syncthreads();
    float base = sc - tot;
#pragma unroll
    for (int w = 0; w < 8; ++w) { const float t = scr[w]; if (w < wave) base += t; }
    float* cd = ckw + 16 * tid; u32x4* kx = (u32x4*)(kxw + (size_t)16 * tid * 16);
#pragma unroll
    for (int j = 0; j < 16; ++j) { const float c2 = (base + v[j]) * LOG2E; cd[j] = c2; const float nv = -c2; const unsigned h1 = f2bf(nv); const float r1 = nv - __uint_as_float(h1 << 16);
        const unsigned h2 = f2bf(r1); const float r2 = r1 - __uint_as_float(h2 << 16); const unsigned h3 = f2bf(r2);
        kx[2 * j] = (u32x4){h1 | (h2 << 16), h3 | 0x3f800000u, 0x3f803f80u, 0u}; kx[2 * j + 1] = (u32x4){0u, 0u, 0u, 0u}; }
    asm volatile("s_waitcnt vmcnt(0)" ::: "memory");
    __syncthreads();
}

__device__ __forceinline__ void transpose_item(const float* W, int K, int Nsrc, int src_n0, int valid, const float* kscale, bf16_t* WT, int dst_row0, LAS float* scr, int kb, int lane) {
    const int k0 = 64 * kb;
#pragma unroll
    for (int i = 0; i < 8; ++i) { const int kk = 8 * i + (lane >> 3), c4 = (lane & 7) * 4;
        f32x4 v = (c4 < valid) ? *(const f32x4*)(W + (size_t)(k0 + kk) * Nsrc + src_n0 + c4) : (f32x4){0.f, 0.f, 0.f, 0.f};
        if (kscale) v *= kscale[k0 + kk];
#pragma unroll
        for (int j = 0; j < 4; ++j) scr[kk * 33 + c4 + j] = (c4 + j < valid) ? v[j] : 0.f; }
    LDS_WAIT(); asm volatile("" ::: "memory");
    const int c = lane & 7;
#pragma unroll
    for (int j = 0; j < 4; ++j) { const int n = (lane >> 3) + 8 * j; const LAS float* s = scr + (8 * c) * 33 + n;
        u32x4 o; o.x = pk2(s[0 * 33], s[1 * 33]); o.y = pk2(s[2 * 33], s[3 * 33]); o.z = pk2(s[4 * 33], s[5 * 33]); o.w = pk2(s[6 * 33], s[7 * 33]);
        *(u32x4*)(WT + (size_t)(dst_row0 + n) * K + k0 + 8 * c) = o; }
    LDS_WAIT(); asm volatile("" ::: "memory");
}

#define XB_TMO      128
#define XB_XCNT(j)  (256  + 64 * (j))
#define XB_XSUB(j)  (1280 + 64 * (j))
#define XB_XGEN(j)  (2304 + 64 * (j))
#define XB_TOP      3328
#define XB_TOPGEN   3392
#define XCD_BAR_WORDS 3456
#define XB_SPIN_CAP (1u << 18)

__device__ __forceinline__ unsigned xb_ld(unsigned* p)              { return __hip_atomic_load(p, __ATOMIC_RELAXED, __HIP_MEMORY_SCOPE_AGENT); }
__device__ __forceinline__ unsigned xb_add(unsigned* p, unsigned v) { return __hip_atomic_fetch_add(p, v, __ATOMIC_RELAXED, __HIP_MEMORY_SCOPE_AGENT); }
__device__ __forceinline__ unsigned xb_xcc_id() { return (unsigned)__builtin_amdgcn_s_getreg((3 << 11) | 20) & 0xFu; }
#define XB_SPIN(cond, bar) do { unsigned _sp = 0; while (cond) { __builtin_amdgcn_s_sleep(1); \
    if ((++_sp & 255u) == 0u) { if (xb_ld(&(bar)[XB_TMO])) break; if (_sp > XB_SPIN_CAP) { atomicAdd(&(bar)[XB_TMO], 1u); break; } } } } while (0)

struct XcdBarrier {
    unsigned* bar; unsigned x;
    volatile LAS unsigned* st;
};

__device__ __forceinline__ XcdBarrier xcd_barrier_post(unsigned* bar, volatile LAS unsigned* st) {
    XcdBarrier b; b.bar = bar; b.x = xb_xcc_id(); b.st = st;
    if (threadIdx.x == 0) (void)xb_add(&bar[XB_XCNT(b.x)], 1u);
    return b;
}
__device__ __forceinline__ void xcd_barrier_complete(unsigned* bar, unsigned x, unsigned& nloc, unsigned& nx) {
    const unsigned G = gridDim.x * gridDim.y * gridDim.z;
    unsigned sum, cnt, mine, sp = 0u;
    for (;;) {
        sum = 0u; cnt = 0u; mine = 0u;
#pragma unroll
        for (unsigned j = 0; j < 16; ++j) { const unsigned c = xb_ld(&bar[XB_XCNT(j)]); sum += c; cnt += (c > 0u) ? 1u : 0u; mine = (j == x) ? c : mine; }
        if (sum == G) break;
        __builtin_amdgcn_s_sleep(1);
        if ((++sp & 255u) == 0u) { if (xb_ld(&bar[XB_TMO])) break; if (sp > XB_SPIN_CAP) { atomicAdd(&bar[XB_TMO], 1u); break; } }
    }
    nloc = mine > 0u ? mine : 1u; nx = cnt > 0u ? cnt : 1u;
}

__device__ __forceinline__ void xcd_barrier(const XcdBarrier& b) {
    asm volatile("s_waitcnt vmcnt(0)" ::: "memory");
    __syncthreads();
    if (threadIdx.x == 0) {
        unsigned* bar = b.bar;
        __builtin_amdgcn_s_waitcnt(0);
        unsigned nloc = b.st[0], nx = b.st[1];
        if (nloc == 0u) { xcd_barrier_complete(bar, b.x, nloc, nx); b.st[0] = nloc; b.st[1] = nx; }
        const unsigned old = xb_add(&bar[XB_XSUB(b.x)], 1u);
        const unsigned gen = old / nloc;
        if (old + 1u == (gen + 1u) * nloc) {
            __builtin_amdgcn_fence(__ATOMIC_RELEASE, "agent");
            asm volatile("s_waitcnt vmcnt(0)" ::: "memory");
            const unsigned og = xb_add(&bar[XB_TOP], 1u);
            const unsigned tg = og / nx;
            if (og + 1u == (tg + 1u) * nx) xb_add(&bar[XB_TOPGEN], 1u);
            else XB_SPIN(xb_ld(&bar[XB_TOPGEN]) == tg, bar);
            __builtin_amdgcn_fence(__ATOMIC_ACQUIRE, "agent");
            xb_add(&bar[XB_XGEN(b.x)], 1u);
            asm volatile("s_waitcnt vmcnt(0)" ::: "memory");
        } else {
            XB_SPIN(xb_ld(&bar[XB_XGEN(b.x)]) == gen, bar);
            __builtin_amdgcn_fence(__ATOMIC_ACQUIRE, "agent");
            asm volatile("s_waitcnt vmcnt(0)" ::: "memory");
        }
    }
    __syncthreads();
}

struct Args { const float* in[28]; float* out; unsigned char* ws; };

__device__ __forceinline__ void s5_tables(const Args& A, int g, int p) {
    const double lre = A.in[11][g * NP + p], lim = A.in[12][g * NP + p], dt = exp((double)A.in[13][g]);
    const double mag = exp(lre * dt); double x = lim * dt;
    const double TWO_PI = 6.283185307179586476925; x -= TWO_PI * rint(x / TWO_PI);
    const double x2 = x * x; double sn = 0.0, cs = 0.0;
#pragma unroll
    for (int k = 14; k >= 0; --k) { sn = sn * x2 * (-1.0 / ((2.0 * k + 2.0) * (2.0 * k + 3.0))) + 1.0; cs = cs * x2 * (-1.0 / ((2.0 * k + 1.0) * (2.0 * k + 2.0))) + 1.0; }
    sn *= x;
    const double ar = mag * cs, ai = mag * sn;
    const double den = lre * lre + lim * lim, nr = ar - 1.0;
    const double zr = (nr * lre + ai * lim) / den, zi = (ai * lre - nr * lim) / den;
    unsigned char* ws = A.ws;
    float* abar = (float*)(ws + WS_ABAR); float* a16 = (float*)(ws + WS_A16); float* a64 = (float*)(ws + WS_A64);
    abar[(g * NP + p) * 2] = (float)ar; abar[(g * NP + p) * 2 + 1] = (float)ai;
    double pr = ar, pi = ai;
#pragma unroll
    for (int s = 0; s < 4; ++s) { const double t = pr * pr - pi * pi; pi = 2.0 * pr * pi; pr = t; }
    a16[(g * NP + p) * 2] = (float)pr; a16[(g * NP + p) * 2 + 1] = (float)pi;
#pragma unroll
    for (int s = 0; s < 2; ++s) { const double t = pr * pr - pi * pi; pi = 2.0 * pr * pi; pr = t; }
    a64[(g * NP + p) * 2] = (float)pr; a64[(g * NP + p) * 2 + 1] = (float)pi;
    bf16_t* bbT = (bf16_t*)(ws + WS_BBT); bf16_t* cmT = (bf16_t*)(ws + WS_CMT);
    const int pb = p >> 5, pp = p & 31;
    const float* bre = A.in[14] + ((size_t)g * NP + p) * 16; const float* bim = A.in[15] + ((size_t)g * NP + p) * 16;
#pragma unroll
    for (int h = 0; h < 16; ++h) {
        const double br = bre[h], bi = bim[h];
        const float vr = (float)(zr * br - zi * bi), vi = (float)(zr * bi + zi * br);
        const int ln = pp + 32 * (h >> 3), i = h & 7;
        bbT[(((size_t)g * 4 + pb) * 64 + ln) * 8 + i] = (bf16_t)f2bf(vr);
        bbT[(((size_t)g * 4 + pb + 2) * 64 + ln) * 8 + i] = (bf16_t)f2bf(vi);
        const float cr = A.in[16][((size_t)g * 16 + h) * NP + p], ci = A.in[17][((size_t)g * 16 + h) * NP + p];
        const int ks = pp >> 4, l2 = h + 16 * ((pp & 15) >> 2), i2 = 2 * (pp & 3);
        cmT[((((size_t)g * 2 + pb) * 2 + ks) * 64 + l2) * 8 + i2] = (bf16_t)f2bf(cr);
        cmT[((((size_t)g * 2 + pb) * 2 + ks) * 64 + l2) * 8 + i2 + 1] = (bf16_t)f2bf(-ci);
    }
}

__device__ __forceinline__ const float* xrow_ptr(const Args& A, int row) { return row < MP ? A.in[0] + (size_t)row * DM : A.in[1] + (size_t)(row - MP) * DM; }

template <int PASS> __device__ __forceinline__ void s5_item(const Args& A, int item, int g, LAS unsigned char* sbuf  , int lane, bool use_carry, float& carry_r, float& carry_i) {
    unsigned char* ws = A.ws;
    const bool samp = item >= NB * NCH; const int n = item / NCH, c = item % NCH, b = item - NB * NCH;
    const int row0 = samp ? MP + 64 * b : n * SEQ + 64 * c;
    const float* ir0 = (const float*)(ws + WS_IR0);
    const float* gm = A.in[8];
    const int n32 = lane & 31, hh = lane >> 5;
    bf16x8 ua[2];
    {
        const int tp = 16 * ((n32 >> 2) & 1) + 4 * (n32 >> 3) + (n32 & 3);
        const f32x4 g0 = *(const f32x4*)(gm + 16 * g + 8 * hh), g1 = *(const f32x4*)(gm + 16 * g + 8 * hh + 4);
#pragma unroll
        for (int tb = 0; tb < 2; ++tb) { const int row = row0 + 32 * tb + tp; const float* xp = xrow_ptr(A, row) + 16 * g + 8 * hh; const float rs = ir0[row];
            const f32x4 x0 = *(const f32x4*)xp * rs * g0, x1 = *(const f32x4*)(xp + 4) * rs * g1;
            u32x4 w; w.x = cvt_pk_bf16(x0[0], x0[1]); w.y = cvt_pk_bf16(x0[2], x0[3]); w.z = cvt_pk_bf16(x1[0], x1[1]); w.w = cvt_pk_bf16(x1[2], x1[3]); ua[tb] = __builtin_bit_cast(bf16x8, w); }
    }
    float hin_r = 0.f, hin_i = 0.f;
    if (PASS == 2) {
        if (samp) { hin_r = A.in[2][((size_t)b * NG + g) * NP + lane]; hin_i = A.in[3][((size_t)b * NG + g) * NP + lane]; }
        else if (use_carry) { hin_r = carry_r; hin_i = carry_i; }
        else {
            const f32x2 a64 = *(const f32x2*)(ws + WS_A64 + ((size_t)(g * NP + lane)) * 8);
            const float* e1 = (const float*)(ws + WS_E1) + (((size_t)(n * NCH) * NG + g) * NP + lane) * 2;
            int cc = 0;
            for (; cc + 16 <= c; cc += 16) { f32x2 e[16];
#pragma unroll
                for (int k = 0; k < 16; ++k) e[k] = *(const f32x2*)(e1 + (size_t)(cc + k) * NG * NP * 2);
#pragma unroll
                for (int k = 0; k < 16; ++k) { const float tr = a64.x * hin_r - a64.y * hin_i + e[k].x; hin_i = a64.x * hin_i + a64.y * hin_r + e[k].y; hin_r = tr; } }
            for (; cc < c; ++cc) { const f32x2 e = *(const f32x2*)(e1 + (size_t)cc * NG * NP * 2);
                const float tr = a64.x * hin_r - a64.y * hin_i + e.x; hin_i = a64.x * hin_i + a64.y * hin_r + e.y; hin_r = tr; }
        }
    }
    f32x4 yacc[4] = {(f32x4){0, 0, 0, 0}, (f32x4){0, 0, 0, 0}, (f32x4){0, 0, 0, 0}, (f32x4){0, 0, 0, 0}};
    const bf16_t* bbT = (const bf16_t*)(ws + WS_BBT); const bf16_t* cmT = (const bf16_t*)(ws + WS_CMT);
#pragma unroll 1
    for (int pb = 0; pb < 2; ++pb) {
        const int p = 32 * pb + n32;
        const bf16x8 Bre = *(const bf16x8*)(bbT + (((size_t)g * 4 + pb) * 64 + lane) * 8), Bim = *(const bf16x8*)(bbT + (((size_t)g * 4 + pb + 2) * 64 + lane) * 8);
        f32x16 xr[2], xi[2];
        const f32x16 z16 = f32x16{};
#pragma unroll
        for (int tb = 0; tb < 2; ++tb) { xr[tb] = __builtin_amdgcn_mfma_f32_32x32x16_bf16(ua[tb], Bre, z16, 0, 0, 0); xi[tb] = __builtin_amdgcn_mfma_f32_32x32x16_bf16(ua[tb], Bim, z16, 0, 0, 0); }
        const f32x2 ab = *(const f32x2*)(ws + WS_ABAR + ((size_t)(g * NP + p)) * 8), a16 = *(const f32x2*)(ws + WS_A16 + ((size_t)(g * NP + p)) * 8);
        const float ar = ab.x, ai = ab.y;
#pragma unroll
        for (int tb = 0; tb < 2; ++tb)
#pragma unroll
            for (int r = 1; r < 16; ++r) { const float pr = xr[tb][r - 1], pi = xi[tb][r - 1];
                xr[tb][r] += ar * pr - ai * pi; xi[tb][r] += ar * pi + ai * pr; }
        float H_r = __shfl(hin_r, p), H_i = __shfl(hin_i, p);
        float Hs_r[2], Hs_i[2];
#pragma unroll
        for (int tb = 0; tb < 2; ++tb) {
            const float er = xr[tb][15], ei = xi[tb][15];
            const float or_ = __shfl_xor(er, 32), oi_ = __shfl_xor(ei, 32);
            const float e0r = hh ? or_ : er, e0i = hh ? oi_ : ei, e1r = hh ? er : or_, e1i = hh ? ei : oi_;
            const float h0r = H_r, h0i = H_i;
            const float h1r = a16.x * h0r - a16.y * h0i + e0r, h1i = a16.x * h0i + a16.y * h0r + e0i;
            const float h2r = a16.x * h1r - a16.y * h1i + e1r, h2i = a16.x * h1i + a16.y * h1r + e1i;
            Hs_r[tb] = hh ? h1r : h0r; Hs_i[tb] = hh ? h1i : h0i;
            H_r = h2r; H_i = h2i;
        }
        if (PASS == 2) { if ((lane >> 5) == pb) { carry_r = H_r; carry_i = H_i; } }
        if (PASS == 1) {
            if (hh == 0) { float* e1 = (float*)(ws + WS_E1) + (((size_t)item * NG + g) * NP + p) * 2; *(f32x2*)e1 = (f32x2){H_r, H_i}; }
        } else {
            if (samp || c == NCH - 1) { if (hh == 0) { const size_t o = samp ? ((size_t)b * NG + g) * NP + p : ((size_t)n * NG + g) * NP + p;
                A.out[(samp ? O_SRE_S : O_SRE_P) + o] = H_r; A.out[(samp ? O_SIM_S : O_SIM_P) + o] = H_i; } }
#pragma unroll
            for (int tb = 0; tb < 2; ++tb) { float cr = Hs_r[tb], ci = Hs_i[tb];
#pragma unroll
                for (int r = 0; r < 16; ++r) { const float t = ar * cr - ai * ci; ci = ar * ci + ai * cr; cr = t;
                    const float sr = xr[tb][r] + cr, si = xi[tb][r] + ci;
                    LAS unsigned* rowp = (LAS unsigned*)(sbuf + (32 * tb + 16 * hh + r) * 144);
                    rowp[n32] = cvt_pk_bf16(sr, si); } }
            LDS_WAIT(); asm volatile("" ::: "memory");
#pragma unroll
            for (int ks = 0; ks < 2; ++ks) { const bf16x8 Bc = *(const bf16x8*)(cmT + ((((size_t)g * 2 + pb) * 2 + ks) * 64 + lane) * 8);
#pragma unroll
                for (int t4 = 0; t4 < 4; ++t4) { const bf16x8 Af = *(const LAS bf16x8*)(sbuf + (16 * t4 + (lane & 15)) * 144 + ks * 64 + (lane >> 4) * 16);
                    yacc[t4] = __builtin_amdgcn_mfma_f32_16x16x32_bf16(Af, Bc, yacc[t4], 0, 0, 0); } }
            LDS_WAIT(); asm volatile("" ::: "memory");
        }
    }
    if (PASS == 2) {
        const int h = lane & 15, ch = 16 * g + h; const float dsk = A.in[18][ch], gmh = gm[ch];
        bf16_t* G = (bf16_t*)(ws + WS_G);
#pragma unroll
        for (int t4 = 0; t4 < 4; ++t4)
#pragma unroll
            for (int r = 0; r < 4; ++r) { const int row = row0 + 16 * t4 + 4 * (lane >> 4) + r;
                const float u = xrow_ptr(A, row)[ch] * ir0[row] * gmh; const float v = yacc[t4][r] + dsk * u;
                G[(size_t)row * DM + ch] = (bf16_t)f2bf(gelu_tanh(v)); }
    }
}

#ifndef PHM
#define PHM 2047
#endif
constexpr int LDS_BYTES = 147456;
constexpr int XCH_OFF = 131072;

__device__ __forceinline__ Args ldargs() {
#if defined(__HIP_DEVICE_COMPILE__)
    const __attribute__((address_space(4))) Args* p = (const __attribute__((address_space(4))) Args*)__builtin_amdgcn_kernarg_segment_ptr(); asm volatile("" : "+s"(p)); return *p;
#else
    return Args{};
#endif
}
#define PHASE_ARGS const Args A = ldargs(); unsigned char* const ws = A.ws; float* const sumsq = (float*)(ws + WS_SS); float* const X = (float*)(ws + WS_X); bf16_t* const XB = (bf16_t*)(ws + WS_XB); \
    int tid_p = threadIdx.x; asm volatile("" : "+v"(tid_p)); const int tid = tid_p, lane = tid & 63, wave = __builtin_amdgcn_readfirstlane(tid >> 6); const int gw = bx * 8 + wave; \
    (void)sumsq; (void)X; (void)XB; (void)lane; (void)gw; (void)ws
__global__ void __launch_bounds__(512, 2) fwd_mega(Args Aparam) {
    extern __shared__ __attribute__((aligned(16))) unsigned char lds[];
    cg::grid_group grid = cg::this_grid();
    LAS unsigned char* L = (LAS unsigned char*)lds;
    const int G = gridDim.x, bx = blockIdx.x, NGW = G * 8;
    volatile LAS unsigned* bst = (volatile LAS unsigned*)(L + 139008);
    if (threadIdx.x == 0) { bst[0] = 0u; bst[1] = 0u; }
    __syncthreads();
    const XcdBarrier xbar = xcd_barrier_post((unsigned*)(ldargs().ws + WS_BAR), bst);
    if (G == 0x7fffffff) grid.sync();

    volatile LAS unsigned long long* TS = (volatile LAS unsigned long long*)(L + 140000);
    int n_ts = 0;
#ifdef PROBE_A
#define STAMP() do { if (threadIdx.x == 0) TS[n_ts] = __builtin_amdgcn_s_memrealtime(); ++n_ts; } while (0)
#else
#define STAMP() do { (void)TS; (void)n_ts; } while (0)
#endif
    STAMP();
    if (PHM & 1) { PHASE_ARGS;
        for (int i = bx * 512 + tid; i < 4 * MT; i += G * 512) sumsq[i] = 0.f;
        if (bx == 0 && tid < 128) ((unsigned*)(ws + WS_CNT))[tid] = 0u;
        LAS float* scr = (LAS float*)(L + wave * 16384);
        constexpr int I_GLU = 16 * 64, I_UG = 16 * 176, I_DN = 44 * 32, I_QKV = 16 * 104, I_WO = 16 * 32;
        constexpr int NW_ITEMS = I_GLU + 2 * I_UG + 2 * I_DN + I_QKV + I_WO;
        for (int it = gw; it < NW_ITEMS; it += NGW) {
            int r = it;
            if (r < I_GLU) { const int kb = r / 64, nb = r % 64, pn = nb >> 3, j = nb & 7; const int src = j < 4 ? 128 * pn + 32 * j : 1024 + 128 * pn + 32 * (j - 4);
                transpose_item(A.in[19], DM, 2048, src, 32, nullptr, (bf16_t*)(ws + WS_WGLU), 32 * nb, scr, kb, lane); continue; } r -= I_GLU;
            if (r < 2 * I_UG) { const int l = r / I_UG; r %= I_UG; const int kb = r / 176, nb = r % 176, pn = nb >> 3, j = nb & 7;
                const float* W = (j < 4 ? A.in[23] : A.in[24]) + (size_t)l * DM * FF; const int src = 128 * pn + 32 * (j & 3);
                transpose_item(W, DM, FF, src, 32, A.in[9] + l * DM, (bf16_t*)(ws + WS_WUG) + (size_t)l * 5632 * DM, 32 * nb, scr, kb, lane); continue; } r -= 2 * I_UG;
            if (r < 2 * I_DN) { const int l = r / I_DN; r %= I_DN; const int kb = r / 32, nb = r % 32;
                transpose_item(A.in[27] + (size_t)l * FF * DM, FF, DM, 32 * nb, 32, nullptr, (bf16_t*)(ws + WS_WDN) + (size_t)l * DM * FF, 32 * nb, scr, kb, lane); continue; } r -= 2 * I_DN;
            if (r < I_QKV) { const int kb = r / 104, nb = r % 104; int valid = 3088 - 32 * nb; valid = valid < 0 ? 0 : (valid > 32 ? 32 : valid);
                transpose_item(A.in[20], DM, 3088, 32 * nb, valid, A.in[8] + DM, (bf16_t*)(ws + WS_WQKV), 32 * nb, scr, kb, lane); continue; } r -= I_QKV;
            { const int kb = r / 32, nb = r % 32; transpose_item(A.in[22], DM, DM, 32 * nb, 32, nullptr, (bf16_t*)(ws + WS_WO), 32 * nb, scr, kb, lane); }
        }
        for (int g = gw; g < NG; g += NGW) s5_tables(A, g, lane);
        float* ir0 = (float*)(ws + WS_IR0);
        for (int m = gw; m < MT; m += NGW) { const f32x4* xr = (const f32x4*)xrow_ptr(A, m) + lane; float s = 0.f;
#pragma unroll
            for (int j = 0; j < 4; ++j) { const f32x4 v = xr[64 * j]; s += (v.x * v.x + v.y * v.y) + (v.z * v.z + v.w * v.w); }
            s = wave_sum(s); if (lane == 0) ir0[m] = __builtin_amdgcn_rsqf(s * (1.0f / DM) + EPS); }
    }
    xcd_barrier(xbar); STAMP();

    if (PHM & 2) { PHASE_ARGS;
        LAS unsigned char* sbuf = L + wave * 9216;
        float cr_ = 0.f, ci_ = 0.f;
        for (int it = gw; it < NB * NCH * NG; it += NGW) { const int item = it / NG, g = it % NG; if ((item % NCH) == NCH - 1) continue; s5_item<1>(A, item, g, sbuf, lane, false, cr_, ci_); }
    }
    xcd_barrier(xbar); STAMP();
    if (PHM & 4) { PHASE_ARGS;
        LAS unsigned char* sbuf = L + wave * 9216;
        { float cr_ = 0.f, ci_ = 0.f;
          for (int it = gw; it < NITEM * NG; it += NGW) { const int item = it / NG, g = it % NG; s5_item<2>(A, item, g, sbuf, lane, false, cr_, ci_); } }
    }
    xcd_barrier(xbar); STAMP();

    if (PHM & 8) { PHASE_ARGS;
        pg8::Gemm g{(const bf16_t*)(ws + WS_G), (const bf16_t*)(ws + WS_WGLU), DM, 16}; pg8::Order<false> S; S.init(MT / 256, 8, G, bx);
        EpiRes<1, true, true, false> E{A.in[0], A.in[1], X, XB, sumsq};
        pg8::gemm_phase(L, g, S, E);
    }
    xcd_barrier(xbar); STAMP();

    { constexpr int layer = 0;
        if (layer == 1) {
            if (PHM & 16) { PHASE_ARGS;
                pg8::Gemm g{XB, (const bf16_t*)(ws + WS_WQKV), DM, 16}; pg8::Order<false> S; S.init(MT / 256, 13, G, bx);
                EpiQKV E{sumsq + 1 * MT, A.in[21], (bf16_t*)(ws + WS_Q), (bf16_t*)(ws + WS_KP), (bf16_t*)(ws + WS_VP), (bf16_t*)(ws + WS_KS), (bf16_t*)(ws + WS_VS), A.out};
                pg8::gemm_phase(L, g, S, E);
            }
            xcd_barrier(xbar); STAMP();
            if (PHM & 64) { PHASE_ARGS;
                const bf16_t* Q = (const bf16_t*)(ws + WS_Q); bf16_t* O = (bf16_t*)(ws + WS_Q);
                const bf16_t* Kp = (const bf16_t*)(ws + WS_KP); const bf16_t* Vp = (const bf16_t*)(ws + WS_VP);
                const bf16_t* Ks = (const bf16_t*)(ws + WS_KS); const bf16_t* Vs = (const bf16_t*)(ws + WS_VS);
                float* ckw = (float*)(ws + WS_CKW) + (size_t)(bx & 255) * SEQ; bf16_t* kxw = (bf16_t*)(ws + WS_KXW) + (size_t)(bx & 255) * SEQ * 16;
                int last_bh = -1;
                for (int idx = bx; idx < 9 * 256; idx += G) {
                    const int i = idx >> 8, v = idx & 255;
                    if (i < 8) { const int bh = v >> 2, s = v & 3, b = bh >> 4, h = bh & 15; const int qb = (i & 1) ? (8 * (i >> 1) + 7 - s) : (8 * (i >> 1) + s);
                        if (bh != last_bh) { wg_cumsum_prompt(A.out + O_LF_P, b, h, ckw, kxw, (LAS float*)L); last_bh = bh; }
                        atf::attn_unit<8>(b, h, qb, (const atf::bf16*)Q, (const atf::bf16*)Kp, (const atf::bf16*)Vp, (atf::bf16*)O, (const atf::bf16*)kxw, ckw, (char*)lds);
                    } else { const int b = v >> 4, h = v & 15;
                        att::attn_unit_sample((char*)lds, Q + ((size_t)MP + 64 * b) * DM + h * HD, A.in[4] + (size_t)b * PAST * DM + h * HD, A.in[5] + (size_t)b * PAST * DM + h * HD,
                                              A.out + O_K_S + (size_t)b * SS * DM + h * HD, A.out + O_V_S + (size_t)b * SS * DM + h * HD, O + ((size_t)MP + 64 * b) * DM + h * HD,
                                              A.in[6] + (size_t)b * PAST * NH + h, A.out + O_LF_S + (size_t)b * SS * NH + h);
                    }
                }
            }
            xcd_barrier(xbar); STAMP();
            if (PHM & 128) { PHASE_ARGS;
                pg8::Gemm g{(const bf16_t*)(ws + WS_Q), (const bf16_t*)(ws + WS_WO), DM, 16}; pg8::Order<false> S; S.init(MT / 256, 4, G, bx);
                EpiRes<0, false, true, false> E{X, X + (size_t)MP * DM, X, XB, sumsq + 2 * MT};
                pg8::gemm_phase(L, g, S, E);
            }
            xcd_barrier(xbar); STAMP();
        }
        if (PHM & 256) { PHASE_ARGS;
            pg8::Gemm g{XB, (const bf16_t*)(ws + WS_WUG) + (size_t)layer * 5632 * DM, DM, 16}; pg8::Order<true> S; S.init(136, 22, G, bx);
            EpiConv E{(bf16_t*)(ws + WS_H), sumsq + (layer == 0 ? 0 : 2 * MT), A.in[25] + (size_t)layer * 3 * FF, A.in[26] + (size_t)layer * FF, A.in[7] + (size_t)layer * SB * 2 * FF,
                      A.out + O_CV_P + (size_t)layer * NB * 2 * FF, A.out + O_CV_S + (size_t)layer * SB * 2 * FF, (LAS float*)(L + XCH_OFF)};
            pg8::gemm_phase(L, g, S, E);
        }
        xcd_barrier(xbar); STAMP();
        if (PHM & 512) { PHASE_ARGS;
            pg8::Gemm g{(const bf16_t*)(ws + WS_H), (const bf16_t*)(ws + WS_WDN) + (size_t)layer * DM * FF, FF, 44}; pg8::Order<false> S; S.init(MP / 256, 4, G, bx);
            pg8::Gemm gt{g.A, g.Bt, FF, 4}; pg8::OrderTail<MP / 256, 4, 4, 11> St{G, bx};
            if (layer == 0) { EpiRes<0, false, true, false> E{X, X + (size_t)MP * DM, X, XB, sumsq + 1 * MT}; pg8::gemm_phase(L, g, S, E);
                EpiSplitK<EpiRes<0, false, true, false>, 11, 4, MP / 256, WS_PDN0, 64> Et{E, ws}; pg8::gemm_phase(L, gt, St, Et); }
            else { EpiRes<0, false, false, true> E{X, X + (size_t)MP * DM, X, XB, sumsq + 3 * MT}; pg8::gemm_phase(L, g, S, E);
                EpiSplitK<EpiRes<0, false, false, true>, 11, 4, MP / 256, WS_PDN1, 96> Et{E, ws}; pg8::gemm_phase(L, gt, St, Et); }
        }
        xcd_barrier(xbar); STAMP();
        }
    { constexpr int layer = 1;
        if (layer == 1) {
            if (PHM & 16) { PHASE_ARGS;
                pg8::Gemm g{XB, (const bf16_t*)(ws + WS_WQKV), DM, 16}; pg8::Order<false> S; S.init(MT / 256, 13, G, bx);
                EpiQKV E{sumsq + 1 * MT, A.in[21], (bf16_t*)(ws + WS_Q), (bf16_t*)(ws + WS_KP), (bf16_t*)(ws + WS_VP), (bf16_t*)(ws + WS_KS), (bf16_t*)(ws + WS_VS), A.out};
                pg8::gemm_phase(L, g, S, E);
            }
            xcd_barrier(xbar); STAMP();
            if (PHM & 64) { PHASE_ARGS;
                const bf16_t* Q = (const bf16_t*)(ws + WS_Q); bf16_t* O = (bf16_t*)(ws + WS_Q);
                const bf16_t* Kp = (const bf16_t*)(ws + WS_KP); const bf16_t* Vp = (const bf16_t*)(ws + WS_VP);
                const bf16_t* Ks = (const bf16_t*)(ws + WS_KS); const bf16_t* Vs = (const bf16_t*)(ws + WS_VS);
                float* ckw = (float*)(ws + WS_CKW) + (size_t)(bx & 255) * SEQ; bf16_t* kxw = (bf16_t*)(ws + WS_KXW) + (size_t)(bx & 255) * SEQ * 16;
                int last_bh = -1;
                for (int idx = bx; idx < 9 * 256; idx += G) {
                    const int i = idx >> 8, v = idx & 255;
                    if (i < 8) { const int bh = v >> 2, s = v & 3, b = bh >> 4, h = bh & 15; const int qb = (i & 1) ? (8 * (i >> 1) + 7 - s) : (8 * (i >> 1) + s);
                        if (bh != last_bh) { wg_cumsum_prompt(A.out + O_LF_P, b, h, ckw, kxw, (LAS float*)L); last_bh = bh; }
                        atf::attn_unit<8>(b, h, qb, (const atf::bf16*)Q, (const atf::bf16*)Kp, (const atf::bf16*)Vp, (atf::bf16*)O, (const atf::bf16*)kxw, ckw, (char*)lds);
                    } else { const int b = v >> 4, h = v & 15;
                        att::attn_unit_sample((char*)lds, Q + ((size_t)MP + 64 * b) * DM + h * HD, A.in[4] + (size_t)b * PAST * DM + h * HD, A.in[5] + (size_t)b * PAST * DM + h * HD,
                                              A.out + O_K_S + (size_t)b * SS * DM + h * HD, A.out + O_V_S + (size_t)b * SS * DM + h * HD, O + ((size_t)MP + 64 * b) * DM + h * HD,
                                              A.in[6] + (size_t)b * PAST * NH + h, A.out + O_LF_S + (size_t)b * SS * NH + h);
                    }
                }
            }
            xcd_barrier(xbar); STAMP();
            if (PHM & 128) { PHASE_ARGS;
                pg8::Gemm g{(const bf16_t*)(ws + WS_Q), (const bf16_t*)(ws + WS_WO), DM, 16}; pg8::Order<false> S; S.init(MT / 256, 4, G, bx);
                EpiRes<0, false, true, false> E{X, X + (size_t)MP * DM, X, XB, sumsq + 2 * MT};
                pg8::gemm_phase(L, g, S, E);
            }
            xcd_barrier(xbar); STAMP();
        }
        if (PHM & 256) { PHASE_ARGS;
            pg8::Gemm g{XB, (const bf16_t*)(ws + WS_WUG) + (size_t)layer * 5632 * DM, DM, 16}; pg8::Order<true> S; S.init(136, 22, G, bx);
            EpiConv E{(bf16_t*)(ws + WS_H), sumsq + (layer == 0 ? 0 : 2 * MT), A.in[25] + (size_t)layer * 3 * FF, A.in[26] + (size_t)layer * FF, A.in[7] + (size_t)layer * SB * 2 * FF,
                      A.out + O_CV_P + (size_t)layer * NB * 2 * FF, A.out + O_CV_S + (size_t)layer * SB * 2 * FF, (LAS float*)(L + XCH_OFF)};
            pg8::gemm_phase(L, g, S, E);
        }
        xcd_barrier(xbar); STAMP();
        if (PHM & 512) { PHASE_ARGS;
            pg8::Gemm g{(const bf16_t*)(ws + WS_H), (const bf16_t*)(ws + WS_WDN) + (size_t)layer * DM * FF, FF, 44}; pg8::Order<false> S; S.init(MP / 256, 4, G, bx);
            pg8::Gemm gt{g.A, g.Bt, FF, 4}; pg8::OrderTail<MP / 256, 4, 4, 11> St{G, bx};
            if (layer == 0) { EpiRes<0, false, true, false> E{X, X + (size_t)MP * DM, X, XB, sumsq + 1 * MT}; pg8::gemm_phase(L, g, S, E);
                EpiSplitK<EpiRes<0, false, true, false>, 11, 4, MP / 256, WS_PDN0, 64> Et{E, ws}; pg8::gemm_phase(L, gt, St, Et); }
            else { EpiRes<0, false, false, true> E{X, X + (size_t)MP * DM, X, XB, sumsq + 3 * MT}; pg8::gemm_phase(L, g, S, E);
                EpiSplitK<EpiRes<0, false, false, true>, 11, 4, MP / 256, WS_PDN1, 96> Et{E, ws}; pg8::gemm_phase(L, gt, St, Et); }
        }
        xcd_barrier(xbar); STAMP();
        }
    if (PHM & 1024) { PHASE_ARGS;
        const float* gf = A.in[10]; const float* ssq = sumsq + 3 * MT;
        for (int m = gw; m < MT; m += NGW) { const float rs = __builtin_amdgcn_rsqf(ssq[m] * (1.0f / DM) + EPS);
            const f32x4* xr = (const f32x4*)(X + (size_t)m * DM) + lane; f32x4* o = (f32x4*)(A.out + O_Y + (size_t)m * DM) + lane; const f32x4* gg = (const f32x4*)gf + lane;
#pragma unroll
            for (int j = 0; j < 4; ++j) o[64 * j] = xr[64 * j] * rs * gg[64 * j]; }
    }
#ifdef PROBE_A
    STAMP();
    if (bx == 0 && threadIdx.x == 0) { const unsigned long long dt = TS[PROBE_B] - TS[PROBE_A], t0 = __builtin_amdgcn_s_memrealtime(); while (__builtin_amdgcn_s_memrealtime() - t0 < dt) __builtin_amdgcn_s_sleep(8); }
#endif
}

extern "C" void kernel_launch(void* const* d_in, const int* in_sizes, int n_in, void* d_out, int out_size, void* d_ws, size_t ws_size, hipStream_t stream) {
    static int grid = 0;
    if (grid == 0) {
        int dev = 0, cus = 0, per_cu = 0;
        hipGetDevice(&dev); hipDeviceGetAttribute(&cus, hipDeviceAttributeMultiprocessorCount, dev);
        hipFuncSetAttribute((const void*)fwd_mega, hipFuncAttributeMaxDynamicSharedMemorySize, LDS_BYTES);
        hipOccupancyMaxActiveBlocksPerMultiprocessor(&per_cu, (const void*)fwd_mega, 512, LDS_BYTES);
        if (per_cu < 1) per_cu = 1;
        grid = cus * 1;
        if (grid <= 0) grid = 256;
    }
    (void)hipMemsetAsync((char*)d_ws + WS_BAR, 0, XCD_BAR_WORDS * 4, stream);
    Args a{};
    for (int i = 0; i < 28; ++i) a.in[i] = (const float*)d_in[i];
    a.out = (float*)d_out; a.ws = (unsigned char*)d_ws;
    void* args[] = {&a};
    hipError_t e = hipLaunchCooperativeKernel((const void*)fwd_mega, dim3(grid), dim3(512), args, LDS_BYTES, stream);
    if (e != hipSuccess) fprintf(stderr, "cooperative launch failed: %s (grid %d)\n", hipGetErrorString(e), grid);
}
```

```cpp
#include <hip/hip_runtime.h>
#include <hip/hip_cooperative_groups.h>
#include <hip/hip_bf16.h>
#include <cstdint>
#include <cstdio>
namespace cg = cooperative_groups;

#define LAS __attribute__((address_space(3)))
typedef unsigned short bf16_t;
typedef short bf16x8 __attribute__((ext_vector_type(8)));
typedef short s16x4 __attribute__((ext_vector_type(4)));
typedef float f32x2 __attribute__((ext_vector_type(2)));
typedef float f32x4 __attribute__((ext_vector_type(4)));
typedef float f32x16 __attribute__((ext_vector_type(16)));
typedef unsigned u32x4 __attribute__((ext_vector_type(4)));
typedef unsigned u32x2 __attribute__((ext_vector_type(2)));

constexpr int DM = 1024, NB = 4, SEQ = 8192, SB = 16, SS = 64, PAST = 4096, KALL = PAST + SS;
constexpr int MP = NB * SEQ, MS = SB * SS, MT = MP + MS;
constexpr int FF = 2816, NH = 16, HD = 64, NG = 64, NP = 64;
constexpr int NQKV = 3328;
constexpr float EPS = 1e-6f;
constexpr float C2 = 0.125f * 1.4426950408889634f;
constexpr float LOG2E = 1.4426950408889634f;
constexpr int NCH = SEQ / 64;
constexpr int NITEM = NB * NCH + SB;

constexpr size_t O_Y = 0;
constexpr size_t O_SRE_P = (size_t)MT * DM;
constexpr size_t O_SIM_P = O_SRE_P + NB * NG * NP;
constexpr size_t O_K_P = O_SIM_P + NB * NG * NP;
constexpr size_t O_V_P = O_K_P + (size_t)MP * DM;
constexpr size_t O_LF_P = O_V_P + (size_t)MP * DM;
constexpr size_t O_CV_P = O_LF_P + (size_t)MP * NH;
constexpr size_t O_SRE_S = O_CV_P + 2 * NB * 2 * FF;
constexpr size_t O_SIM_S = O_SRE_S + SB * NG * NP;
constexpr size_t O_K_S = O_SIM_S + SB * NG * NP;
constexpr size_t O_V_S = O_K_S + (size_t)MS * DM;
constexpr size_t O_LF_S = O_V_S + (size_t)MS * DM;
constexpr size_t O_CV_S = O_LF_S + (size_t)MS * NH;

constexpr size_t MiB = 1u << 20;
constexpr size_t WS_ABAR = 0, WS_A16 = 32768, WS_A64 = 65536, WS_BBT = 131072, WS_CMT = 393216;
constexpr size_t WS_SS = 1 * MiB, WS_IR0 = 2 * MiB, WS_CKP = 3 * MiB, WS_CKS = 5 * MiB;
constexpr size_t WS_WGLU = 10 * MiB, WS_WUG = 14 * MiB, WS_WDN = 36 * MiB, WS_WQKV = 47 * MiB, WS_WO = 54 * MiB;
constexpr size_t WS_X = 64 * MiB, WS_XB = 197 * MiB;
constexpr size_t WS_BIG = 264 * MiB;
constexpr size_t WS_G = WS_BIG, WS_E1 = 346 * MiB, WS_HIN = 362 * MiB;
constexpr size_t WS_H = WS_BIG;
constexpr size_t WS_PG1 = 734 * MiB, WS_PDN0 = 798 * MiB, WS_PWO = 842 * MiB, WS_PDN1 = 874 * MiB;
constexpr size_t WS_BAR = WS_SS + 720896;
constexpr size_t WS_CNT = WS_SS + 655360;
constexpr size_t WS_KX = 718 * MiB;
constexpr size_t WS_KXW = 458 * MiB, WS_CKW = 522 * MiB;
constexpr size_t WS_Q = WS_BIG, WS_KP = 330 * MiB, WS_VP = 394 * MiB, WS_KS = 458 * MiB, WS_VS = 588 * MiB;

__device__ __forceinline__ unsigned cvt_pk_bf16(float lo, float hi) { unsigned r; asm volatile("v_cvt_pk_bf16_f32 %0, %1, %2" : "=v"(r) : "v"(lo), "v"(hi)); return r; }
__device__ __forceinline__ unsigned cvtpk_s(float lo, float hi) { typedef __bf16 bf16x2_t __attribute__((ext_vector_type(2))); f32x2 v = {lo, hi}; bf16x2_t b = __builtin_convertvector(v, bf16x2_t); return __builtin_bit_cast(unsigned, b); }
__device__ __forceinline__ float gelu_tanh(float v) {
    const float t = v * (0.7978845608f + 0.0356774081f * v * v);
    const float e = __builtin_amdgcn_exp2f(-2.8853900818f * t);
    return v * __builtin_amdgcn_rcpf(1.0f + e);
}
__device__ __forceinline__ float sigmoidf_(float v) { const float e = __builtin_amdgcn_exp2f(-LOG2E * v); return __builtin_amdgcn_rcpf(1.0f + e); }
__device__ __forceinline__ float wave_sum(float v) {
#pragma unroll
    for (int o = 1; o < 64; o <<= 1) v += __shfl_xor(v, o);
    return v;
}
template <int CTRL> __device__ __forceinline__ float dppf(float v) { return __int_as_float(__builtin_amdgcn_update_dpp(0, __float_as_int(v), CTRL, 0xf, 0xf, false)); }
#define LDS_WAIT() asm volatile("s_waitcnt lgkmcnt(0)" ::: "memory")

namespace pg8 {
constexpr int BM = 256, BK = 64, HALF = 128, HTB = HALF * BK * 2, STAGE_BYTES = 8 * HTB, NXCD = 8, WGM = 8;
__host__ __device__ __forceinline__ int lds_byte(int r, int c) { const int st = (r >> 4) * 2 + (c >> 5), rr = r & 15, cc = c & 31, ob = rr * 64 + cc * 2; return st * 1024 + (ob ^ (((ob >> 9) & 1) << 5)); }
__host__ __device__ __forceinline__ void stage_rc(int b, int& R, int& C) { const int st = b / 1024, sb = b % 1024, swz = sb ^ (((sb >> 9) & 1) << 5); R = (st >> 1) * 16 + swz / 64; C = (st & 1) * 32 + (swz % 64) / 2; }
__host__ __device__ __forceinline__ int perm32(int rho) { const int n = rho >> 4, i = rho & 15; return 8 * (i >> 2) + 4 * n + (i & 3); }
struct Unit { int pm, pn, ks; };
struct Gemm { const bf16_t* A; const bf16_t* Bt; int K; int nt; };
template <bool FFNROWS> struct Order {
    int nM, nN, nwg, G, c;
    __device__ void init(int nM_, int nN_, int G_, int c_) { nM = nM_; nN = nN_; nwg = nM * nN; G = G_; c = c_; }
    __device__ bool next(int i, Unit& u) const {
        const long L = (long)i * G + c; if (L >= nwg) return false;
        int wgid = (int)L; { const int q = nwg / NXCD, r = nwg % NXCD, xcd = wgid % NXCD, off = wgid / NXCD; wgid = (xcd < r ? xcd * (q + 1) : r * (q + 1) + (xcd - r) * q) + off; }
        const int nig = WGM * nN, gid = wgid / nig, fm = gid * WGM, gsz = (nM - fm) < WGM ? (nM - fm) : WGM;
        u.pm = fm + ((wgid % nig) % gsz); u.pn = (wgid % nig) / gsz; u.ks = 0; return true;
    }
    __device__ __forceinline__ long arow(int pm) const {
        if (!FFNROWS) return (long)pm * BM;
        if (pm < 132) { const int n = pm / 33, R = pm % 33; return (long)n * SEQ + 254 * R - 2; }
        return (long)MP + 256 * (pm - 132);
    }
};

template <int pm0, int nMt, int nN, int S> struct OrderTail {
    int G, c;
    __device__ bool next(int i, Unit& u) const { const long L = (long)i * G + c; if (L >= (long)nMt * nN * S) return false; const int tile = (int)L / S; u.ks = (int)L % S; u.pm = pm0 + tile % nMt; u.pn = tile / nMt; return true; }
    __device__ __forceinline__ long arow(int pm) const { return (long)pm * BM; }
};
template <class Epi, class Sched>
__device__ __forceinline__ void gemm_phase(LAS unsigned char* lds, const Gemm g, const Sched& S, const Epi& E) {
    int tid_ = threadIdx.x; asm volatile("" : "+v"(tid_));
    const int tid = tid_, wid = __builtin_amdgcn_readfirstlane(tid >> 6), lane = tid & 63, wr = wid >> 2, wc = wid & 3, fr = lane & 15, fq = lane >> 4;
    const int K = g.K, nt = g.nt;
    unsigned voffA[2], voffB[2];
#pragma unroll
    for (int i = 0; i < 2; ++i) { int R, C; stage_rc(tid * 16 + i * 8192, R, C); const int Rb = ((R & ~31) + perm32(R & 31));
        voffA[i] = (unsigned)(R * K + C) * 2u; voffB[i] = (unsigned)(Rb * K + C) * 2u; }
    const size_t kstep = (size_t)(BK * 2);
    const size_t hstep = (size_t)HALF * K * 2;
    const size_t tstep = 2 * hstep;
    const size_t rowb = (size_t)K * 2;
    const unsigned ldsw = (unsigned)wid * 1024u;
    const int aoff = lds_byte(wr * 64 + fr, fq * 8), boff = lds_byte(wc * 32 + fr, fq * 8);
#define PG8_SA(b, h) (((b) * 2 + (h)) * HTB)
#define PG8_SB(b, h) ((4 + (b) * 2 + (h)) * HTB)
#define PG8_STAGE(bufoff, gbase, voff) do { _Pragma("unroll") for (int _i = 0; _i < 2; ++_i) \
        __builtin_amdgcn_global_load_lds((const unsigned*)((const char*)(gbase) + (voff)[_i]), (LAS unsigned*)(lds + (bufoff) + ldsw + _i * 8192), 16, 0, 0); } while (0)
#define PG8_LDA(dst, b, h) do { _Pragma("unroll") for (int m = 0; m < 4; ++m) _Pragma("unroll") for (int k = 0; k < 2; ++k) dst[m][k] = *(const LAS bf16x8*)(lds + PG8_SA(b, h) + aoff + m * 2048 + k * 1024); } while (0)
#define PG8_LDB(dst, b, h) do { _Pragma("unroll") for (int n = 0; n < 2; ++n) _Pragma("unroll") for (int k = 0; k < 2; ++k) dst[n][k] = *(const LAS bf16x8*)(lds + PG8_SB(b, h) + boff + n * 2048 + k * 1024); } while (0)
#define PG8_MMA(ai, bj, At, Bt) do { __builtin_amdgcn_s_setprio(1); _Pragma("unroll") for (int m = 0; m < 4; ++m) _Pragma("unroll") for (int n = 0; n < 2; ++n) _Pragma("unroll") for (int k = 0; k < 2; ++k) \
        acc[ai][bj][m][n] = __builtin_amdgcn_mfma_f32_16x16x32_bf16(Bt[n][k], At[m][k], acc[ai][bj][m][n], 0, 0, 0); __builtin_amdgcn_s_setprio(0); } while (0)
#define PG8_WAIT_V(n) asm volatile("s_waitcnt vmcnt(" #n ")" ::: "memory")
#define PG8_WAIT_L(n) asm volatile("s_waitcnt lgkmcnt(" #n ")" ::: "memory")
#define PG8_BAR __builtin_amdgcn_s_barrier()
#define PG8_SCHED __builtin_amdgcn_sched_barrier(0)
    Unit cur, nxt; int ui = 0;
    if (!S.next(0, cur)) return;
    f32x4 acc[2][2][4][2];
#pragma unroll
    for (int a = 0; a < 2; ++a)
#pragma unroll
        for (int b = 0; b < 2; ++b)
#pragma unroll
            for (int m = 0; m < 4; ++m)
#pragma unroll
                for (int n = 0; n < 2; ++n) acc[a][b][m][n] = (f32x4){0.f, 0.f, 0.f, 0.f};
    bf16x8 At[4][2], B0[2][2], B1[2][2];
    const size_t kslice = (size_t)nt * kstep;
    const char* cA = (const char*)g.A + S.arow(cur.pm) * (long)rowb + cur.ks * kslice; const char* cB = (const char*)g.Bt + (size_t)cur.pn * tstep + cur.ks * kslice;
    PG8_STAGE(PG8_SB(0, 0), cB, voffB); PG8_STAGE(PG8_SB(0, 1), cB + hstep, voffB); PG8_STAGE(PG8_SA(0, 0), cA, voffA); PG8_STAGE(PG8_SA(0, 1), cA + hstep, voffA);
    if (wr == 1) PG8_BAR;
    PG8_WAIT_V(2); PG8_BAR;
    PG8_STAGE(PG8_SB(1, 0), cB + kstep, voffB); PG8_STAGE(PG8_SA(1, 0), cA + kstep, voffA); PG8_STAGE(PG8_SB(1, 1), cB + hstep + kstep, voffB);
    PG8_WAIT_V(6); PG8_BAR;
    for (;;) {
        const bool has_next = S.next(ui + 1, nxt);
        const char* nA = has_next ? (const char*)g.A + S.arow(nxt.pm) * (long)rowb + nxt.ks * kslice : cA; const char* nB = has_next ? (const char*)g.Bt + (size_t)nxt.pn * tstep + nxt.ks * kslice : cB;
        for (int t = 0; t < nt; t += 2) {
            const bool last = (t == nt - 2);
            const char* a1 = cA + (size_t)(t + 1) * kstep;
            const char* a2 = last ? nA : cA + (size_t)(t + 2) * kstep; const char* b2 = last ? nB : cB + (size_t)(t + 2) * kstep;
            const char* a3 = a2 + kstep; const char* b3 = b2 + kstep;
            PG8_LDB(B0, 0, 0); PG8_LDB(B1, 0, 1); PG8_SCHED; PG8_LDA(At, 0, 0); PG8_STAGE(PG8_SA(1, 1), a1 + hstep, voffA);
            PG8_WAIT_V(8); PG8_WAIT_L(0); PG8_BAR; PG8_MMA(0, 0, At, B0); PG8_MMA(0, 1, At, B1); PG8_BAR; PG8_SCHED;
            PG8_LDA(At, 0, 1); PG8_STAGE(PG8_SB(0, 0), b2, voffB); PG8_STAGE(PG8_SB(0, 1), b2 + hstep, voffB); PG8_STAGE(PG8_SA(0, 0), a2, voffA);
            PG8_WAIT_V(8); PG8_WAIT_L(0); PG8_BAR; PG8_MMA(1, 0, At, B0); PG8_MMA(1, 1, At, B1); PG8_BAR; PG8_SCHED;
            PG8_LDB(B0, 1, 0); PG8_LDB(B1, 1, 1); PG8_SCHED; PG8_LDA(At, 1, 0); PG8_STAGE(PG8_SA(0, 1), a2 + hstep, voffA);
            PG8_WAIT_V(8); PG8_WAIT_L(0); PG8_BAR; PG8_MMA(0, 0, At, B0); PG8_MMA(0, 1, At, B1); PG8_BAR; PG8_SCHED;
            PG8_LDA(At, 1, 1); PG8_STAGE(PG8_SB(1, 0), b3, voffB); PG8_STAGE(PG8_SB(1, 1), b3 + hstep, voffB); PG8_STAGE(PG8_SA(1, 0), a3, voffA);
            PG8_WAIT_V(8); PG8_WAIT_L(0); PG8_BAR; PG8_MMA(1, 0, At, B0); PG8_MMA(1, 1, At, B1); PG8_BAR; PG8_SCHED;
        }
        if (wr == 0) PG8_BAR;
        { int fr_ = fr, fq_ = fq; asm volatile("" : "+v"(fr_), "+v"(fq_)); E(acc, cur, wr, wc, fr_, fq_); }
        if (!has_next) break;
#pragma unroll
        for (int a = 0; a < 2; ++a)
#pragma unroll
            for (int b = 0; b < 2; ++b)
#pragma unroll
                for (int m = 0; m < 4; ++m)
#pragma unroll
                    for (int n = 0; n < 2; ++n) acc[a][b][m][n] = (f32x4){0.f, 0.f, 0.f, 0.f};
        cur = nxt; cA = nA; cB = nB; ++ui;
        if (wr == 1) PG8_BAR;
    }
    PG8_WAIT_V(0);
    PG8_BAR;
#undef PG8_SA
#undef PG8_SB
#undef PG8_STAGE
#undef PG8_LDA
#undef PG8_LDB
#undef PG8_MMA
#undef PG8_WAIT_V
#undef PG8_WAIT_L
#undef PG8_BAR
#undef PG8_SCHED
}
}


template <int MODE  , bool RES_F32  , bool WRITE_XB, bool WRITE_X> struct EpiRes {
    const float* r0; const float* r1;
    float* X; bf16_t* xb; float* sumsq;
    __device__ __forceinline__ void group(const f32x4 (&a)[2][2], const pg8::Unit& u, int ai, int m, int wr, int wc, int fr, int fq) const {
        const int row = u.pm * 256 + ai * 128 + wr * 64 + m * 16 + fr;
        const float* rp = row < MP ? r0 + (size_t)row * DM : r1 + (size_t)(row - MP) * DM;
        float ss = 0.f;
#pragma unroll
        for (int bj = 0; bj < (MODE == 1 ? 1 : 2); ++bj) {
            const int col = (MODE == 1 ? u.pn * 128 : u.pn * 256 + bj * 128) + wc * 32 + fq * 8;
            f32x4 v0, v1;
            if (MODE == 1) {
#pragma unroll
                for (int j = 0; j < 4; ++j) { v0[j] = a[0][0][j] * sigmoidf_(a[1][0][j]); v1[j] = a[0][1][j] * sigmoidf_(a[1][1][j]); }
            } else { v0 = a[bj][0]; v1 = a[bj][1]; }
            if (RES_F32) { v0 += *(const f32x4*)(rp + col); v1 += *(const f32x4*)(rp + col + 4); }
            else { const u32x4 rb = *(const u32x4*)(xb + (size_t)row * DM + col);
                v0 += (f32x4){__uint_as_float(rb.x << 16), __uint_as_float(rb.x & 0xffff0000u), __uint_as_float(rb.y << 16), __uint_as_float(rb.y & 0xffff0000u)};
                v1 += (f32x4){__uint_as_float(rb.z << 16), __uint_as_float(rb.z & 0xffff0000u), __uint_as_float(rb.w << 16), __uint_as_float(rb.w & 0xffff0000u)}; }
            if (WRITE_X) { *(f32x4*)(X + (size_t)row * DM + col) = v0; *(f32x4*)(X + (size_t)row * DM + col + 4) = v1; }
            if (WRITE_XB) { u32x4 w; w.x = cvt_pk_bf16(v0[0], v0[1]); w.y = cvt_pk_bf16(v0[2], v0[3]); w.z = cvt_pk_bf16(v1[0], v1[1]); w.w = cvt_pk_bf16(v1[2], v1[3]);
                *(u32x4*)(xb + (size_t)row * DM + col) = w; }
            ss += (v0[0] * v0[0] + v0[1] * v0[1]) + (v0[2] * v0[2] + v0[3] * v0[3]) + (v1[0] * v1[0] + v1[1] * v1[1]) + (v1[2] * v1[2] + v1[3] * v1[3]);
        }
        ss += __shfl_xor(ss, 16); ss += __shfl_xor(ss, 32);
        if (fq == 0) atomicAdd(sumsq + row, ss);
    }
    __device__ __forceinline__ void operator()(f32x4 (&acc)[2][2][4][2], const pg8::Unit& u, int wr, int wc, int fr, int fq) const {
#pragma unroll
        for (int ai = 0; ai < 2; ++ai)
#pragma unroll
            for (int m = 0; m < 4; ++m) { const f32x4 a[2][2] = {{acc[ai][0][m][0], acc[ai][0][m][1]}, {acc[ai][1][m][0], acc[ai][1][m][1]}}; group(a, u, ai, m, wr, wc, fr, fq); }
    }
};

template <class Inner, int S, int nN, int pm0, size_t POFF, int COFF> struct EpiSplitK {
    Inner inner; unsigned char* wsb;
    __device__ __forceinline__ void operator()(f32x4 (&acc)[2][2][4][2], const pg8::Unit& u, int wr, int wc, int fr, int fq) const {
        static_assert(S >= 8, "eight row groups need eight slices");
        float* const P = (float*)(wsb + POFF); unsigned* const cnt = (unsigned*)(wsb + WS_CNT) + COFF;
        const int tix = (u.pm - pm0) * nN + u.pn; int tid = threadIdx.x; asm volatile("" : "+v"(tid));
        float* slice = P + ((size_t)tix * S + u.ks) * 65536 + (size_t)tid * 4;
#pragma unroll
        for (int ai = 0; ai < 2; ++ai)
#pragma unroll
            for (int bj = 0; bj < 2; ++bj)
#pragma unroll
                for (int m = 0; m < 4; ++m)
#pragma unroll
                    for (int n = 0; n < 2; ++n) *(f32x4*)(slice + (size_t)(((ai * 2 + bj) * 4 + m) * 2 + n) * 2048) = acc[ai][bj][m][n];
        asm volatile("s_waitcnt vmcnt(0)" ::: "memory");
        __syncthreads();
        if (tid == 0) { __threadfence(); (void)__hip_atomic_fetch_add(cnt + tix, 1u, __ATOMIC_RELAXED, __HIP_MEMORY_SCOPE_AGENT); }
        if (u.ks >= 8) return;
        if (tid == 0) { unsigned sp = 0; while (__hip_atomic_load(cnt + tix, __ATOMIC_RELAXED, __HIP_MEMORY_SCOPE_AGENT) < (unsigned)S) { __builtin_amdgcn_s_sleep(4); if (++sp > (1u << 22)) break; } __threadfence(); }
        __syncthreads();
        const int ai = u.ks >> 2, m = u.ks & 3;
        f32x4 t[2][2] = {{(f32x4){0.f, 0.f, 0.f, 0.f}, (f32x4){0.f, 0.f, 0.f, 0.f}}, {(f32x4){0.f, 0.f, 0.f, 0.f}, (f32x4){0.f, 0.f, 0.f, 0.f}}};
        const float* p0 = P + (size_t)tix * S * 65536 + (size_t)tid * 4;
#pragma unroll
        for (int s = 0; s < S; ++s) {
#pragma unroll
            for (int bj = 0; bj < 2; ++bj)
#pragma unroll
                for (int n = 0; n < 2; ++n) t[bj][n] += __builtin_nontemporal_load((const f32x4*)(p0 + (size_t)s * 65536 + (size_t)(((ai * 2 + bj) * 4 + m) * 2 + n) * 2048));
        }
        inner.group(t, u, ai, m, wr, wc, fr, fq);
    }
};

struct EpiConv {
    bf16_t* H; const float* sumsq; const float* convw; const float* convb; const float* hist; float* outc_p; float* outc_s; LAS float* xch;
    __device__ __forceinline__ void operator()(f32x4 (&acc)[2][2][4][2], const pg8::Unit& u, int wr, int wc, int fr, int fq) const {
        const bool samp = u.pm >= 132;
        int n = 0, tok0 = 0; long grow0;
        if (!samp) { n = u.pm / 33; const int R = u.pm % 33; tok0 = 254 * R - 2; grow0 = (long)n * SEQ + tok0; } else { grow0 = (long)MP + 256 * (u.pm - 132); }
        const int f0 = 128 * u.pn + 32 * wc + 8 * fq;
#pragma unroll
        for (int ai = 0; ai < 2; ++ai)
#pragma unroll
            for (int m = 0; m < 4; ++m) {
                const int i = ai * 128 + wr * 64 + m * 16 + fr; long gr = grow0 + i; if (gr < 0) gr = 0;
                float rs = __builtin_amdgcn_rsqf(sumsq[gr] * (1.0f / DM) + EPS);
                float ra = rs; if (!samp && tok0 + i < 0) ra = 0.f;
#pragma unroll
                for (int nn = 0; nn < 2; ++nn) { acc[ai][0][m][nn] *= ra; acc[ai][1][m][nn] *= rs; }
            }
        if (fr >= 14) {
#pragma unroll
            for (int ai = 0; ai < 2; ++ai) { LAS float* p = xch + ((ai * 2 + wr) * 2 + (fr - 14)) * 128 + 32 * wc + 8 * fq;
                *(LAS f32x4*)p = acc[ai][0][3][0]; *(LAS f32x4*)(p + 4) = acc[ai][0][3][1]; }
        }
        asm volatile("s_waitcnt lgkmcnt(0)\n\ts_barrier" ::: "memory");
#pragma unroll
        for (int nn = 0; nn < 2; ++nn) {
            asm volatile("" ::: "memory");
            const int fc = f0 + 4 * nn;
            const f32x4 w0 = *(const f32x4*)(convw + fc), w1 = *(const f32x4*)(convw + FF + fc), w2 = *(const f32x4*)(convw + 2 * FF + fc), cb = *(const f32x4*)(convb + fc);
#pragma unroll
            for (int ai = 0; ai < 2; ++ai) {
                const int blk = ai * 2 + wr;
                f32x4 prev = (f32x4){0.f, 0.f, 0.f, 0.f};
                if (fr >= 14) {
                    if (samp) { prev = *(const f32x4*)(hist + ((size_t)((4 * (u.pm - 132) + blk) * 2 + (fr - 14))) * FF + fc); }
                    else if (blk > 0) { prev = *(const LAS f32x4*)(xch + (((blk - 1) * 2) + (fr - 14)) * 128 + 32 * wc + 8 * fq + 4 * nn); }
                }
#pragma unroll
                for (int m = 0; m < 4; ++m) {
                    const int i = ai * 128 + wr * 64 + m * 16 + fr; const long gr = grow0 + i;
                    const f32x4 a = acc[ai][0][m][nn], gt = acc[ai][1][m][nn]; f32x4 hv, a1, a2;
#pragma unroll
                    for (int j = 0; j < 4; ++j) {
                        a1[j] = __int_as_float(__builtin_amdgcn_update_dpp(__float_as_int(dppf<0x121>(prev[j])), __float_as_int(a[j]), 0x111, 0xf, 0xf, false));
                        a2[j] = __int_as_float(__builtin_amdgcn_update_dpp(__float_as_int(dppf<0x122>(prev[j])), __float_as_int(a[j]), 0x112, 0xf, 0xf, false));
                    }
                    {
                        const f32x4 cv = w0 * a2 + (w1 * a1 + (w2 * a + cb));
                        const f32x4 tt = cv * (cv * cv * 0.0356774081f + 0.7978845608f) * (-2.8853900818f);
                        f32x4 ee;
#pragma unroll
                        for (int j = 0; j < 4; ++j) ee[j] = __builtin_amdgcn_exp2f(tt[j]);
                        ee = ee + 1.0f;
#pragma unroll
                        for (int j = 0; j < 4; ++j) ee[j] = __builtin_amdgcn_rcpf(ee[j]);
                        hv = cv * ee * gt;
                    }
                    u32x2 wv; wv.x = cvt_pk_bf16(hv[0], hv[1]); wv.y = cvt_pk_bf16(hv[2], hv[3]);
                    const int tok = tok0 + i;
                    const bool valid = samp || (i >= 2 && tok < SEQ);
                    if (valid) *(u32x2*)(H + (size_t)gr * FF + fc) = wv;
                    if (!samp) { if (valid && tok >= SEQ - 2) { float* o = outc_p + ((size_t)(n * 2 + (tok - (SEQ - 2)))) * FF + fc; *(f32x4*)o = a; } }
                    else { if ((i & 63) >= 62) { float* o = outc_s + ((size_t)((4 * (u.pm - 132) + (i >> 6)) * 2 + ((i & 63) - 62))) * FF + fc; *(f32x4*)o = a; } }
                    prev = a;
                }
            }
        }
    }
};

struct EpiQKV {
    const float* sumsq; const float* bf; bf16_t* Q; bf16_t* Kp; bf16_t* Vp; bf16_t* Ks; bf16_t* Vs; float* out;
    __device__ __forceinline__ void operator()(f32x4 (&acc)[2][2][4][2], const pg8::Unit& u, int wr, int wc, int fr, int fq) const {
        const int sec = u.pn >> 2;
#pragma unroll
        for (int ai = 0; ai < 2; ++ai)
#pragma unroll
            for (int m = 0; m < 4; ++m) {
                const int row = u.pm * 256 + ai * 128 + wr * 64 + m * 16 + fr;
                const float rs = __builtin_amdgcn_rsqf(sumsq[row] * (1.0f / DM) + EPS);
                if (sec == 3) {
                    if (wc == 0 && fq < 2) {
                        const f32x4 v0 = acc[ai][0][m][0] * rs, v1 = acc[ai][0][m][1] * rs; f32x4 l0, l1;
#pragma unroll
                        for (int j = 0; j < 4; ++j) { const float x0 = v0[j] + bf[8 * fq + j], x1 = v1[j] + bf[8 * fq + 4 + j];
                            l0[j] = fminf(x0, 0.f) - log1pf(__expf(-fabsf(x0))); l1[j] = fminf(x1, 0.f) - log1pf(__expf(-fabsf(x1))); }
                        float* o = row < MP ? out + O_LF_P + (size_t)row * NH + 8 * fq : out + O_LF_S + (size_t)(row - MP) * NH + 8 * fq;
                        *(f32x4*)o = l0; *(f32x4*)(o + 4) = l1;
                    }
                } else {
#pragma unroll
                    for (int bj = 0; bj < 2; ++bj) {
                        const int col = (u.pn & 3) * 256 + bj * 128 + wc * 32 + fq * 8;
                        const float sc = sec == 0 ? rs * C2 : rs;
                        const f32x4 v0 = acc[ai][bj][m][0] * sc, v1 = acc[ai][bj][m][1] * sc;
                        u32x4 w; w.x = cvt_pk_bf16(v0[0], v0[1]); w.y = cvt_pk_bf16(v0[2], v0[3]); w.z = cvt_pk_bf16(v1[0], v1[1]); w.w = cvt_pk_bf16(v1[2], v1[3]);
                        if (sec == 0) { *(u32x4*)(Q + (size_t)row * DM + col) = w; }
                        else {
                            bf16_t* dst; float* o;
                            if (row < MP) { dst = (sec == 1 ? Kp : Vp) + (size_t)row * DM + col; o = out + (sec == 1 ? O_K_P : O_V_P) + (size_t)row * DM + col; }
                            else { const int rs_ = row - MP; dst = nullptr; o = out + (sec == 1 ? O_K_S : O_V_S) + (size_t)rs_ * DM + col; }
                            if (dst) *(u32x4*)dst = w; __builtin_nontemporal_store(v0, (f32x4*)o); __builtin_nontemporal_store(v1, (f32x4*)(o + 4));
                        }
                    }
                }
            }
    }
};

namespace att {
constexpr int OFF_K = 0, OFF_V = 16384, OFF_CK = 32768, OFF_WSF = 33280, OFF_OST = 35328;
__device__ __forceinline__ int crow(int r, int hi) { return (r & 3) + 8 * (r >> 2) + 4 * hi; }
__device__ __forceinline__ void glds16(const void* gsrc, unsigned lds_dst) { unsigned keep;
    asm volatile("s_mov_b32 %0, m0\n\ts_mov_b32 m0, %2\n\ts_nop 0\n\tglobal_load_lds_dwordx4 %1, off\n\ts_mov_b32 m0, %0" : "=&s"(keep) : "v"(gsrc), "s"(lds_dst) : "memory"); }
__device__ __forceinline__ void glds4(const void* gsrc, unsigned lds_dst) { unsigned keep;
    asm volatile("s_mov_b32 %0, m0\n\ts_mov_b32 m0, %2\n\ts_nop 0\n\tglobal_load_lds_dword %1, off\n\ts_mov_b32 m0, %0" : "=&s"(keep) : "v"(gsrc), "s"(lds_dst) : "memory"); }
__device__ __forceinline__ float max3f(float a, float b, float c) { return __builtin_fmaxf(__builtin_fmaxf(a, b), c); }
#define SBAR() __builtin_amdgcn_sched_barrier(0)
__device__ __forceinline__ void qkt(f32x16& p0, f32x16& p1, const char* Kslot, const bf16x8* qr, const f32x16& negm, int r32, int hi) {
    const char* kb = Kslot + hi * 1024 + r32 * 16;
#pragma unroll
    for (int d0 = 0; d0 < 4; ++d0) {
        const bf16x8 b0 = *reinterpret_cast<const bf16x8*>(kb + d0 * 2048);
        const bf16x8 b1 = *reinterpret_cast<const bf16x8*>(kb + d0 * 2048 + 512);
        if (d0 == 0) { p0 = __builtin_amdgcn_mfma_f32_32x32x16_bf16(b0, qr[0], negm, 0, 0, 0); p1 = __builtin_amdgcn_mfma_f32_32x32x16_bf16(b1, qr[0], negm, 0, 0, 0); }
        else { p0 = __builtin_amdgcn_mfma_f32_32x32x16_bf16(b0, qr[d0], p0, 0, 0, 0); p1 = __builtin_amdgcn_mfma_f32_32x32x16_bf16(b1, qr[d0], p1, 0, 0, 0); } }
}
__device__ __forceinline__ void pv(f32x16* o, int vb, bf16x8 pa0, bf16x8 pa1, bf16x8 pa2, bf16x8 pa3) {
#pragma unroll
    for (int d0 = 0; d0 < 2; ++d0) { s16x4 lo[4], hi[4];
#pragma unroll
        for (int ks = 0; ks < 4; ++ks) {
            asm volatile("ds_read_b64_tr_b16 %0,%1 offset:%c2" : "=&v"(lo[ks]) : "v"(vb), "i"(d0 * 4096 + ks * 1024) : "memory");
            asm volatile("ds_read_b64_tr_b16 %0,%1 offset:%c2" : "=&v"(hi[ks]) : "v"(vb), "i"(d0 * 4096 + ks * 1024 + 512) : "memory"); }
        asm volatile("s_waitcnt lgkmcnt(0)" ::: "memory"); SBAR();
#define PK(k) (bf16x8){lo[k][0], lo[k][1], lo[k][2], lo[k][3], hi[k][0], hi[k][1], hi[k][2], hi[k][3]}
        o[d0] = __builtin_amdgcn_mfma_f32_32x32x16_bf16(pa0, PK(0), o[d0], 0, 0, 0);
        o[d0] = __builtin_amdgcn_mfma_f32_32x32x16_bf16(pa1, PK(1), o[d0], 0, 0, 0);
        o[d0] = __builtin_amdgcn_mfma_f32_32x32x16_bf16(pa2, PK(2), o[d0], 0, 0, 0);
        o[d0] = __builtin_amdgcn_mfma_f32_32x32x16_bf16(pa3, PK(3), o[d0], 0, 0, 0);
#undef PK
    }
}
constexpr int OFF_CKA = 32768, OFF_WSF2 = 49408, OFF_OST2 = 51456;
__device__ __forceinline__ void attn_unit_sample(char* shm, const bf16_t* Q, const float* kc, const float* vc, const float* kn, const float* vn, bf16_t* O, const float* lfc, const float* lfn) {
    int tid_ = threadIdx.x; asm volatile("" : "+v"(tid_));
    const int tid = tid_, lane = tid & 63, r32 = lane & 31, hi = lane >> 5; const int wid = __builtin_amdgcn_readfirstlane(tid >> 6);
    const unsigned lds0 = (unsigned)(uintptr_t)shm;
    float* wsf = (float*)(shm + OFF_WSF2) + wid * 64;
    float* cka = (float*)(shm + OFF_CKA);
    constexpr int NT = KALL / 64, qpos0 = PAST;
    const int vrow = 16 * (wid & 3) + (lane >> 2), vcol = (wid >> 2) * 32 + (lane & 3) * 8;
    f32x4 kreg[4][2], vreg[4][2];
#define LOADT(t, q) do { const float* kp = (t) < PAST / 64 ? kc + ((size_t)(t) * 64 + lane) * DM + wid * 8 : kn + (size_t)lane * DM + wid * 8; \
        const float* vp = (t) < PAST / 64 ? vc + ((size_t)(t) * 64 + vrow) * DM + vcol : vn + (size_t)vrow * DM + vcol; \
        kreg[q][0] = *(const f32x4*)kp; kreg[q][1] = *(const f32x4*)(kp + 4); vreg[q][0] = *(const f32x4*)vp; vreg[q][1] = *(const f32x4*)(vp + 4); } while (0)
#define STORET(slot, q) do { u32x4 kw, vw; kw.x = cvt_pk_bf16(kreg[q][0][0], kreg[q][0][1]); kw.y = cvt_pk_bf16(kreg[q][0][2], kreg[q][0][3]); kw.z = cvt_pk_bf16(kreg[q][1][0], kreg[q][1][1]); kw.w = cvt_pk_bf16(kreg[q][1][2], kreg[q][1][3]); \
        vw.x = cvt_pk_bf16(vreg[q][0][0], vreg[q][0][1]); vw.y = cvt_pk_bf16(vreg[q][0][2], vreg[q][0][3]); vw.z = cvt_pk_bf16(vreg[q][1][0], vreg[q][1][1]); vw.w = cvt_pk_bf16(vreg[q][1][2], vreg[q][1][3]); \
        *(u32x4*)(shm + OFF_K + (slot) * 8192 + wid * 1024 + lane * 16) = kw; *(u32x4*)(shm + OFF_V + (slot) * 8192 + wid * 1024 + lane * 16) = vw; } while (0)
    LOADT(0, 0); LOADT(1, 1); LOADT(2, 2); LOADT(3, 3);
    {
        float v[9]; float tot = 0.f;
#pragma unroll
        for (int j = 0; j < 9; ++j) { const int k = 9 * tid + j; float x = 0.f; if (k < PAST) x = lfc[(size_t)k * NH]; else if (k < KALL) x = lfn[(size_t)(k - PAST) * NH]; tot += x; v[j] = tot; }
        float sc = tot;
#pragma unroll
        for (int o = 1; o < 64; o <<= 1) { const float t = __shfl_up(sc, o); if (lane >= o) sc += t; }
        float* wtot = (float*)(shm + OFF_WSF2);
        if (lane == 63) wtot[wid] = sc;
        asm volatile("s_waitcnt lgkmcnt(0)\n\ts_barrier" ::: "memory");
        float base = sc - tot;
#pragma unroll
        for (int w = 0; w < 8; ++w) { const float t = wtot[w]; if (w < wid) base += t; }
#pragma unroll
        for (int j = 0; j < 9; ++j) { const int k = 9 * tid + j; if (k < KALL) cka[k] = (base + v[j]) * LOG2E; }
        asm volatile("s_waitcnt lgkmcnt(0)\n\ts_barrier" ::: "memory");
    }
    const bool active = wid < 4; const int qw = wid & 1, kh = (wid >> 1) & 1;
    const int vb0 = (int)(lds0 + OFF_V) + ((lane >> 4) & 1) * 32 + (lane & 3) * 8 + (4 * hi + ((lane & 15) >> 2)) * 64 + kh * 2048;
    const bf16_t* Qw = Q + (long)(qw * 32) * DM;
    bf16x8 qr[4];
#pragma unroll
    for (int d0 = 0; d0 < 4; ++d0) qr[d0] = *reinterpret_cast<const bf16x8*>(&Qw[(long)r32 * DM + d0 * 16 + hi * 8]);
    const int qpos = qpos0 + qw * 32 + r32, qmin = qpos0 + qw * 32;
    float mhat = -cka[qpos], l_reg = 0.f;
    f32x16 o[2]; o[0] = f32x16{}; o[1] = f32x16{};
    f32x16 negm;
#pragma unroll
    for (int r = 0; r < 16; ++r) negm[r] = -mhat;
    for (int t0 = 0; t0 < NT; t0 += 4) {
#pragma unroll
      for (int q = 0; q < 4; ++q) {
        const int t = t0 + q; if (t >= NT) break;
        const int slot = q & 1;
        STORET(slot, q);
        if (t + 4 < NT) LOADT(t + 4, q);
        asm volatile("s_waitcnt lgkmcnt(0)\n\ts_barrier" ::: "memory");
        if (active) {
            f32x16 p0;
            { const char* kb = shm + OFF_K + slot * 8192 + hi * 1024 + (r32 + 32 * kh) * 16;
#pragma unroll
              for (int d0 = 0; d0 < 4; ++d0) { const bf16x8 b0 = *reinterpret_cast<const bf16x8*>(kb + d0 * 2048);
                  p0 = __builtin_amdgcn_mfma_f32_32x32x16_bf16(b0, qr[d0], d0 == 0 ? negm : p0, 0, 0, 0); } }
            const float* ckp = cka + 64 * t + 32 * kh;
#pragma unroll
            for (int a = 0; a < 4; ++a) { const f32x4 c0 = *(const f32x4*)(ckp + 8 * a + 4 * hi);
#pragma unroll
                for (int j = 0; j < 4; ++j) p0[4 * a + j] -= c0[j]; }
            if (64 * t + 63 > qmin) {
#pragma unroll
                for (int r = 0; r < 16; ++r) { const int kv = 64 * t + 32 * kh + crow(r, hi); if (kv > qpos) p0[r] = -1e30f; }
            }
            float a = max3f(p0[0], p0[1], p0[2]), b = max3f(p0[3], p0[4], p0[5]);
#pragma unroll
            for (int r = 6; r < 16; r += 2) { a = __builtin_fmaxf(a, p0[r]); b = __builtin_fmaxf(b, p0[r + 1]); }
            float rm = __builtin_fmaxf(a, b); rm = __builtin_fmaxf(rm, __shfl_xor(rm, 32));
            if (__any(rm > 8.f)) {
                const float dl = __builtin_fmaxf(rm, 0.f); mhat += dl;
#pragma unroll
                for (int r = 0; r < 16; ++r) p0[r] -= dl;
#pragma unroll
                for (int r = 0; r < 16; ++r) negm[r] = -mhat;
                const float f = __builtin_amdgcn_exp2f(-dl); l_reg *= f; if (hi == 0) wsf[r32] = f;
                LDS_WAIT();
#pragma unroll
                for (int d_ = 0; d_ < 2; ++d_)
#pragma unroll
                    for (int r = 0; r < 16; ++r) o[d_][r] *= wsf[crow(r, hi)];
            }
            float sacc = 0.f;
#pragma unroll
            for (int r = 0; r < 16; ++r) { p0[r] = __builtin_amdgcn_exp2f(p0[r]); sacc += p0[r]; }
            l_reg += sacc;
            u32x4 pw0, pw1;
            pw0 = (u32x4){cvtpk_s(p0[0], p0[1]), cvtpk_s(p0[2], p0[3]), cvtpk_s(p0[4], p0[5]), cvtpk_s(p0[6], p0[7])};
            pw1 = (u32x4){cvtpk_s(p0[8], p0[9]), cvtpk_s(p0[10], p0[11]), cvtpk_s(p0[12], p0[13]), cvtpk_s(p0[14], p0[15])};
            SBAR();
            { const int vb = vb0 + slot * 8192; const bf16x8 pa0 = __builtin_bit_cast(bf16x8, pw0), pa1 = __builtin_bit_cast(bf16x8, pw1);
#pragma unroll
              for (int d0 = 0; d0 < 2; ++d0) { s16x4 lo[2], hi2[2];
#pragma unroll
                for (int ks = 0; ks < 2; ++ks) {
                    asm volatile("ds_read_b64_tr_b16 %0,%1 offset:%c2" : "=&v"(lo[ks]) : "v"(vb), "i"(d0 * 4096 + ks * 1024) : "memory");
                    asm volatile("ds_read_b64_tr_b16 %0,%1 offset:%c2" : "=&v"(hi2[ks]) : "v"(vb), "i"(d0 * 4096 + ks * 1024 + 512) : "memory"); }
                asm volatile("s_waitcnt lgkmcnt(0)" ::: "memory"); SBAR();
#define PK(k) (bf16x8){lo[k][0], lo[k][1], lo[k][2], lo[k][3], hi2[k][0], hi2[k][1], hi2[k][2], hi2[k][3]}
                o[d0] = __builtin_amdgcn_mfma_f32_32x32x16_bf16(pa0, PK(0), o[d0], 0, 0, 0);
                o[d0] = __builtin_amdgcn_mfma_f32_32x32x16_bf16(pa1, PK(1), o[d0], 0, 0, 0);
#undef PK
              } }
        }
      }
    }
    asm volatile("s_waitcnt lgkmcnt(0)\n\ts_barrier" ::: "memory");
    l_reg += __shfl_xor(l_reg, 32);
    float* mrg = (float*)(shm + OFF_K) + qw * (2 * 32 + 32 * 64);
    if (active && kh == 1) {
        if (hi == 0) { mrg[r32] = mhat; mrg[32 + r32] = l_reg; }
#pragma unroll
        for (int d0 = 0; d0 < 2; ++d0)
#pragma unroll
            for (int r = 0; r < 16; ++r) mrg[64 + (d0 * 16 + r) * 64 + lane] = o[d0][r];
    }
    asm volatile("s_waitcnt lgkmcnt(0)\n\ts_barrier" ::: "memory");
    if (active && kh == 0) {
        const float m1 = mrg[r32], l1 = mrg[32 + r32];
        const float mm = __builtin_fmaxf(mhat, m1), f0 = __builtin_amdgcn_exp2f(mhat - mm), f1 = __builtin_amdgcn_exp2f(m1 - mm);
        const float lt = l_reg * f0 + l1 * f1;
        if (hi == 0) { wsf[r32] = f0 * __builtin_amdgcn_rcpf(lt); wsf[32 + r32] = f1 * __builtin_amdgcn_rcpf(lt); }
        LDS_WAIT();
        bf16_t* Ow = O + (long)(qw * 32) * DM;
        __hip_bfloat16* stg = (__hip_bfloat16*)(shm + OFF_OST2) + wid * 2048;
#pragma unroll
        for (int r = 0; r < 16; ++r) { const int orow = crow(r, hi); const float s0 = wsf[orow], s1 = wsf[32 + orow];
#pragma unroll
            for (int d0 = 0; d0 < 2; ++d0) stg[orow * 64 + d0 * 32 + r32] = __float2bfloat16(o[d0][r] * s0 + mrg[64 + (d0 * 16 + r) * 64 + lane] * s1); }
        LDS_WAIT();
#pragma unroll
        for (int i = 0; i < 4; ++i) { const int row = i * 8 + (lane >> 3), ch = lane & 7; const u32x4 v = *(const u32x4*)(stg + row * 64 + ch * 8); *(u32x4*)(Ow + (long)row * DM + ch * 8) = v; }
    }
    asm volatile("s_waitcnt vmcnt(0) lgkmcnt(0)\n\ts_barrier" ::: "memory");
#undef LOADT
#undef STORET
}
#undef SBAR
}

namespace atf {
using bf16=__hip_bfloat16;
constexpr int SEQ=8192,D=64,DM=1024,NW=8,QBLK=32,QB=QBLK*NW,KVBLK=64;
__device__ __forceinline__ int crow(int r,int hi){return (r&3)+8*(r>>2)+4*hi;}
#define SBAR() __builtin_amdgcn_sched_barrier(0)
__device__ __forceinline__ void cmask(f32x16&p0,f32x16&p1,int jb,int qrel,int hi){
  const float NEG=-INFINITY; int kb=64*jb+4*hi;
  #pragma unroll
  for(int r=0;r<16;++r){int kv=kb+(r&3)+8*(r>>2); if(kv>qrel)p0[r]=NEG; if(kv+32>qrel)p1[r]=NEG;}
}

constexpr int NSLOT=3, SLOTB=8192;
constexpr int LDS_K=0, LDS_V=NSLOT*SLOTB, LDS_X=2*NSLOT*SLOTB, LDS_WS=LDS_X+NSLOT*2048, LDS_OST=LDS_WS+NW*64*4, LDS_BYTES=LDS_OST+NW*4096;
__device__ __forceinline__ void glds16(const void*gsrc,unsigned lds_dst){unsigned keep;
  asm volatile("s_mov_b32 %0, m0\n\ts_mov_b32 m0, %2\n\ts_nop 0\n\tglobal_load_lds_dwordx4 %1, off\n\ts_mov_b32 m0, %0":"=&s"(keep):"v"(gsrc),"s"(lds_dst):"memory");}
__device__ __forceinline__ void glds4(const void*gsrc,unsigned lds_dst){unsigned keep;
  asm volatile("s_mov_b32 %0, m0\n\ts_mov_b32 m0, %2\n\ts_nop 0\n\tglobal_load_lds_dword %1, off\n\ts_mov_b32 m0, %0":"=&s"(keep):"v"(gsrc),"s"(lds_dst):"memory");}
__device__ __forceinline__ bf16x8 mkqx(float mhat,int hi){ const float nv=-mhat; const unsigned h1=(__builtin_bit_cast(unsigned,nv)+0x7fffu+((__builtin_bit_cast(unsigned,nv)>>16)&1u))>>16; const float r1=nv-__builtin_bit_cast(float,h1<<16);
  const unsigned u1=__builtin_bit_cast(unsigned,r1), h2=(u1+0x7fffu+((u1>>16)&1u))>>16; const float r2=r1-__builtin_bit_cast(float,h2<<16); const unsigned u2=__builtin_bit_cast(unsigned,r2), h3=(u2+0x7fffu+((u2>>16)&1u))>>16;
  u32x4 w=hi?(u32x4){0u,0u,0u,0u}:(u32x4){0x3f803f80u,0x3f80u|(h1<<16),h2|(h3<<16),0u}; return __builtin_bit_cast(bf16x8,w); }
__device__ __forceinline__ float max3f(float a,float b,float c){float r;asm("v_max3_f32 %0, %1, %2, %3":"=v"(r):"v"(a),"v"(b),"v"(c));return r;}
__device__ __forceinline__ float max2f(float a,float b){float r;asm("v_max_f32_e32 %0, %1, %2":"=v"(r):"v"(a),"v"(b));return r;}
__device__ __forceinline__ float fadd_s(float a,float b){float r;asm("v_add_f32_e32 %0, %1, %2":"=v"(r):"v"(a),"v"(b));return r;}
__device__ __forceinline__ float fsub_s(float a,float b){float r;asm("v_sub_f32_e32 %0, %1, %2":"=v"(r):"v"(a),"v"(b));return r;}
typedef float f32x2_t __attribute__((ext_vector_type(2))); typedef __bf16 bf16x2_t __attribute__((ext_vector_type(2)));
__device__ __forceinline__ unsigned cvtpk_s(float lo,float hi){f32x2_t v={lo,hi};bf16x2_t b=__builtin_convertvector(v,bf16x2_t);return __builtin_bit_cast(unsigned,b);}
#define WAIT_BAR(N) asm volatile("s_waitcnt vmcnt(" #N ") lgkmcnt(0)\n\ts_barrier":::"memory")

__device__ __forceinline__ void qkt(f32x16&p0,f32x16&p1,const char*Kslot,const char*Xslot,const bf16x8*qr,const bf16x8 qx,const f32x16&negm,int r32,int hi){
  const char*kb=Kslot+hi*1024+r32*16;
  #pragma unroll
  for(int d0=0;d0<4;++d0){
    const bf16x8 b0=*reinterpret_cast<const bf16x8*>(kb+d0*2048);
    const bf16x8 b1=*reinterpret_cast<const bf16x8*>(kb+d0*2048+512);
    if(d0==0){p0=__builtin_amdgcn_mfma_f32_32x32x16_bf16(b0,qr[0],negm,0,0,0);p1=__builtin_amdgcn_mfma_f32_32x32x16_bf16(b1,qr[0],negm,0,0,0);}
    else{p0=__builtin_amdgcn_mfma_f32_32x32x16_bf16(b0,qr[d0],p0,0,0,0);p1=__builtin_amdgcn_mfma_f32_32x32x16_bf16(b1,qr[d0],p1,0,0,0);}}
  { const char*xb=Xslot+hi*1024+r32*16; const bf16x8 x0=*reinterpret_cast<const bf16x8*>(xb), x1=*reinterpret_cast<const bf16x8*>(xb+512);
    p0=__builtin_amdgcn_mfma_f32_32x32x16_bf16(x0,qx,p0,0,0,0);p1=__builtin_amdgcn_mfma_f32_32x32x16_bf16(x1,qx,p1,0,0,0); }
}
typedef __attribute__((address_space(3))) const char* lds_cptr;
typedef short v4i16_t __attribute__((ext_vector_type(4)));
__device__ __forceinline__ void kloadx(bf16x8*kf,lds_cptr xp){ kf[8]=*(const __attribute__((address_space(3))) bf16x8*)(xp); kf[9]=*(const __attribute__((address_space(3))) bf16x8*)(xp+512); }
__device__ __forceinline__ void kload8(bf16x8*kf,lds_cptr kp){
  kf[0]=*(const __attribute__((address_space(3))) bf16x8*)(kp);      kf[1]=*(const __attribute__((address_space(3))) bf16x8*)(kp+512);
  kf[2]=*(const __attribute__((address_space(3))) bf16x8*)(kp+2048); kf[3]=*(const __attribute__((address_space(3))) bf16x8*)(kp+2560);
  kf[4]=*(const __attribute__((address_space(3))) bf16x8*)(kp+4096); kf[5]=*(const __attribute__((address_space(3))) bf16x8*)(kp+4608);
  kf[6]=*(const __attribute__((address_space(3))) bf16x8*)(kp+6144); kf[7]=*(const __attribute__((address_space(3))) bf16x8*)(kp+6656);
}
__device__ __forceinline__ void kload2(bf16x8*kf,lds_cptr kp,int j){ kf[2*j]=*(const __attribute__((address_space(3))) bf16x8*)(kp+j*2048); kf[2*j+1]=*(const __attribute__((address_space(3))) bf16x8*)(kp+j*2048+512); }
__device__ __forceinline__ s16x4 vtr(lds_cptr p){ return __builtin_bit_cast(s16x4,__builtin_amdgcn_ds_read_tr16_b64_v4i16((__attribute__((address_space(3))) v4i16_t*)p)); }
__device__ __forceinline__ float rowmax(const f32x16&p0,const f32x16&p1){
  float a=max3f(p0[0],p0[1],p1[0]),b=max3f(p0[2],p0[3],p1[1]);a=max3f(a,p1[2],p1[3]);
  #pragma unroll
  for(int r=4;r<16;r+=4){a=max3f(a,p0[r],p0[r+1]);b=max3f(b,p0[r+2],p0[r+3]);a=max3f(a,p1[r],p1[r+1]);b=max3f(b,p1[r+2],p1[r+3]);}
  const float m=max2f(a,b);
  auto rr=__builtin_amdgcn_permlane32_swap(__float_as_uint(m),__float_as_uint(m),false,false);
  return max2f(__uint_as_float(rr[0]),__uint_as_float(rr[1]));
}
__device__ __forceinline__ void pv(f32x16*o,int vb,bf16x8 pa0,bf16x8 pa1,bf16x8 pa2,bf16x8 pa3){
  #pragma unroll
  for(int d0=0;d0<2;++d0){s16x4 lo[4],hi[4];
    #pragma unroll
    for(int ks=0;ks<4;++ks){
      asm volatile("ds_read_b64_tr_b16 %0,%1 offset:%c2":"=&v"(lo[ks]):"v"(vb),"i"(d0*4096+ks*1024):"memory");
      asm volatile("ds_read_b64_tr_b16 %0,%1 offset:%c2":"=&v"(hi[ks]):"v"(vb),"i"(d0*4096+ks*1024+512):"memory");}
    asm volatile("s_waitcnt lgkmcnt(0)":::"memory");SBAR();
    #define PK(k) (bf16x8){lo[k][0],lo[k][1],lo[k][2],lo[k][3],hi[k][0],hi[k][1],hi[k][2],hi[k][3]}
    o[d0]=__builtin_amdgcn_mfma_f32_32x32x16_bf16(pa0,PK(0),o[d0],0,0,0);
    o[d0]=__builtin_amdgcn_mfma_f32_32x32x16_bf16(pa1,PK(1),o[d0],0,0,0);
    o[d0]=__builtin_amdgcn_mfma_f32_32x32x16_bf16(pa2,PK(2),o[d0],0,0,0);
    o[d0]=__builtin_amdgcn_mfma_f32_32x32x16_bf16(pa3,PK(3),o[d0],0,0,0);
    #undef PK
  }
}

#ifndef ATTN_STORE16
#define ATTN_STORE16(p,v) (*(u32x4*)(p)=(v))
#endif
template<int THRL> __device__ __forceinline__ void attn_unit(int b,int h,int qb,const bf16*Q,const bf16*__restrict__ K,const bf16*__restrict__ V,bf16*O,const bf16*__restrict__ KX,const float*__restrict__ CK,char*shm){
  int tid_=threadIdx.x; asm volatile("":"+v"(tid_)); const int tid=tid_,lane=tid&63,r32=lane&31,hi=lane>>5; const int wid=__builtin_amdgcn_readfirstlane(tid>>6);
  const long rowbase=(long)b*SEQ; const int q0=qb*QB;
  const bf16*Qw=Q+(rowbase+q0+wid*QBLK)*DM+h*D;
  const bf16*Kh=K+rowbase*DM+h*D,*Vh=V+rowbase*DM+h*D;
  const unsigned lds0=(unsigned)(uintptr_t)shm;
  float*wsf=(float*)(shm+LDS_WS)+wid*64;
  const bf16*ksrc=Kh+(long)lane*DM+wid*8;
  const bf16*vsrc=Vh+(long)(16*(wid&3)+(lane>>2))*DM+(wid>>2)*32+(lane&3)*8;
  const bf16*xsrc=KX+(long)(16*(wid&3)+(lane>>2))*16+(wid>>2)*8+(lane&3)*2;
  const unsigned kdst=lds0+LDS_K+wid*1024, vdst=lds0+LDS_V+wid*1024, xdst=lds0+LDS_X+wid*256;
  #define DMA_K(t,slot) do{ glds16(ksrc+(long)(t)*KVBLK*DM,(unsigned)__builtin_amdgcn_readfirstlane(kdst+(slot))); glds4(xsrc+(long)(t)*KVBLK*16,(unsigned)__builtin_amdgcn_readfirstlane(xdst+((slot)>>2))); }while(0)
  #define DMA_V(t,slot) glds16(vsrc+(long)(t)*KVBLK*DM,(unsigned)__builtin_amdgcn_readfirstlane(vdst+(slot)))
  const int vb0=(int)(lds0+LDS_V)+((lane>>4)&1)*32+(lane&3)*8+(4*hi+((lane&15)>>2))*64;
  const char*Kbase=shm+LDS_K; const char*Xbase=shm+LDS_X; bf16x8 kf[10];
  const lds_cptr shm3=(lds_cptr)shm; const lds_cptr kp0=shm3+LDS_K+hi*1024+r32*16; const lds_cptr xp0=shm3+LDS_X+hi*1024+r32*16; const lds_cptr vp0=shm3+LDS_V+((lane>>4)&1)*32+(lane&3)*8+(4*hi+((lane&15)>>2))*64;
  const int NT=(q0+QB)/KVBLK;
  DMA_K(0,0);DMA_V(0,0);DMA_K(1,SLOTB);
  bf16x8 qr[4];
  #pragma unroll
  for(int d0=0;d0<4;++d0)qr[d0]=*reinterpret_cast<const bf16x8*>(&Qw[(long)r32*DM+d0*16+hi*8]);
  const int qrel=wid*QBLK+r32;
  float mhat=-CK[q0+qrel],l_reg=0.f;f32x16 o[2];o[0]=f32x16{};o[1]=f32x16{};const f32x16 negm=f32x16{};
  bf16x8 qx=mkqx(mhat,hi);
  #define CMASK(P0,P1,t) do{int jb_=(t)-(NT-4); if(jb_>=0)cmask(P0,P1,jb_,qrel,hi);}while(0)
  bool resc=false;
  #define START(P0,P1) do{ const float rm=rowmax(P0,P1); resc=false; \
    { const float dl=rm; mhat=fadd_s(mhat,dl); \
      _Pragma("unroll") for(int r=0;r<16;++r){P0[r]=fsub_s(P0[r],dl);P1[r]=fsub_s(P1[r],dl);} \
      _Pragma("unroll") for(int r=0;r<16;++r)negm[r]=-mhat; asm volatile("":"+v"(negm)); } \
    _Pragma("unroll") for(int r=0;r<16;++r)P0[r]=__builtin_amdgcn_exp2f(P0[r]); }while(0)
  #define RESC() do{ if(resc){ asm volatile("s_waitcnt lgkmcnt(0)":::"memory"); \
      _Pragma("unroll") for(int d_=0;d_<2;++d_) _Pragma("unroll") for(int r=0;r<16;++r)o[d_][r]*=wsf[crow(r,hi)]; } }while(0)
  f32x16 pA0,pA1,pB0,pB1;
  int sl_prev=0,sl_cur=0,sl_next=SLOTB;
  #define ROT() do{sl_prev=sl_cur;sl_cur=sl_next;sl_next=(sl_next==(NSLOT-1)*SLOTB)?0:sl_next+SLOTB;}while(0)
  DMA_K(2,2*SLOTB);
  WAIT_BAR(5);
  qkt(pA0,pA1,Kbase,Xbase,qr,qx,negm,r32,hi);asm volatile("s_nop 15\n\ts_nop 7":"+v"(pA0),"+v"(pA1));CMASK(pA0,pA1,0);
  _Pragma("unroll") for(int r=0;r<16;++r){pA0[r]=__builtin_amdgcn_exp2f(pA0[r]);pA1[r]=__builtin_amdgcn_exp2f(pA1[r]);}
  WAIT_BAR(0);
  DMA_K(3,0);DMA_V(1,SLOTB);
  ROT();
  kload8(kf,kp0+sl_cur); kloadx(kf,xp0+(sl_cur>>2));
  WAIT_BAR(3);
  s16x4 vlo[8],vhi[8]; u32x4 pw0,pw1,pw2,pw3;
  #define PKW(P,B) cvtpk_s(P[B],P[B+1])
  #define PAF(k) __builtin_bit_cast(bf16x8,pw##k)
  #define VFR(i) (bf16x8){vlo[i][0],vlo[i][1],vlo[i][2],vlo[i][3],vhi[i][0],vhi[i][1],vhi[i][2],vhi[i][3]}
  #define PIN(x) asm volatile("":"+v"(x))
  #define MX3(a,b,c) __builtin_fmaxf(__builtin_fmaxf((a),(b)),(c))
  #define GAPA(MF,A0,A1,A2,A3,W0,W1,PW) do{ MF; sacc+=A0; sacc+=A1; sacc+=A2; sacc+=A3; PIN(sacc); W0; W1; PIN(PW); SBAR(); }while(0)
  #define EX(v) __builtin_amdgcn_exp2f(v)
  #define GAPB(MF,X,B) do{ MF; X[B]=EX(X[B]); X[B+1]=EX(X[B+1]); X[B+2]=EX(X[B+2]); X[B+3]=EX(X[B+3]); PIN(X); SBAR(); }while(0)
  #define VRD(i) do{ vlo[i]=vtr(vp_+(((i)>>2)*4096+((i)&3)*1024)); vhi[i]=vtr(vp_+(((i)>>2)*4096+((i)&3)*1024+512)); }while(0)
  #define KRD(G,j) do{ if(G){ kload2(kf,kp0+sl_next,j); if((j)==3) kloadx(kf,xp0+(sl_next>>2)); SBAR(); } }while(0)
  #define STEP(C0,C1,P0,P1,t,GK,GV,GL) do{ SBAR(); \
    const lds_cptr vp_=vp0+sl_prev; \
    VRD(0); SBAR(); float sacc=(P0[0]+P0[1]); \
    GAPA(C0=__builtin_amdgcn_mfma_f32_32x32x16_bf16(kf[0],qr[0],negm,0,0,0), P0[2],P0[3],P0[4],P0[5],     pw0[0]=PKW(P0,0), pw0[1]=PKW(P0,2), pw0); \
    VRD(4); SBAR(); GAPA(C1=__builtin_amdgcn_mfma_f32_32x32x16_bf16(kf[1],qr[0],negm,0,0,0), P0[6],P0[7],P0[8],P0[9],     pw0[2]=PKW(P0,4), pw0[3]=PKW(P0,6), pw0); \
    VRD(1); SBAR(); GAPA(C0=__builtin_amdgcn_mfma_f32_32x32x16_bf16(kf[2],qr[1],C0,0,0,0),   P0[10],P0[11],P0[12],P0[13], pw1[0]=PKW(P0,8), pw1[1]=PKW(P0,10), pw1); \
    VRD(5); SBAR(); GAPA(C1=__builtin_amdgcn_mfma_f32_32x32x16_bf16(kf[3],qr[1],C1,0,0,0),   P0[14],P0[15],P1[0],P1[1],   pw1[2]=PKW(P0,12),pw1[3]=PKW(P0,14), pw1); \
    VRD(2); SBAR(); GAPA(C0=__builtin_amdgcn_mfma_f32_32x32x16_bf16(kf[4],qr[2],C0,0,0,0),   P1[2],P1[3],P1[4],P1[5],     pw2[0]=PKW(P1,0), pw2[1]=PKW(P1,2), pw2); \
    VRD(6); SBAR(); GAPA(C1=__builtin_amdgcn_mfma_f32_32x32x16_bf16(kf[5],qr[2],C1,0,0,0),   P1[6],P1[7],P1[8],P1[9],     pw2[2]=PKW(P1,4), pw2[3]=PKW(P1,6), pw2); \
    VRD(3); SBAR(); GAPA(C0=__builtin_amdgcn_mfma_f32_32x32x16_bf16(kf[6],qr[3],C0,0,0,0),   P1[10],P1[11],P1[12],P1[13], pw3[0]=PKW(P1,8), pw3[1]=PKW(P1,10), pw3); \
    VRD(7); SBAR(); GAPA(C1=__builtin_amdgcn_mfma_f32_32x32x16_bf16(kf[7],qr[3],C1,0,0,0),   P1[14],P1[15],0.f,0.f,       pw3[2]=PKW(P1,12),pw3[3]=PKW(P1,14), pw3); \
    C0=__builtin_amdgcn_mfma_f32_32x32x16_bf16(kf[8],qx,C0,0,0,0); C1=__builtin_amdgcn_mfma_f32_32x32x16_bf16(kf[9],qx,C1,0,0,0); SBAR(); \
    l_reg+=sacc; \
    if(GK){DMA_K((t)+3,sl_cur);} if(GV){DMA_V((t)+1,sl_next);} \
    CMASK(C0,C1,t); \
    { float a=MX3(C0[0],C0[1],C1[0]),b=MX3(C0[2],C0[3],C1[1]); a=MX3(a,C1[2],C1[3]); \
      _Pragma("unroll") for(int r=4;r<16;r+=4){a=MX3(a,C0[r],C0[r+1]);b=MX3(b,C0[r+2],C0[r+3]);a=MX3(a,C1[r],C1[r+1]);b=MX3(b,C1[r+2],C1[r+3]);} \
      float rm=__builtin_fmaxf(a,b); { auto rr=__builtin_amdgcn_permlane32_swap(__float_as_uint(rm),__float_as_uint(rm),false,false); rm=__builtin_fmaxf(__uint_as_float(rr[0]),__uint_as_float(rr[1])); } \
      resc=false; \
      if(__builtin_expect(__any(rm>(float)THRL),0)){ const float dl=__builtin_fmaxf(rm,0.f); mhat+=dl; \
        _Pragma("unroll") for(int r=0;r<16;++r){C0[r]-=dl;C1[r]-=dl;} \
        qx=mkqx(mhat,hi); \
        const float f=__builtin_amdgcn_exp2f(-dl); l_reg*=f; if(hi==0)wsf[r32]=f; resc=true; } } \
    SBAR(); \
    GAPB(o[0]=__builtin_amdgcn_mfma_f32_32x32x16_bf16(PAF(0),VFR(0),o[0],0,0,0), C0,0); \
    GAPB(o[1]=__builtin_amdgcn_mfma_f32_32x32x16_bf16(PAF(0),VFR(4),o[1],0,0,0), C0,4); \
    KRD(GL,0); GAPB(o[0]=__builtin_amdgcn_mfma_f32_32x32x16_bf16(PAF(1),VFR(1),o[0],0,0,0), C0,8); \
    KRD(GL,1); GAPB(o[1]=__builtin_amdgcn_mfma_f32_32x32x16_bf16(PAF(1),VFR(5),o[1],0,0,0), C0,12); \
    KRD(GL,2); GAPB(o[0]=__builtin_amdgcn_mfma_f32_32x32x16_bf16(PAF(2),VFR(2),o[0],0,0,0), C1,0); \
    KRD(GL,3); GAPB(o[1]=__builtin_amdgcn_mfma_f32_32x32x16_bf16(PAF(2),VFR(6),o[1],0,0,0), C1,4); \
    GAPB(o[0]=__builtin_amdgcn_mfma_f32_32x32x16_bf16(PAF(3),VFR(3),o[0],0,0,0), C1,8); \
    GAPB(o[1]=__builtin_amdgcn_mfma_f32_32x32x16_bf16(PAF(3),VFR(7),o[1],0,0,0), C1,12); \
    }while(0)
  int t=1;
  #undef CMASK
  #define CMASK(P0,P1,t) do{}while(0)
  for(;t+5<NT;t+=2){
    STEP(pB0,pB1,pA0,pA1,t,true,true,true);     WAIT_BAR(3); RESC(); ROT();
    STEP(pA0,pA1,pB0,pB1,t+1,true,true,true);   WAIT_BAR(3); RESC(); ROT();
  }
  #undef CMASK
  #define CMASK(P0,P1,t) do{int jb_=(t)-(NT-4); if(jb_>=0)cmask(P0,P1,jb_,qrel,hi);}while(0)
  #define ENDW(tt) do{ if((tt)+3<NT){WAIT_BAR(3);} else if((tt)+2<NT){WAIT_BAR(1);} else {WAIT_BAR(0);} }while(0)
  for(;t+1<NT;t+=2){
    STEP(pB0,pB1,pA0,pA1,t,(t+3<NT),(t+1<NT),(t+1<NT));       ENDW(t);   RESC(); ROT();
    STEP(pA0,pA1,pB0,pB1,t+1,(t+4<NT),(t+2<NT),(t+2<NT));     ENDW(t+1); RESC(); ROT();
  }
  STEP(pB0,pB1,pA0,pA1,NT-1,false,false,false); RESC();
  { float sacc=pB0[0]+pB0[1]; _Pragma("unroll") for(int r=2;r<16;++r)sacc+=pB0[r]; _Pragma("unroll") for(int r=0;r<16;++r)sacc+=pB1[r]; l_reg+=sacc;
    pw0=(u32x4){PKW(pB0,0),PKW(pB0,2),PKW(pB0,4),PKW(pB0,6)};pw1=(u32x4){PKW(pB0,8),PKW(pB0,10),PKW(pB0,12),PKW(pB0,14)};pw2=(u32x4){PKW(pB1,0),PKW(pB1,2),PKW(pB1,4),PKW(pB1,6)};pw3=(u32x4){PKW(pB1,8),PKW(pB1,10),PKW(pB1,12),PKW(pB1,14)};
    SBAR(); pv(o,vb0+sl_cur,PAF(0),PAF(1),PAF(2),PAF(3)); }
  #undef PKW
  #undef PAF
  #undef VFR
  #undef PIN
  #undef MX3
  #undef GAPA
  #undef GAPB
  #undef EX
  #undef VRD
  #undef KRD
  #undef STEP
  #undef ENDW
  {auto rr=__builtin_amdgcn_permlane32_swap(__float_as_uint(l_reg),__float_as_uint(l_reg),false,false);l_reg=__uint_as_float(rr[0])+__uint_as_float(rr[1]);}
  if(hi==0)wsf[32+r32]=l_reg;asm volatile("s_waitcnt lgkmcnt(0)":::"memory");
  float rli[16];
  #pragma unroll
  for(int r=0;r<16;++r)rli[r]=__builtin_amdgcn_rcpf(wsf[32+crow(r,hi)]);
  bf16*Ow=O+(rowbase+q0+wid*QBLK)*DM+h*D;
  { bf16*stg=(bf16*)(shm+LDS_OST)+wid*2048;
    #pragma unroll
    for(int r=0;r<16;++r){const int orow=crow(r,hi);
      #pragma unroll
      for(int d0=0;d0<2;++d0)stg[orow*64+d0*32+r32]=__float2bfloat16(o[d0][r]*rli[r]);}
    asm volatile("s_waitcnt lgkmcnt(0)":::"memory");
    #pragma unroll
    for(int i=0;i<4;++i){const int row=i*8+(lane>>3),ch=lane&7; const u32x4 v=*(const u32x4*)(stg+row*64+ch*8); ATTN_STORE16(Ow+(long)row*DM+ch*8,v);} }
  asm volatile("s_waitcnt lgkmcnt(0)\n\ts_barrier":::"memory");
  #undef DMA_K
  #undef DMA_V
  #undef CMASK
  #undef START
  #undef RESC
  #undef ROT
}
#undef SBAR
#undef WAIT_BAR
}

__device__ __forceinline__ unsigned f2bf(float f) { unsigned u = __builtin_bit_cast(unsigned, f); return (u + 0x7fffu + ((u >> 16) & 1u)) >> 16; }
__device__ __forceinline__ unsigned pk2(float lo, float hi) { return f2bf(lo) | (f2bf(hi) << 16); }
__device__ __forceinline__ void wg_cumsum_prompt(const float* lf, int b, int h, float* ckw, bf16_t* kxw, LAS float* scr) {
    int tid = threadIdx.x; asm volatile("" : "+v"(tid)); const int lane = tid & 63, wave = tid >> 6;
    const float* src = lf + ((size_t)b * SEQ + 16 * tid) * NH + h;
    float v[16]; float tot = 0.f;
#pragma unroll
    for (int j = 0; j < 16; ++j) { tot += src[j * NH]; v[j] = tot; }
    float sc = tot;
#pragma unroll
    for (int o = 1; o < 64; o <<= 1) { const float t = __shfl_up(sc, o); if (lane >= o) sc += t; }
    if (lane == 63) scr[wave] = sc;
    __syncthreads();
    float base = sc - tot;
#pragma unroll
    for (int w = 0; w < 8; ++w) { const float t = scr[w]; if (w < wave) base += t; }
    float* cd = ckw + 16 * tid; u32x4* kx = (u32x4*)(kxw + (size_t)16 * tid * 16);
#pragma unroll
    for (int j = 0; j < 16; ++j) { const float c2 = (base + v[j]) * LOG2E; cd[j] = c2; const float nv = -c2; const unsigned h1 = f2bf(nv); const float r1 = nv - __uint_as_float(h1 << 16);
        const unsigned h2 = f2bf(r1); const float r2 = r1 - __uint_as_float(h2 << 16); const unsigned h3 = f2bf(r2);
        kx[2 * j] = (u32x4){h1 | (h2 << 16), h3 | 0x3f800000u, 0x3f803f80u, 0u}; kx[2 * j + 1] = (u32x4){0u, 0u, 0u, 0u}; }
    asm volatile("s_waitcnt vmcnt(0)" ::: "memory");
    __syncthreads();
}

__device__ __forceinline__ void transpose_item(const float* W, int K, int Nsrc, int src_n0, int valid, const float* kscale, bf16_t* WT, int dst_row0, LAS float* scr, int kb, int lane) {
    const int k0 = 64 * kb;
#pragma unroll
    for (int i = 0; i < 8; ++i) { const int kk = 8 * i + (lane >> 3), c4 = (lane & 7) * 4;
        f32x4 v = (c4 < valid) ? *(const f32x4*)(W + (size_t)(k0 + kk) * Nsrc + src_n0 + c4) : (f32x4){0.f, 0.f, 0.f, 0.f};
        if (kscale) v *= kscale[k0 + kk];
#pragma unroll
        for (int j = 0; j < 4; ++j) scr[kk * 33 + c4 + j] = (c4 + j < valid) ? v[j] : 0.f; }
    LDS_WAIT(); asm volatile("" ::: "memory");
    const int c = lane & 7;
#pragma unroll
    for (int j = 0; j < 4; ++j) { const int n = (lane >> 3) + 8 * j; const LAS float* s = scr + (8 * c) * 33 + n;
        u32x4 o; o.x = pk2(s[0 * 33], s[1 * 33]); o.y = pk2(s[2 * 33], s[3 * 33]); o.z = pk2(s[4 * 33], s[5 * 33]); o.w = pk2(s[6 * 33], s[7 * 33]);
        *(u32x4*)(WT + (size_t)(dst_row0 + n) * K + k0 + 8 * c) = o; }
    LDS_WAIT(); asm volatile("" ::: "memory");
}

#define XB_TMO      128
#define XB_XCNT(j)  (256  + 64 * (j))
#define XB_XSUB(j)  (1280 + 64 * (j))
#define XB_XGEN(j)  (2304 + 64 * (j))
#define XB_TOP      3328
#define XB_TOPGEN   3392
#define XCD_BAR_WORDS 3456
#define XB_SPIN_CAP (1u << 18)

__device__ __forceinline__ unsigned xb_ld(unsigned* p)              { return __hip_atomic_load(p, __ATOMIC_RELAXED, __HIP_MEMORY_SCOPE_AGENT); }
__device__ __forceinline__ unsigned xb_add(unsigned* p, unsigned v) { return __hip_atomic_fetch_add(p, v, __ATOMIC_RELAXED, __HIP_MEMORY_SCOPE_AGENT); }
__device__ __forceinline__ unsigned xb_xcc_id() { return (unsigned)__builtin_amdgcn_s_getreg((3 << 11) | 20) & 0xFu; }
#define XB_SPIN(cond, bar) do { unsigned _sp = 0; while (cond) { __builtin_amdgcn_s_sleep(1); \
    if ((++_sp & 255u) == 0u) { if (xb_ld(&(bar)[XB_TMO])) break; if (_sp > XB_SPIN_CAP) { atomicAdd(&(bar)[XB_TMO], 1u); break; } } } } while (0)

struct XcdBarrier {
    unsigned* bar; unsigned x;
    volatile LAS unsigned* st;
};

__device__ __forceinline__ XcdBarrier xcd_barrier_post(unsigned* bar, volatile LAS unsigned* st) {
    XcdBarrier b; b.bar = bar; b.x = xb_xcc_id(); b.st = st;
    if (threadIdx.x == 0) (void)xb_add(&bar[XB_XCNT(b.x)], 1u);
    return b;
}
__device__ __forceinline__ void xcd_barrier_complete(unsigned* bar, unsigned x, unsigned& nloc, unsigned& nx) {
    const unsigned G = gridDim.x * gridDim.y * gridDim.z;
    unsigned sum, cnt, mine, sp = 0u;
    for (;;) {
        sum = 0u; cnt = 0u; mine = 0u;
#pragma unroll
        for (unsigned j = 0; j < 16; ++j) { const unsigned c = xb_ld(&bar[XB_XCNT(j)]); sum += c; cnt += (c > 0u) ? 1u : 0u; mine = (j == x) ? c : mine; }
        if (sum == G) break;
        __builtin_amdgcn_s_sleep(1);
        if ((++sp & 255u) == 0u) { if (xb_ld(&bar[XB_TMO])) break; if (sp > XB_SPIN_CAP) { atomicAdd(&bar[XB_TMO], 1u); break; } }
    }
    nloc = mine > 0u ? mine : 1u; nx = cnt > 0u ? cnt : 1u;
}

__device__ __forceinline__ void xcd_barrier(const XcdBarrier& b) {
    asm volatile("s_waitcnt vmcnt(0)" ::: "memory");
    __syncthreads();
    if (threadIdx.x == 0) {
        unsigned* bar = b.bar;
        __builtin_amdgcn_s_waitcnt(0);
        unsigned nloc = b.st[0], nx = b.st[1];
        if (nloc == 0u) { xcd_barrier_complete(bar, b.x, nloc, nx); b.st[0] = nloc; b.st[1] = nx; }
        const unsigned old = xb_add(&bar[XB_XSUB(b.x)], 1u);
        const unsigned gen = old / nloc;
        if (old + 1u == (gen + 1u) * nloc) {
            __builtin_amdgcn_fence(__ATOMIC_RELEASE, "agent");
            asm volatile("s_waitcnt vmcnt(0)" ::: "memory");
            const unsigned og = xb_add(&bar[XB_TOP], 1u);
            const unsigned tg = og / nx;
            if (og + 1u == (tg + 1u) * nx) xb_add(&bar[XB_TOPGEN], 1u);
            else XB_SPIN(xb_ld(&bar[XB_TOPGEN]) == tg, bar);
            __builtin_amdgcn_fence(__ATOMIC_ACQUIRE, "agent");
            xb_add(&bar[XB_XGEN(b.x)], 1u);
            asm volatile("s_waitcnt vmcnt(0)" ::: "memory");
        } else {
            XB_SPIN(xb_ld(&bar[XB_XGEN(b.x)]) == gen, bar);
            __builtin_amdgcn_fence(__ATOMIC_ACQUIRE, "agent");
            asm volatile("s_waitcnt vmcnt(0)" ::: "memory");
        }
    }
    __syncthreads();
}

struct Args { const float* in[28]; float* out; unsigned char* ws; };

__device__ __forceinline__ void s5_tables(const Args& A, int g, int p) {
    const double lre = A.in[11][g * NP + p], lim = A.in[12][g * NP + p], dt = exp((double)A.in[13][g]);
    const double mag = exp(lre * dt); double x = lim * dt;
    const double TWO_PI = 6.283185307179586476925; x -= TWO_PI * rint(x / TWO_PI);
    const double x2 = x * x; double sn = 0.0, cs = 0.0;
#pragma unroll
    for (int k = 14; k >= 0; --k) { sn = sn * x2 * (-1.0 / ((2.0 * k + 2.0) * (2.0 * k + 3.0))) + 1.0; cs = cs * x2 * (-1.0 / ((2.0 * k + 1.0) * (2.0 * k + 2.0))) + 1.0; }
    sn *= x;
    const double ar = mag * cs, ai = mag * sn;
    const double den = lre * lre + lim * lim, nr = ar - 1.0;
    const double zr = (nr * lre + ai * lim) / den, zi = (ai * lre - nr * lim) / den;
    unsigned char* ws = A.ws;
    float* abar = (float*)(ws + WS_ABAR); float* a16 = (float*)(ws + WS_A16); float* a64 = (float*)(ws + WS_A64);
    abar[(g * NP + p) * 2] = (float)ar; abar[(g * NP + p) * 2 + 1] = (float)ai;
    double pr = ar, pi = ai;
#pragma unroll
    for (int s = 0; s < 4; ++s) { const double t = pr * pr - pi * pi; pi = 2.0 * pr * pi; pr = t; }
    a16[(g * NP + p) * 2] = (float)pr; a16[(g * NP + p) * 2 + 1] = (float)pi;
#pragma unroll
    for (int s = 0; s < 2; ++s) { const double t = pr * pr - pi * pi; pi = 2.0 * pr * pi; pr = t; }
    a64[(g * NP + p) * 2] = (float)pr; a64[(g * NP + p) * 2 + 1] = (float)pi;
    bf16_t* bbT = (bf16_t*)(ws + WS_BBT); bf16_t* cmT = (bf16_t*)(ws + WS_CMT);
    const int pb = p >> 5, pp = p & 31;
    const float* bre = A.in[14] + ((size_t)g * NP + p) * 16; const float* bim = A.in[15] + ((size_t)g * NP + p) * 16;
#pragma unroll
    for (int h = 0; h < 16; ++h) {
        const double br = bre[h], bi = bim[h];
        const float vr = (float)(zr * br - zi * bi), vi = (float)(zr * bi + zi * br);
        const int ln = pp + 32 * (h >> 3), i = h & 7;
        bbT[(((size_t)g * 4 + pb) * 64 + ln) * 8 + i] = (bf16_t)f2bf(vr);
        bbT[(((size_t)g * 4 + pb + 2) * 64 + ln) * 8 + i] = (bf16_t)f2bf(vi);
        const float cr = A.in[16][((size_t)g * 16 + h) * NP + p], ci = A.in[17][((size_t)g * 16 + h) * NP + p];
        const int ks = pp >> 4, l2 = h + 16 * ((pp & 15) >> 2), i2 = 2 * (pp & 3);
        cmT[((((size_t)g * 2 + pb) * 2 + ks) * 64 + l2) * 8 + i2] = (bf16_t)f2bf(cr);
        cmT[((((size_t)g * 2 + pb) * 2 + ks) * 64 + l2) * 8 + i2 + 1] = (bf16_t)f2bf(-ci);
    }
}

__device__ __forceinline__ const float* xrow_ptr(const Args& A, int row) { return row < MP ? A.in[0] + (size_t)row * DM : A.in[1] + (size_t)(row - MP) * DM; }

template <int PASS> __device__ __forceinline__ void s5_item(const Args& A, int item, int g, LAS unsigned char* sbuf  , int lane, bool use_carry, float& carry_r, float& carry_i, LAS float* ubuf  ) {
    unsigned char* ws = A.ws;
    const bool samp = item >= NB * NCH; const int n = item / NCH, c = item % NCH, b = item - NB * NCH;
    const int row0 = samp ? MP + 64 * b : n * SEQ + 64 * c;
    const float* ir0 = (const float*)(ws + WS_IR0);
    const float* gm = A.in[8];
    const int n32 = lane & 31, hh = lane >> 5;
    bf16x8 ua[2];
    {
        const int tp = 16 * ((n32 >> 2) & 1) + 4 * (n32 >> 3) + (n32 & 3);
        const f32x4 g0 = *(const f32x4*)(gm + 16 * g + 8 * hh), g1 = *(const f32x4*)(gm + 16 * g + 8 * hh + 4);
#pragma unroll
        for (int tb = 0; tb < 2; ++tb) { const int row = row0 + 32 * tb + tp; const float* xp = xrow_ptr(A, row) + 16 * g + 8 * hh; const float rs = ir0[row];
            const f32x4 x0 = *(const f32x4*)xp * rs * g0, x1 = *(const f32x4*)(xp + 4) * rs * g1;
            if (PASS == 2) { LAS float* up = ubuf + (32 * tb + tp) * 16 + 8 * hh; *(LAS f32x4*)up = x0; *(LAS f32x4*)(up + 4) = x1; }
            u32x4 w; w.x = cvt_pk_bf16(x0[0], x0[1]); w.y = cvt_pk_bf16(x0[2], x0[3]); w.z = cvt_pk_bf16(x1[0], x1[1]); w.w = cvt_pk_bf16(x1[2], x1[3]); ua[tb] = __builtin_bit_cast(bf16x8, w); }
    }
    float hin_r = 0.f, hin_i = 0.f;
    if (PASS == 2) {
        if (samp) { hin_r = A.in[2][((size_t)b * NG + g) * NP + lane]; hin_i = A.in[3][((size_t)b * NG + g) * NP + lane]; }
        else if (use_carry) { hin_r = carry_r; hin_i = carry_i; }
        else if (c > 0) { const f32x2 hv = *(const f32x2*)((const float*)(ws + WS_HIN) + (((size_t)item * NG + g) * NP + lane) * 2); hin_r = hv.x; hin_i = hv.y; }
    }
    f32x4 yacc[4] = {(f32x4){0, 0, 0, 0}, (f32x4){0, 0, 0, 0}, (f32x4){0, 0, 0, 0}, (f32x4){0, 0, 0, 0}};
    const bf16_t* bbT = (const bf16_t*)(ws + WS_BBT); const bf16_t* cmT = (const bf16_t*)(ws + WS_CMT);
#pragma unroll 1
    for (int pb = 0; pb < 2; ++pb) {
        const int p = 32 * pb + n32;
        const bf16x8 Bre = *(const bf16x8*)(bbT + (((size_t)g * 4 + pb) * 64 + lane) * 8), Bim = *(const bf16x8*)(bbT + (((size_t)g * 4 + pb + 2) * 64 + lane) * 8);
        f32x16 xr[2], xi[2];
        const f32x16 z16 = f32x16{};
#pragma unroll
        for (int tb = 0; tb < 2; ++tb) { xr[tb] = __builtin_amdgcn_mfma_f32_32x32x16_bf16(ua[tb], Bre, z16, 0, 0, 0); xi[tb] = __builtin_amdgcn_mfma_f32_32x32x16_bf16(ua[tb], Bim, z16, 0, 0, 0); }
        const f32x2 ab = *(const f32x2*)(ws + WS_ABAR + ((size_t)(g * NP + p)) * 8), a16 = *(const f32x2*)(ws + WS_A16 + ((size_t)(g * NP + p)) * 8);
        const float ar = ab.x, ai = ab.y;
#pragma unroll
        for (int tb = 0; tb < 2; ++tb)
#pragma unroll
            for (int r = 1; r < 16; ++r) { const float pr = xr[tb][r - 1], pi = xi[tb][r - 1];
                xr[tb][r] += ar * pr - ai * pi; xi[tb][r] += ar * pi + ai * pr; }
        float H_r = __shfl(hin_r, p), H_i = __shfl(hin_i, p);
        float Hs_r[2], Hs_i[2];
#pragma unroll
        for (int tb = 0; tb < 2; ++tb) {
            const float er = xr[tb][15], ei = xi[tb][15];
            const float or_ = __shfl_xor(er, 32), oi_ = __shfl_xor(ei, 32);
            const float e0r = hh ? or_ : er, e0i = hh ? oi_ : ei, e1r = hh ? er : or_, e1i = hh ? ei : oi_;
            const float h0r = H_r, h0i = H_i;
            const float h1r = a16.x * h0r - a16.y * h0i + e0r, h1i = a16.x * h0i + a16.y * h0r + e0i;
            const float h2r = a16.x * h1r - a16.y * h1i + e1r, h2i = a16.x * h1i + a16.y * h1r + e1i;
            Hs_r[tb] = hh ? h1r : h0r; Hs_i[tb] = hh ? h1i : h0i;
            H_r = h2r; H_i = h2i;
        }
        if (PASS == 2) { if ((lane >> 5) == pb) { carry_r = H_r; carry_i = H_i; } }
        if (PASS == 1) {
            if (hh == 0) { float* e1 = (float*)(ws + WS_E1) + (((size_t)item * NG + g) * NP + p) * 2; *(f32x2*)e1 = (f32x2){H_r, H_i}; }
        } else {
            if (samp || c == NCH - 1) { if (hh == 0) { const size_t o = samp ? ((size_t)b * NG + g) * NP + p : ((size_t)n * NG + g) * NP + p;
                A.out[(samp ? O_SRE_S : O_SRE_P) + o] = H_r; A.out[(samp ? O_SIM_S : O_SIM_P) + o] = H_i; } }
#pragma unroll
            for (int tb = 0; tb < 2; ++tb) { float cr = Hs_r[tb], ci = Hs_i[tb];
#pragma unroll
                for (int r = 0; r < 16; ++r) { const float t = ar * cr - ai * ci; ci = ar * ci + ai * cr; cr = t;
                    const float sr = xr[tb][r] + cr, si = xi[tb][r] + ci;
                    LAS unsigned* rowp = (LAS unsigned*)(sbuf + (32 * tb + 16 * hh + r) * 144);
                    rowp[n32] = cvt_pk_bf16(sr, si); } }
            LDS_WAIT(); asm volatile("" ::: "memory");
#pragma unroll
            for (int ks = 0; ks < 2; ++ks) { const bf16x8 Bc = *(const bf16x8*)(cmT + ((((size_t)g * 2 + pb) * 2 + ks) * 64 + lane) * 8);
#pragma unroll
                for (int t4 = 0; t4 < 4; ++t4) { const bf16x8 Af = *(const LAS bf16x8*)(sbuf + (16 * t4 + (lane & 15)) * 144 + ks * 64 + (lane >> 4) * 16);
                    yacc[t4] = __builtin_amdgcn_mfma_f32_16x16x32_bf16(Af, Bc, yacc[t4], 0, 0, 0); } }
            LDS_WAIT(); asm volatile("" ::: "memory");
        }
    }
    if (PASS == 2) {
        const int h = lane & 15, ch = 16 * g + h; const float dsk = A.in[18][ch];
        bf16_t* G = (bf16_t*)(ws + WS_G);
#pragma unroll
        for (int t4 = 0; t4 < 4; ++t4)
#pragma unroll
            for (int r = 0; r < 4; ++r) { const int row = row0 + 16 * t4 + 4 * (lane >> 4) + r;
                const float u = ubuf[(16 * t4 + 4 * (lane >> 4) + r) * 16 + h]; const float v = yacc[t4][r] + dsk * u;
                G[(size_t)row * DM + ch] = (bf16_t)f2bf(gelu_tanh(v)); }
        LDS_WAIT(); asm volatile("" ::: "memory");
    }
}

#ifndef PHM
#define PHM 2047
#endif
constexpr int LDS_BYTES = 147456;
constexpr int XCH_OFF = 131072;

__device__ __forceinline__ Args ldargs() {
#if defined(__HIP_DEVICE_COMPILE__)
    const __attribute__((address_space(4))) Args* p = (const __attribute__((address_space(4))) Args*)__builtin_amdgcn_kernarg_segment_ptr(); asm volatile("" : "+s"(p)); return *p;
#else
    return Args{};
#endif
}
#define PHASE_ARGS const Args A = ldargs(); unsigned char* const ws = A.ws; float* const sumsq = (float*)(ws + WS_SS); float* const X = (float*)(ws + WS_X); bf16_t* const XB = (bf16_t*)(ws + WS_XB); \
    int tid_p = threadIdx.x; asm volatile("" : "+v"(tid_p)); const int tid = tid_p, lane = tid & 63, wave = __builtin_amdgcn_readfirstlane(tid >> 6); const int gw = bx * 8 + wave; \
    (void)sumsq; (void)X; (void)XB; (void)lane; (void)gw; (void)ws
__global__ void __launch_bounds__(512, 2) fwd_mega(Args Aparam) {
    extern __shared__ __attribute__((aligned(16))) unsigned char lds[];
    cg::grid_group grid = cg::this_grid();
    LAS unsigned char* L = (LAS unsigned char*)lds;
    const int G = gridDim.x, bx = blockIdx.x, NGW = G * 8;
    volatile LAS unsigned* bst = (volatile LAS unsigned*)(L + 139008);
    if (threadIdx.x == 0) { bst[0] = 0u; bst[1] = 0u; }
    __syncthreads();
    const XcdBarrier xbar = xcd_barrier_post((unsigned*)(ldargs().ws + WS_BAR), bst);
    if (G == 0x7fffffff) grid.sync();

    volatile LAS unsigned long long* TS = (volatile LAS unsigned long long*)(L + 140000);
    int n_ts = 0;
#ifdef PROBE_A
#define STAMP() do { if (threadIdx.x == 0) TS[n_ts] = __builtin_amdgcn_s_memrealtime(); ++n_ts; } while (0)
#else
#define STAMP() do { (void)TS; (void)n_ts; } while (0)
#endif
    STAMP();
    if (PHM & 1) { PHASE_ARGS;
        for (int i = bx * 512 + tid; i < 4 * MT; i += G * 512) sumsq[i] = 0.f;
        if (bx == 0 && tid < 128) ((unsigned*)(ws + WS_CNT))[tid] = 0u;
        for (int g = gw; g < NG; g += NGW) s5_tables(A, g, lane);
        float* ir0 = (float*)(ws + WS_IR0);
        for (int m = gw; m < MT; m += NGW) { const f32x4* xr = (const f32x4*)xrow_ptr(A, m) + lane; float s = 0.f;
#pragma unroll
            for (int j = 0; j < 4; ++j) { const f32x4 v = xr[64 * j]; s += (v.x * v.x + v.y * v.y) + (v.z * v.z + v.w * v.w); }
            s = wave_sum(s); if (lane == 0) ir0[m] = __builtin_amdgcn_rsqf(s * (1.0f / DM) + EPS); }
    }
    xcd_barrier(xbar); STAMP();

    if (PHM & 2) { PHASE_ARGS;
        {
        LAS float* scr = (LAS float*)(L + wave * 16384);
        constexpr int I_GLU = 16 * 64, I_UG = 16 * 176, I_DN = 44 * 32, I_QKV = 16 * 104, I_WO = 16 * 32;
        constexpr int NW_ITEMS = I_GLU + 2 * I_UG + 2 * I_DN + I_QKV + I_WO;
        for (int it = gw; it < NW_ITEMS; it += NGW) {
            int r = it;
            if (r < I_GLU) { const int kb = r / 64, nb = r % 64, pn = nb >> 3, j = nb & 7; const int src = j < 4 ? 128 * pn + 32 * j : 1024 + 128 * pn + 32 * (j - 4);
                transpose_item(A.in[19], DM, 2048, src, 32, nullptr, (bf16_t*)(ws + WS_WGLU), 32 * nb, scr, kb, lane); continue; } r -= I_GLU;
            if (r < 2 * I_UG) { const int l = r / I_UG; r %= I_UG; const int kb = r / 176, nb = r % 176, pn = nb >> 3, j = nb & 7;
                const float* W = (j < 4 ? A.in[23] : A.in[24]) + (size_t)l * DM * FF; const int src = 128 * pn + 32 * (j & 3);
                transpose_item(W, DM, FF, src, 32, A.in[9] + l * DM, (bf16_t*)(ws + WS_WUG) + (size_t)l * 5632 * DM, 32 * nb, scr, kb, lane); continue; } r -= 2 * I_UG;
            if (r < 2 * I_DN) { const int l = r / I_DN; r %= I_DN; const int kb = r / 32, nb = r % 32;
                transpose_item(A.in[27] + (size_t)l * FF * DM, FF, DM, 32 * nb, 32, nullptr, (bf16_t*)(ws + WS_WDN) + (size_t)l * DM * FF, 32 * nb, scr, kb, lane); continue; } r -= 2 * I_DN;
            if (r < I_QKV) { const int kb = r / 104, nb = r % 104; int valid = 3088 - 32 * nb; valid = valid < 0 ? 0 : (valid > 32 ? 32 : valid);
                transpose_item(A.in[20], DM, 3088, 32 * nb, valid, A.in[8] + DM, (bf16_t*)(ws + WS_WQKV), 32 * nb, scr, kb, lane); continue; } r -= I_QKV;
            { const int kb = r / 32, nb = r % 32; transpose_item(A.in[22], DM, DM, 32 * nb, 32, nullptr, (bf16_t*)(ws + WS_WO), 32 * nb, scr, kb, lane); }
        }
        }
        __syncthreads();
        LAS unsigned char* sbuf = L + wave * 9216;
        float cr_ = 0.f, ci_ = 0.f;
        for (int it = gw; it < NB * NCH * NG; it += NGW) { const int item = it / NG, g = it % NG; if ((item % NCH) == NCH - 1) continue; s5_item<1>(A, item, g, sbuf, lane, false, cr_, ci_, (LAS float*)(L + 73728 + wave * 4096)); }
    }
    xcd_barrier(xbar); STAMP();
    if (PHM & 4) { PHASE_ARGS;
        for (int sq = gw; sq < NB * NG; sq += NGW) { const int n = sq / NG, g = sq % NG;
            const f32x2 a64 = *(const f32x2*)(ws + WS_A64 + ((size_t)(g * NP + lane)) * 8);
            const float* e1 = (const float*)(ws + WS_E1) + (((size_t)(n * NCH) * NG + g) * NP + lane) * 2; float* ho = (float*)(ws + WS_HIN) + (((size_t)(n * NCH) * NG + g) * NP + lane) * 2;
            float hr = 0.f, hi_ = 0.f;
            for (int c0 = 0; c0 < NCH - 1; c0 += 16) { f32x2 ev[16];
#pragma unroll
                for (int k = 0; k < 16; ++k) if (c0 + k < NCH - 1) ev[k] = *(const f32x2*)(e1 + (size_t)(c0 + k) * NG * NP * 2);
#pragma unroll
                for (int k = 0; k < 16; ++k) if (c0 + k < NCH - 1) { const float tr = a64.x * hr - a64.y * hi_ + ev[k].x; hi_ = a64.x * hi_ + a64.y * hr + ev[k].y; hr = tr;
                    *(f32x2*)(ho + (size_t)(c0 + k + 1) * NG * NP * 2) = (f32x2){hr, hi_}; } }
        }
    }
    xcd_barrier(xbar); STAMP();
    if (PHM & 4) { PHASE_ARGS;
        LAS unsigned char* sbuf = L + wave * 9216;
        { float cr_ = 0.f, ci_ = 0.f;
          for (int it = gw; it < NITEM * NG; it += NGW) { const int item = it / NG, g = it % NG; s5_item<2>(A, item, g, sbuf, lane, false, cr_, ci_, (LAS float*)(L + 73728 + wave * 4096)); } }
    }
    xcd_barrier(xbar); STAMP();

    if (PHM & 8) { PHASE_ARGS;
        pg8::Gemm g{(const bf16_t*)(ws + WS_G), (const bf16_t*)(ws + WS_WGLU), DM, 16}; pg8::Order<false> S; S.init(MT / 256, 8, G, bx);
        EpiRes<1, true, true, false> E{A.in[0], A.in[1], X, XB, sumsq};
        pg8::gemm_phase(L, g, S, E);
    }
    xcd_barrier(xbar); STAMP();

    { constexpr int layer = 0;
        if (layer == 1) {
            if (PHM & 16) { PHASE_ARGS;
                pg8::Gemm g{XB, (const bf16_t*)(ws + WS_WQKV), DM, 16}; pg8::Order<false> S; S.init(MT / 256, 13, G, bx);
                EpiQKV E{sumsq + 1 * MT, A.in[21], (bf16_t*)(ws + WS_Q), (bf16_t*)(ws + WS_KP), (bf16_t*)(ws + WS_VP), (bf16_t*)(ws + WS_KS), (bf16_t*)(ws + WS_VS), A.out};
                pg8::gemm_phase(L, g, S, E);
            }
            xcd_barrier(xbar); STAMP();
            if (PHM & 64) { PHASE_ARGS;
                const bf16_t* Q = (const bf16_t*)(ws + WS_Q); bf16_t* O = (bf16_t*)(ws + WS_Q);
                const bf16_t* Kp = (const bf16_t*)(ws + WS_KP); const bf16_t* Vp = (const bf16_t*)(ws + WS_VP);
                const bf16_t* Ks = (const bf16_t*)(ws + WS_KS); const bf16_t* Vs = (const bf16_t*)(ws + WS_VS);
                float* ckw = (float*)(ws + WS_CKW) + (size_t)(bx & 255) * SEQ; bf16_t* kxw = (bf16_t*)(ws + WS_KXW) + (size_t)(bx & 255) * SEQ * 16;
                int last_bh = -1;
                for (int idx = bx; idx < 9 * 256; idx += G) {
                    const int i = idx >> 8, v = idx & 255;
                    if (i < 8) { const int bh = v >> 2, s = v & 3, b = bh >> 4, h = bh & 15; const int qb = (i & 1) ? (8 * (i >> 1) + 7 - s) : (8 * (i >> 1) + s);
                        if (bh != last_bh) { wg_cumsum_prompt(A.out + O_LF_P, b, h, ckw, kxw, (LAS float*)L); last_bh = bh; }
                        atf::attn_unit<8>(b, h, qb, (const atf::bf16*)Q, (const atf::bf16*)Kp, (const atf::bf16*)Vp, (atf::bf16*)O, (const atf::bf16*)kxw, ckw, (char*)lds);
                    } else { const int b = v >> 4, h = v & 15;
                        att::attn_unit_sample((char*)lds, Q + ((size_t)MP + 64 * b) * DM + h * HD, A.in[4] + (size_t)b * PAST * DM + h * HD, A.in[5] + (size_t)b * PAST * DM + h * HD,
                                              A.out + O_K_S + (size_t)b * SS * DM + h * HD, A.out + O_V_S + (size_t)b * SS * DM + h * HD, O + ((size_t)MP + 64 * b) * DM + h * HD,
                                              A.in[6] + (size_t)b * PAST * NH + h, A.out + O_LF_S + (size_t)b * SS * NH + h);
                    }
                }
            }
            xcd_barrier(xbar); STAMP();
            if (PHM & 128) { PHASE_ARGS;
                pg8::Gemm g{(const bf16_t*)(ws + WS_Q), (const bf16_t*)(ws + WS_WO), DM, 16}; pg8::Order<false> S; S.init(MT / 256, 4, G, bx);
                EpiRes<0, false, true, false> E{X, X + (size_t)MP * DM, X, XB, sumsq + 2 * MT};
                pg8::gemm_phase(L, g, S, E);
            }
            xcd_barrier(xbar); STAMP();
        }
        if (PHM & 256) { PHASE_ARGS;
            pg8::Gemm g{XB, (const bf16_t*)(ws + WS_WUG) + (size_t)layer * 5632 * DM, DM, 16}; pg8::Order<true> S; S.init(136, 22, G, bx);
            EpiConv E{(bf16_t*)(ws + WS_H), sumsq + (layer == 0 ? 0 : 2 * MT), A.in[25] + (size_t)layer * 3 * FF, A.in[26] + (size_t)layer * FF, A.in[7] + (size_t)layer * SB * 2 * FF,
                      A.out + O_CV_P + (size_t)layer * NB * 2 * FF, A.out + O_CV_S + (size_t)layer * SB * 2 * FF, (LAS float*)(L + XCH_OFF)};
            pg8::gemm_phase(L, g, S, E);
        }
        xcd_barrier(xbar); STAMP();
        if (PHM & 512) { PHASE_ARGS;
            pg8::Gemm g{(const bf16_t*)(ws + WS_H), (const bf16_t*)(ws + WS_WDN) + (size_t)layer * DM * FF, FF, 44}; pg8::Order<false> S; S.init(MP / 256, 4, G, bx);
            pg8::Gemm gt{g.A, g.Bt, FF, 4}; pg8::OrderTail<MP / 256, 4, 4, 11> St{G, bx};
            if (layer == 0) { EpiRes<0, false, true, false> E{X, X + (size_t)MP * DM, X, XB, sumsq + 1 * MT}; pg8::gemm_phase(L, g, S, E);
                EpiSplitK<EpiRes<0, false, true, false>, 11, 4, MP / 256, WS_PDN0, 64> Et{E, ws}; pg8::gemm_phase(L, gt, St, Et); }
            else { EpiRes<0, false, false, true> E{X, X + (size_t)MP * DM, X, XB, sumsq + 3 * MT}; pg8::gemm_phase(L, g, S, E);
                EpiSplitK<EpiRes<0, false, false, true>, 11, 4, MP / 256, WS_PDN1, 96> Et{E, ws}; pg8::gemm_phase(L, gt, St, Et); }
        }
        xcd_barrier(xbar); STAMP();
        }
    { constexpr int layer = 1;
        if (layer == 1) {
            if (PHM & 16) { PHASE_ARGS;
                pg8::Gemm g{XB, (const bf16_t*)(ws + WS_WQKV), DM, 16}; pg8::Order<false> S; S.init(MT / 256, 13, G, bx);
                EpiQKV E{sumsq + 1 * MT, A.in[21], (bf16_t*)(ws + WS_Q), (bf16_t*)(ws + WS_KP), (bf16_t*)(ws + WS_VP), (bf16_t*)(ws + WS_KS), (bf16_t*)(ws + WS_VS), A.out};
                pg8::gemm_phase(L, g, S, E);
            }
            xcd_barrier(xbar); STAMP();
            if (PHM & 64) { PHASE_ARGS;
                const bf16_t* Q = (const bf16_t*)(ws + WS_Q); bf16_t* O = (bf16_t*)(ws + WS_Q);
                const bf16_t* Kp = (const bf16_t*)(ws + WS_KP); const bf16_t* Vp = (const bf16_t*)(ws + WS_VP);
                const bf16_t* Ks = (const bf16_t*)(ws + WS_KS); const bf16_t* Vs = (const bf16_t*)(ws + WS_VS);
                float* ckw = (float*)(ws + WS_CKW) + (size_t)(bx & 255) * SEQ; bf16_t* kxw = (bf16_t*)(ws + WS_KXW) + (size_t)(bx & 255) * SEQ * 16;
                int last_bh = -1;
                for (int idx = bx; idx < 9 * 256; idx += G) {
                    const int i = idx >> 8, v = idx & 255;
                    if (i < 8) { const int bh = v >> 2, s = v & 3, b = bh >> 4, h = bh & 15; const int qb = (i & 1) ? (8 * (i >> 1) + 7 - s) : (8 * (i >> 1) + s);
                        if (bh != last_bh) { wg_cumsum_prompt(A.out + O_LF_P, b, h, ckw, kxw, (LAS float*)L); last_bh = bh; }
                        atf::attn_unit<8>(b, h, qb, (const atf::bf16*)Q, (const atf::bf16*)Kp, (const atf::bf16*)Vp, (atf::bf16*)O, (const atf::bf16*)kxw, ckw, (char*)lds);
                    } else { const int b = v >> 4, h = v & 15;
                        att::attn_unit_sample((char*)lds, Q + ((size_t)MP + 64 * b) * DM + h * HD, A.in[4] + (size_t)b * PAST * DM + h * HD, A.in[5] + (size_t)b * PAST * DM + h * HD,
                                              A.out + O_K_S + (size_t)b * SS * DM + h * HD, A.out + O_V_S + (size_t)b * SS * DM + h * HD, O + ((size_t)MP + 64 * b) * DM + h * HD,
                                              A.in[6] + (size_t)b * PAST * NH + h, A.out + O_LF_S + (size_t)b * SS * NH + h);
                    }
                }
            }
            xcd_barrier(xbar); STAMP();
            if (PHM & 128) { PHASE_ARGS;
                pg8::Gemm g{(const bf16_t*)(ws + WS_Q), (const bf16_t*)(ws + WS_WO), DM, 16}; pg8::Order<false> S; S.init(MT / 256, 4, G, bx);
                EpiRes<0, false, true, false> E{X, X + (size_t)MP * DM, X, XB, sumsq + 2 * MT};
                pg8::gemm_phase(L, g, S, E);
            }
            xcd_barrier(xbar); STAMP();
        }
        if (PHM & 256) { PHASE_ARGS;
            pg8::Gemm g{XB, (const bf16_t*)(ws + WS_WUG) + (size_t)layer * 5632 * DM, DM, 16}; pg8::Order<true> S; S.init(136, 22, G, bx);
            EpiConv E{(bf16_t*)(ws + WS_H), sumsq + (layer == 0 ? 0 : 2 * MT), A.in[25] + (size_t)layer * 3 * FF, A.in[26] + (size_t)layer * FF, A.in[7] + (size_t)layer * SB * 2 * FF,
                      A.out + O_CV_P + (size_t)layer * NB * 2 * FF, A.out + O_CV_S + (size_t)layer * SB * 2 * FF, (LAS float*)(L + XCH_OFF)};
            pg8::gemm_phase(L, g, S, E);
        }
        xcd_barrier(xbar); STAMP();
        if (PHM & 512) { PHASE_ARGS;
            pg8::Gemm g{(const bf16_t*)(ws + WS_H), (const bf16_t*)(ws + WS_WDN) + (size_t)layer * DM * FF, FF, 44}; pg8::Order<false> S; S.init(MP / 256, 4, G, bx);
            pg8::Gemm gt{g.A, g.Bt, FF, 4}; pg8::OrderTail<MP / 256, 4, 4, 11> St{G, bx};
            if (layer == 0) { EpiRes<0, false, true, false> E{X, X + (size_t)MP * DM, X, XB, sumsq + 1 * MT}; pg8::gemm_phase(L, g, S, E);
                EpiSplitK<EpiRes<0, false, true, false>, 11, 4, MP / 256, WS_PDN0, 64> Et{E, ws}; pg8::gemm_phase(L, gt, St, Et); }
            else { EpiRes<0, false, false, true> E{X, X + (size_t)MP * DM, X, XB, sumsq + 3 * MT}; pg8::gemm_phase(L, g, S, E);
                EpiSplitK<EpiRes<0, false, false, true>, 11, 4, MP / 256, WS_PDN1, 96> Et{E, ws}; pg8::gemm_phase(L, gt, St, Et); }
        }
        xcd_barrier(xbar); STAMP();
        }
    if (PHM & 1024) { PHASE_ARGS;
        const float* gf = A.in[10]; const float* ssq = sumsq + 3 * MT;
        for (int m = gw; m < MT; m += NGW) { const float rs = __builtin_amdgcn_rsqf(ssq[m] * (1.0f / DM) + EPS);
            const f32x4* xr = (const f32x4*)(X + (size_t)m * DM) + lane; f32x4* o = (f32x4*)(A.out + O_Y + (size_t)m * DM) + lane; const f32x4* gg = (const f32x4*)gf + lane;
#pragma unroll
            for (int j = 0; j < 4; ++j) __builtin_nontemporal_store(xr[64 * j] * rs * gg[64 * j], o + 64 * j); }
    }
#ifdef PROBE_A
    STAMP();
    if (bx == 0 && threadIdx.x == 0) { const unsigned long long dt = TS[PROBE_B] - TS[PROBE_A], t0 = __builtin_amdgcn_s_memrealtime(); while (__builtin_amdgcn_s_memrealtime() - t0 < dt) __builtin_amdgcn_s_sleep(8); }
#endif
}

extern "C" void kernel_launch(void* const* d_in, const int* in_sizes, int n_in, void* d_out, int out_size, void* d_ws, size_t ws_size, hipStream_t stream) {
    static int grid = 0;
    if (grid == 0) {
        int dev = 0, cus = 0, per_cu = 0;
        hipGetDevice(&dev); hipDeviceGetAttribute(&cus, hipDeviceAttributeMultiprocessorCount, dev);
        hipFuncSetAttribute((const void*)fwd_mega, hipFuncAttributeMaxDynamicSharedMemorySize, LDS_BYTES);
        hipOccupancyMaxActiveBlocksPerMultiprocessor(&per_cu, (const void*)fwd_mega, 512, LDS_BYTES);
        if (per_cu < 1) per_cu = 1;
        grid = cus * 1;
        if (grid <= 0) grid = 256;
    }
    (void)hipMemsetAsync((char*)d_ws + WS_BAR, 0, XCD_BAR_WORDS * 4, stream);
    Args a{};
    for (int i = 0; i < 28; ++i) a.in[i] = (const float*)d_in[i];
    a.out = (float*)d_out; a.ws = (unsigned char*)d_ws;
    void* args[] = {&a};
    hipError_t e = hipLaunchCooperativeKernel((const void*)fwd_mega, dim3(grid), dim3(512), args, LDS_BYTES, stream);
    if (e != hipSuccess) fprintf(stderr, "cooperative launch failed: %s (grid %d)\n", hipGetErrorString(e), grid);
}
```

```cpp
#include <hip/hip_runtime.h>
#include <hip/hip_cooperative_groups.h>
#include <hip/hip_bf16.h>
#include <cstdint>
#include <cstdio>
namespace cg = cooperative_groups;

#define LAS __attribute__((address_space(3)))
typedef unsigned short bf16_t;
typedef short bf16x8 __attribute__((ext_vector_type(8)));
typedef short s16x4 __attribute__((ext_vector_type(4)));
typedef float f32x2 __attribute__((ext_vector_type(2)));
typedef float f32x4 __attribute__((ext_vector_type(4)));
typedef float f32x16 __attribute__((ext_vector_type(16)));
typedef unsigned u32x4 __attribute__((ext_vector_type(4)));
typedef unsigned u32x2 __attribute__((ext_vector_type(2)));

constexpr int DM = 1024, NB = 4, SEQ = 8192, SB = 16, SS = 64, PAST = 4096, KALL = PAST + SS;
constexpr int MP = NB * SEQ, MS = SB * SS, MT = MP + MS;
constexpr int FF = 2816, NH = 16, HD = 64, NG = 64, NP = 64;
constexpr int NQKV = 3328;
constexpr float EPS = 1e-6f;
constexpr float C2 = 0.125f * 1.4426950408889634f;
constexpr float LOG2E = 1.4426950408889634f;
constexpr int NCH = SEQ / 64;
constexpr int NITEM = NB * NCH + SB;

constexpr size_t O_Y = 0;
constexpr size_t O_SRE_P = (size_t)MT * DM;
constexpr size_t O_SIM_P = O_SRE_P + NB * NG * NP;
constexpr size_t O_K_P = O_SIM_P + NB * NG * NP;
constexpr size_t O_V_P = O_K_P + (size_t)MP * DM;
constexpr size_t O_LF_P = O_V_P + (size_t)MP * DM;
constexpr size_t O_CV_P = O_LF_P + (size_t)MP * NH;
constexpr size_t O_SRE_S = O_CV_P + 2 * NB * 2 * FF;
constexpr size_t O_SIM_S = O_SRE_S + SB * NG * NP;
constexpr size_t O_K_S = O_SIM_S + SB * NG * NP;
constexpr size_t O_V_S = O_K_S + (size_t)MS * DM;
constexpr size_t O_LF_S = O_V_S + (size_t)MS * DM;
constexpr size_t O_CV_S = O_LF_S + (size_t)MS * NH;

constexpr size_t MiB = 1u << 20;
constexpr size_t WS_ABAR = 0, WS_A16 = 32768, WS_A64 = 65536, WS_BBT = 131072, WS_CMT = 393216;
constexpr size_t WS_SS = 1 * MiB, WS_IR0 = 2 * MiB, WS_CKP = 3 * MiB, WS_CKS = 5 * MiB;
constexpr size_t WS_WGLU = 10 * MiB, WS_WUG = 14 * MiB, WS_WDN = 36 * MiB, WS_WQKV = 47 * MiB, WS_WO = 54 * MiB;
constexpr size_t WS_X = 64 * MiB, WS_XB = 197 * MiB;
constexpr size_t WS_BIG = 264 * MiB;
constexpr size_t WS_G = WS_BIG, WS_E1 = 346 * MiB, WS_HIN = 362 * MiB;
constexpr size_t WS_H = WS_BIG;
constexpr size_t WS_PG1 = 734 * MiB, WS_PDN0 = 798 * MiB, WS_PWO = 842 * MiB, WS_PDN1 = 874 * MiB;
constexpr size_t WS_BAR = WS_SS + 720896;
constexpr size_t WS_CNT = WS_SS + 655360;
constexpr size_t WS_KX = 718 * MiB;
constexpr size_t WS_KXW = 458 * MiB, WS_CKW = 522 * MiB;
constexpr size_t WS_Q = WS_BIG, WS_KP = 330 * MiB, WS_VP = 394 * MiB, WS_KS = 458 * MiB, WS_VS = 588 * MiB;

__device__ __forceinline__ unsigned cvt_pk_bf16(float lo, float hi) { unsigned r; asm volatile("v_cvt_pk_bf16_f32 %0, %1, %2" : "=v"(r) : "v"(lo), "v"(hi)); return r; }
__device__ __forceinline__ unsigned cvtpk_s(float lo, float hi) { typedef __bf16 bf16x2_t __attribute__((ext_vector_type(2))); f32x2 v = {lo, hi}; bf16x2_t b = __builtin_convertvector(v, bf16x2_t); return __builtin_bit_cast(unsigned, b); }
__device__ __forceinline__ float gelu_tanh(float v) {
    const float t = v * (0.7978845608f + 0.0356774081f * v * v);
    const float e = __builtin_amdgcn_exp2f(-2.8853900818f * t);
    return v * __builtin_amdgcn_rcpf(1.0f + e);
}
__device__ __forceinline__ float sigmoidf_(float v) { const float e = __builtin_amdgcn_exp2f(-LOG2E * v); return __builtin_amdgcn_rcpf(1.0f + e); }
__device__ __forceinline__ float wave_sum(float v) {
#pragma unroll
    for (int o = 1; o < 64; o <<= 1) v += __shfl_xor(v, o);
    return v;
}
template <int CTRL> __device__ __forceinline__ float dppf(float v) { return __int_as_float(__builtin_amdgcn_update_dpp(0, __float_as_int(v), CTRL, 0xf, 0xf, false)); }
#define LDS_WAIT() asm volatile("s_waitcnt lgkmcnt(0)" ::: "memory")

namespace pg8 {
constexpr int BM = 256, BK = 64, HALF = 128, HTB = HALF * BK * 2, STAGE_BYTES = 8 * HTB, NXCD = 8, WGM = 4;
__host__ __device__ __forceinline__ int lds_byte(int r, int c) { const int st = (r >> 4) * 2 + (c >> 5), rr = r & 15, cc = c & 31, ob = rr * 64 + cc * 2; return st * 1024 + (ob ^ (((ob >> 9) & 1) << 5)); }
__host__ __device__ __forceinline__ void stage_rc(int b, int& R, int& C) { const int st = b / 1024, sb = b % 1024, swz = sb ^ (((sb >> 9) & 1) << 5); R = (st >> 1) * 16 + swz / 64; C = (st & 1) * 32 + (swz % 64) / 2; }
__host__ __device__ __forceinline__ int perm32(int rho) { const int n = rho >> 4, i = rho & 15; return 8 * (i >> 2) + 4 * n + (i & 3); }
struct Unit { int pm, pn, ks; };
struct Gemm { const bf16_t* A; const bf16_t* Bt; int K; int nt; };
template <bool FFNROWS> struct Order {
    int nM, nN, nwg, G, c;
    __device__ void init(int nM_, int nN_, int G_, int c_) { nM = nM_; nN = nN_; nwg = nM * nN; G = G_; c = c_; }
    __device__ bool next(int i, Unit& u) const {
        const long L = (long)i * G + c; if (L >= nwg) return false;
        int wgid = (int)L; { const int q = nwg / NXCD, r = nwg % NXCD, xcd = wgid % NXCD, off = wgid / NXCD; wgid = (xcd < r ? xcd * (q + 1) : r * (q + 1) + (xcd - r) * q) + off; }
        const int nig = WGM * nN, gid = wgid / nig, fm = gid * WGM, gsz = (nM - fm) < WGM ? (nM - fm) : WGM;
        u.pm = fm + ((wgid % nig) % gsz); u.pn = (wgid % nig) / gsz; u.ks = 0; return true;
    }
    __device__ __forceinline__ long arow(int pm) const {
        if (!FFNROWS) return (long)pm * BM;
        if (pm < 132) { const int n = pm / 33, R = pm % 33; return (long)n * SEQ + 254 * R - 2; }
        return (long)MP + 256 * (pm - 132);
    }
};

template <int pm0, int nMt, int nN, int S> struct OrderTail {
    int G, c;
    __device__ bool next(int i, Unit& u) const { const long L = (long)i * G + c; if (L >= (long)nMt * nN * S) return false; const int tile = (int)L / S; u.ks = (int)L % S; u.pm = pm0 + tile % nMt; u.pn = tile / nMt; return true; }
    __device__ __forceinline__ long arow(int pm) const { return (long)pm * BM; }
};
template <class Epi, class Sched>
__device__ __forceinline__ void gemm_phase(LAS unsigned char* lds, const Gemm g, const Sched& S, const Epi& E) {
    int tid_ = threadIdx.x; asm volatile("" : "+v"(tid_));
    const int tid = tid_, wid = __builtin_amdgcn_readfirstlane(tid >> 6), lane = tid & 63, wr = wid >> 2, wc = wid & 3, fr = lane & 15, fq = lane >> 4;
    const int K = g.K, nt = g.nt;
    unsigned voffA[2], voffB[2];
#pragma unroll
    for (int i = 0; i < 2; ++i) { int R, C; stage_rc(tid * 16 + i * 8192, R, C); const int Rb = ((R & ~31) + perm32(R & 31));
        voffA[i] = (unsigned)(R * K + C) * 2u; voffB[i] = (unsigned)(Rb * K + C) * 2u; }
    const size_t kstep = (size_t)(BK * 2);
    const size_t hstep = (size_t)HALF * K * 2;
    const size_t tstep = 2 * hstep;
    const size_t rowb = (size_t)K * 2;
    const unsigned ldsw = (unsigned)wid * 1024u;
    const int aoff = lds_byte(wr * 64 + fr, fq * 8), boff = lds_byte(wc * 32 + fr, fq * 8);
#define PG8_SA(b, h) (((b) * 2 + (h)) * HTB)
#define PG8_SB(b, h) ((4 + (b) * 2 + (h)) * HTB)
#define PG8_STAGE(bufoff, gbase, voff) do { _Pragma("unroll") for (int _i = 0; _i < 2; ++_i) \
        __builtin_amdgcn_global_load_lds((const unsigned*)((const char*)(gbase) + (voff)[_i]), (LAS unsigned*)(lds + (bufoff) + ldsw + _i * 8192), 16, 0, 0); } while (0)
#define PG8_LDA(dst, b, h) do { _Pragma("unroll") for (int m = 0; m < 4; ++m) _Pragma("unroll") for (int k = 0; k < 2; ++k) dst[m][k] = *(const LAS bf16x8*)(lds + PG8_SA(b, h) + aoff + m * 2048 + k * 1024); } while (0)
#define PG8_LDB(dst, b, h) do { _Pragma("unroll") for (int n = 0; n < 2; ++n) _Pragma("unroll") for (int k = 0; k < 2; ++k) dst[n][k] = *(const LAS bf16x8*)(lds + PG8_SB(b, h) + boff + n * 2048 + k * 1024); } while (0)
#define PG8_MMA(ai, bj, At, Bt) do { __builtin_amdgcn_s_setprio(1); _Pragma("unroll") for (int m = 0; m < 4; ++m) _Pragma("unroll") for (int n = 0; n < 2; ++n) _Pragma("unroll") for (int k = 0; k < 2; ++k) \
        acc[ai][bj][m][n] = __builtin_amdgcn_mfma_f32_16x16x32_bf16(Bt[n][k], At[m][k], acc[ai][bj][m][n], 0, 0, 0); __builtin_amdgcn_s_setprio(0); } while (0)
#define PG8_WAIT_V(n) asm volatile("s_waitcnt vmcnt(" #n ")" ::: "memory")
#define PG8_WAIT_L(n) asm volatile("s_waitcnt lgkmcnt(" #n ")" ::: "memory")
#define PG8_BAR __builtin_amdgcn_s_barrier()
#define PG8_SCHED __builtin_amdgcn_sched_barrier(0)
    Unit cur, nxt; int ui = 0;
    if (!S.next(0, cur)) return;
    f32x4 acc[2][2][4][2];
#pragma unroll
    for (int a = 0; a < 2; ++a)
#pragma unroll
        for (int b = 0; b < 2; ++b)
#pragma unroll
            for (int m = 0; m < 4; ++m)
#pragma unroll
                for (int n = 0; n < 2; ++n) acc[a][b][m][n] = (f32x4){0.f, 0.f, 0.f, 0.f};
    bf16x8 At[4][2], B0[2][2], B1[2][2];
    const size_t kslice = (size_t)nt * kstep;
    const char* cA = (const char*)g.A + S.arow(cur.pm) * (long)rowb + cur.ks * kslice; const char* cB = (const char*)g.Bt + (size_t)cur.pn * tstep + cur.ks * kslice;
    PG8_STAGE(PG8_SB(0, 0), cB, voffB); PG8_STAGE(PG8_SB(0, 1), cB + hstep, voffB); PG8_STAGE(PG8_SA(0, 0), cA, voffA); PG8_STAGE(PG8_SA(0, 1), cA + hstep, voffA);
    if (wr == 1) PG8_BAR;
    PG8_WAIT_V(2); PG8_BAR;
    PG8_STAGE(PG8_SB(1, 0), cB + kstep, voffB); PG8_STAGE(PG8_SA(1, 0), cA + kstep, voffA); PG8_STAGE(PG8_SB(1, 1), cB + hstep + kstep, voffB);
    PG8_WAIT_V(6); PG8_BAR;
    for (;;) {
        const bool has_next = S.next(ui + 1, nxt);
        const char* nA = has_next ? (const char*)g.A + S.arow(nxt.pm) * (long)rowb + nxt.ks * kslice : cA; const char* nB = has_next ? (const char*)g.Bt + (size_t)nxt.pn * tstep + nxt.ks * kslice : cB;
        for (int t = 0; t < nt; t += 2) {
            const bool last = (t == nt - 2);
            const char* a1 = cA + (size_t)(t + 1) * kstep;
            const char* a2 = last ? nA : cA + (size_t)(t + 2) * kstep; const char* b2 = last ? nB : cB + (size_t)(t + 2) * kstep;
            const char* a3 = a2 + kstep; const char* b3 = b2 + kstep;
            PG8_LDB(B0, 0, 0); PG8_LDB(B1, 0, 1); PG8_SCHED; PG8_LDA(At, 0, 0); PG8_STAGE(PG8_SA(1, 1), a1 + hstep, voffA);
            PG8_WAIT_V(8); PG8_WAIT_L(0); PG8_BAR; PG8_MMA(0, 0, At, B0); PG8_MMA(0, 1, At, B1); PG8_BAR; PG8_SCHED;
            PG8_LDA(At, 0, 1); PG8_STAGE(PG8_SB(0, 0), b2, voffB); PG8_STAGE(PG8_SB(0, 1), b2 + hstep, voffB); PG8_STAGE(PG8_SA(0, 0), a2, voffA);
            PG8_WAIT_V(8); PG8_WAIT_L(0); PG8_BAR; PG8_MMA(1, 0, At, B0); PG8_MMA(1, 1, At, B1); PG8_BAR; PG8_SCHED;
            PG8_LDB(B0, 1, 0); PG8_LDB(B1, 1, 1); PG8_SCHED; PG8_LDA(At, 1, 0); PG8_STAGE(PG8_SA(0, 1), a2 + hstep, voffA);
            PG8_WAIT_V(8); PG8_WAIT_L(0); PG8_BAR; PG8_MMA(0, 0, At, B0); PG8_MMA(0, 1, At, B1); PG8_BAR; PG8_SCHED;
            PG8_LDA(At, 1, 1); PG8_STAGE(PG8_SB(1, 0), b3, voffB); PG8_STAGE(PG8_SB(1, 1), b3 + hstep, voffB); PG8_STAGE(PG8_SA(1, 0), a3, voffA);
            PG8_WAIT_V(8); PG8_WAIT_L(0); PG8_BAR; PG8_MMA(1, 0, At, B0); PG8_MMA(1, 1, At, B1); PG8_BAR; PG8_SCHED;
        }
        if (wr == 0) PG8_BAR;
        { int fr_ = fr, fq_ = fq; asm volatile("" : "+v"(fr_), "+v"(fq_)); E(acc, cur, wr, wc, fr_, fq_); }
        if (!has_next) break;
#pragma unroll
        for (int a = 0; a < 2; ++a)
#pragma unroll
            for (int b = 0; b < 2; ++b)
#pragma unroll
                for (int m = 0; m < 4; ++m)
#pragma unroll
                    for (int n = 0; n < 2; ++n) acc[a][b][m][n] = (f32x4){0.f, 0.f, 0.f, 0.f};
        cur = nxt; cA = nA; cB = nB; ++ui;
        if (wr == 1) PG8_BAR;
    }
    PG8_WAIT_V(0);
    PG8_BAR;
#undef PG8_SA
#undef PG8_SB
#undef PG8_STAGE
#undef PG8_LDA
#undef PG8_LDB
#undef PG8_MMA
#undef PG8_WAIT_V
#undef PG8_WAIT_L
#undef PG8_BAR
#undef PG8_SCHED
}
}


template <int MODE  , bool RES_F32  , bool WRITE_XB, bool WRITE_X> struct EpiRes {
    const float* r0; const float* r1;
    float* X; bf16_t* xb; float* sumsq;
    __device__ __forceinline__ void group(const f32x4 (&a)[2][2], const pg8::Unit& u, int ai, int m, int wr, int wc, int fr, int fq) const {
        const int row = u.pm * 256 + ai * 128 + wr * 64 + m * 16 + fr;
        const float* rp = row < MP ? r0 + (size_t)row * DM : r1 + (size_t)(row - MP) * DM;
        float ss = 0.f;
#pragma unroll
        for (int bj = 0; bj < (MODE == 1 ? 1 : 2); ++bj) {
            const int col = (MODE == 1 ? u.pn * 128 : u.pn * 256 + bj * 128) + wc * 32 + fq * 8;
            f32x4 v0, v1;
            if (MODE == 1) {
#pragma unroll
                for (int j = 0; j < 4; ++j) { v0[j] = a[0][0][j] * sigmoidf_(a[1][0][j]); v1[j] = a[0][1][j] * sigmoidf_(a[1][1][j]); }
            } else { v0 = a[bj][0]; v1 = a[bj][1]; }
            if (RES_F32) { v0 += *(const f32x4*)(rp + col); v1 += *(const f32x4*)(rp + col + 4); }
            else { const u32x4 rb = *(const u32x4*)(xb + (size_t)row * DM + col);
                v0 += (f32x4){__uint_as_float(rb.x << 16), __uint_as_float(rb.x & 0xffff0000u), __uint_as_float(rb.y << 16), __uint_as_float(rb.y & 0xffff0000u)};
                v1 += (f32x4){__uint_as_float(rb.z << 16), __uint_as_float(rb.z & 0xffff0000u), __uint_as_float(rb.w << 16), __uint_as_float(rb.w & 0xffff0000u)}; }
            if (WRITE_X) { *(f32x4*)(X + (size_t)row * DM + col) = v0; *(f32x4*)(X + (size_t)row * DM + col + 4) = v1; }
            if (WRITE_XB) { u32x4 w; w.x = cvt_pk_bf16(v0[0], v0[1]); w.y = cvt_pk_bf16(v0[2], v0[3]); w.z = cvt_pk_bf16(v1[0], v1[1]); w.w = cvt_pk_bf16(v1[2], v1[3]);
                *(u32x4*)(xb + (size_t)row * DM + col) = w; }
            ss += (v0[0] * v0[0] + v0[1] * v0[1]) + (v0[2] * v0[2] + v0[3] * v0[3]) + (v1[0] * v1[0] + v1[1] * v1[1]) + (v1[2] * v1[2] + v1[3] * v1[3]);
        }
        ss += __shfl_xor(ss, 16); ss += __shfl_xor(ss, 32);
        if (fq == 0) atomicAdd(sumsq + row, ss);
    }
    __device__ __forceinline__ void operator()(f32x4 (&acc)[2][2][4][2], const pg8::Unit& u, int wr, int wc, int fr, int fq) const {
#pragma unroll
        for (int ai = 0; ai < 2; ++ai)
#pragma unroll
            for (int m = 0; m < 4; ++m) { const f32x4 a[2][2] = {{acc[ai][0][m][0], acc[ai][0][m][1]}, {acc[ai][1][m][0], acc[ai][1][m][1]}}; group(a, u, ai, m, wr, wc, fr, fq); }
    }
};

template <class Inner, int S, int nN, int pm0, size_t POFF, int COFF> struct EpiSplitK {
    Inner inner; unsigned char* wsb;
    __device__ __forceinline__ void operator()(f32x4 (&acc)[2][2][4][2], const pg8::Unit& u, int wr, int wc, int fr, int fq) const {
        static_assert(S >= 8, "eight row groups need eight slices");
        float* const P = (float*)(wsb + POFF); unsigned* const cnt = (unsigned*)(wsb + WS_CNT) + COFF;
        const int tix = (u.pm - pm0) * nN + u.pn; int tid = threadIdx.x; asm volatile("" : "+v"(tid));
        float* slice = P + ((size_t)tix * S + u.ks) * 65536 + (size_t)tid * 4;
#pragma unroll
        for (int ai = 0; ai < 2; ++ai)
#pragma unroll
            for (int bj = 0; bj < 2; ++bj)
#pragma unroll
                for (int m = 0; m < 4; ++m)
#pragma unroll
                    for (int n = 0; n < 2; ++n) *(f32x4*)(slice + (size_t)(((ai * 2 + bj) * 4 + m) * 2 + n) * 2048) = acc[ai][bj][m][n];
        asm volatile("s_waitcnt vmcnt(0)" ::: "memory");
        __syncthreads();
        if (tid == 0) { __threadfence(); (void)__hip_atomic_fetch_add(cnt + tix, 1u, __ATOMIC_RELAXED, __HIP_MEMORY_SCOPE_AGENT); }
        if (u.ks >= 8) return;
        if (tid == 0) { unsigned sp = 0; while (__hip_atomic_load(cnt + tix, __ATOMIC_RELAXED, __HIP_MEMORY_SCOPE_AGENT) < (unsigned)S) { __builtin_amdgcn_s_sleep(4); if (++sp > (1u << 22)) break; } __threadfence(); }
        __syncthreads();
        const int ai = u.ks >> 2, m = u.ks & 3;
        f32x4 t[2][2] = {{(f32x4){0.f, 0.f, 0.f, 0.f}, (f32x4){0.f, 0.f, 0.f, 0.f}}, {(f32x4){0.f, 0.f, 0.f, 0.f}, (f32x4){0.f, 0.f, 0.f, 0.f}}};
        const float* p0 = P + (size_t)tix * S * 65536 + (size_t)tid * 4;
#pragma unroll
        for (int s = 0; s < S; ++s) {
#pragma unroll
            for (int bj = 0; bj < 2; ++bj)
#pragma unroll
                for (int n = 0; n < 2; ++n) t[bj][n] += __builtin_nontemporal_load((const f32x4*)(p0 + (size_t)s * 65536 + (size_t)(((ai * 2 + bj) * 4 + m) * 2 + n) * 2048));
        }
        inner.group(t, u, ai, m, wr, wc, fr, fq);
    }
};

struct EpiConv {
    bf16_t* H; const float* sumsq; const float* convw; const float* convb; const float* hist; float* outc_p; float* outc_s; LAS float* xch;
    __device__ __forceinline__ void operator()(f32x4 (&acc)[2][2][4][2], const pg8::Unit& u, int wr, int wc, int fr, int fq) const {
        const bool samp = u.pm >= 132;
        int n = 0, tok0 = 0; long grow0;
        if (!samp) { n = u.pm / 33; const int R = u.pm % 33; tok0 = 254 * R - 2; grow0 = (long)n * SEQ + tok0; } else { grow0 = (long)MP + 256 * (u.pm - 132); }
        const int f0 = 128 * u.pn + 32 * wc + 8 * fq;
#pragma unroll
        for (int ai = 0; ai < 2; ++ai)
#pragma unroll
            for (int m = 0; m < 4; ++m) {
                const int i = ai * 128 + wr * 64 + m * 16 + fr; long gr = grow0 + i; if (gr < 0) gr = 0;
                float rs = __builtin_amdgcn_rsqf(sumsq[gr] * (1.0f / DM) + EPS);
                float ra = rs; if (!samp && tok0 + i < 0) ra = 0.f;
#pragma unroll
                for (int nn = 0; nn < 2; ++nn) { acc[ai][0][m][nn] *= ra; acc[ai][1][m][nn] *= rs; }
            }
        if (fr >= 14) {
#pragma unroll
            for (int ai = 0; ai < 2; ++ai) { LAS float* p = xch + ((ai * 2 + wr) * 2 + (fr - 14)) * 128 + 32 * wc + 8 * fq;
                *(LAS f32x4*)p = acc[ai][0][3][0]; *(LAS f32x4*)(p + 4) = acc[ai][0][3][1]; }
        }
        asm volatile("s_waitcnt lgkmcnt(0)\n\ts_barrier" ::: "memory");
#pragma unroll
        for (int nn = 0; nn < 2; ++nn) {
            asm volatile("" ::: "memory");
            const int fc = f0 + 4 * nn;
            const f32x4 w0 = *(const f32x4*)(convw + fc), w1 = *(const f32x4*)(convw + FF + fc), w2 = *(const f32x4*)(convw + 2 * FF + fc), cb = *(const f32x4*)(convb + fc);
#pragma unroll
            for (int ai = 0; ai < 2; ++ai) {
                const int blk = ai * 2 + wr;
                f32x4 prev = (f32x4){0.f, 0.f, 0.f, 0.f};
                if (fr >= 14) {
                    if (samp) { prev = *(const f32x4*)(hist + ((size_t)((4 * (u.pm - 132) + blk) * 2 + (fr - 14))) * FF + fc); }
                    else if (blk > 0) { prev = *(const LAS f32x4*)(xch + (((blk - 1) * 2) + (fr - 14)) * 128 + 32 * wc + 8 * fq + 4 * nn); }
                }
#pragma unroll
                for (int m = 0; m < 4; ++m) {
                    const int i = ai * 128 + wr * 64 + m * 16 + fr; const long gr = grow0 + i;
                    const f32x4 a = acc[ai][0][m][nn], gt = acc[ai][1][m][nn]; f32x4 hv, a1, a2;
#pragma unroll
                    for (int j = 0; j < 4; ++j) {
                        a1[j] = __int_as_float(__builtin_amdgcn_update_dpp(__float_as_int(dppf<0x121>(prev[j])), __float_as_int(a[j]), 0x111, 0xf, 0xf, false));
                        a2[j] = __int_as_float(__builtin_amdgcn_update_dpp(__float_as_int(dppf<0x122>(prev[j])), __float_as_int(a[j]), 0x112, 0xf, 0xf, false));
                    }
                    {
                        const f32x4 cv = w0 * a2 + (w1 * a1 + (w2 * a + cb));
                        const f32x4 tt = cv * (cv * cv * 0.0356774081f + 0.7978845608f) * (-2.8853900818f);
                        f32x4 ee;
#pragma unroll
                        for (int j = 0; j < 4; ++j) ee[j] = __builtin_amdgcn_exp2f(tt[j]);
                        ee = ee + 1.0f;
#pragma unroll
                        for (int j = 0; j < 4; ++j) ee[j] = __builtin_amdgcn_rcpf(ee[j]);
                        hv = cv * ee * gt;
                    }
                    u32x2 wv; wv.x = cvt_pk_bf16(hv[0], hv[1]); wv.y = cvt_pk_bf16(hv[2], hv[3]);
                    const int tok = tok0 + i;
                    const bool valid = samp || (i >= 2 && tok < SEQ);
                    if (valid) *(u32x2*)(H + (size_t)gr * FF + fc) = wv;
                    if (!samp) { if (valid && tok >= SEQ - 2) { float* o = outc_p + ((size_t)(n * 2 + (tok - (SEQ - 2)))) * FF + fc; *(f32x4*)o = a; } }
                    else { if ((i & 63) >= 62) { float* o = outc_s + ((size_t)((4 * (u.pm - 132) + (i >> 6)) * 2 + ((i & 63) - 62))) * FF + fc; *(f32x4*)o = a; } }
                    prev = a;
                }
            }
        }
    }
};

struct EpiQKV {
    const float* sumsq; const float* bf; bf16_t* Q; bf16_t* Kp; bf16_t* Vp; bf16_t* Ks; bf16_t* Vs; float* out;
    __device__ __forceinline__ void operator()(f32x4 (&acc)[2][2][4][2], const pg8::Unit& u, int wr, int wc, int fr, int fq) const {
        const int sec = u.pn >> 2;
#pragma unroll
        for (int ai = 0; ai < 2; ++ai)
#pragma unroll
            for (int m = 0; m < 4; ++m) {
                const int row = u.pm * 256 + ai * 128 + wr * 64 + m * 16 + fr;
                const float rs = __builtin_amdgcn_rsqf(sumsq[row] * (1.0f / DM) + EPS);
                if (sec == 3) {
                    if (wc == 0 && fq < 2) {
                        const f32x4 v0 = acc[ai][0][m][0] * rs, v1 = acc[ai][0][m][1] * rs; f32x4 l0, l1;
#pragma unroll
                        for (int j = 0; j < 4; ++j) { const float x0 = v0[j] + bf[8 * fq + j], x1 = v1[j] + bf[8 * fq + 4 + j];
                            l0[j] = fminf(x0, 0.f) - log1pf(__expf(-fabsf(x0))); l1[j] = fminf(x1, 0.f) - log1pf(__expf(-fabsf(x1))); }
                        float* o = row < MP ? out + O_LF_P + (size_t)row * NH + 8 * fq : out + O_LF_S + (size_t)(row - MP) * NH + 8 * fq;
                        *(f32x4*)o = l0; *(f32x4*)(o + 4) = l1;
                    }
                } else {
#pragma unroll
                    for (int bj = 0; bj < 2; ++bj) {
                        const int col = (u.pn & 3) * 256 + bj * 128 + wc * 32 + fq * 8;
                        const float sc = sec == 0 ? rs * C2 : rs;
                        const f32x4 v0 = acc[ai][bj][m][0] * sc, v1 = acc[ai][bj][m][1] * sc;
                        u32x4 w; w.x = cvt_pk_bf16(v0[0], v0[1]); w.y = cvt_pk_bf16(v0[2], v0[3]); w.z = cvt_pk_bf16(v1[0], v1[1]); w.w = cvt_pk_bf16(v1[2], v1[3]);
                        if (sec == 0) { *(u32x4*)(Q + (size_t)row * DM + col) = w; }
                        else {
                            bf16_t* dst; float* o;
                            if (row < MP) { dst = (sec == 1 ? Kp : Vp) + (size_t)row * DM + col; o = out + (sec == 1 ? O_K_P : O_V_P) + (size_t)row * DM + col; }
                            else { const int rs_ = row - MP; dst = nullptr; o = out + (sec == 1 ? O_K_S : O_V_S) + (size_t)rs_ * DM + col; }
                            if (dst) *(u32x4*)dst = w; __builtin_nontemporal_store(v0, (f32x4*)o); __builtin_nontemporal_store(v1, (f32x4*)(o + 4));
                        }
                    }
                }
            }
    }
};

namespace att {
constexpr int OFF_K = 0, OFF_V = 16384, OFF_CK = 32768, OFF_WSF = 33280, OFF_OST = 35328;
__device__ __forceinline__ int crow(int r, int hi) { return (r & 3) + 8 * (r >> 2) + 4 * hi; }
__device__ __forceinline__ void glds16(const void* gsrc, unsigned lds_dst) { unsigned keep;
    asm volatile("s_mov_b32 %0, m0\n\ts_mov_b32 m0, %2\n\ts_nop 0\n\tglobal_load_lds_dwordx4 %1, off\n\ts_mov_b32 m0, %0" : "=&s"(keep) : "v"(gsrc), "s"(lds_dst) : "memory"); }
__device__ __forceinline__ void glds4(const void* gsrc, unsigned lds_dst) { unsigned keep;
    asm volatile("s_mov_b32 %0, m0\n\ts_mov_b32 m0, %2\n\ts_nop 0\n\tglobal_load_lds_dword %1, off\n\ts_mov_b32 m0, %0" : "=&s"(keep) : "v"(gsrc), "s"(lds_dst) : "memory"); }
__device__ __forceinline__ float max3f(float a, float b, float c) { return __builtin_fmaxf(__builtin_fmaxf(a, b), c); }
#define SBAR() __builtin_amdgcn_sched_barrier(0)
__device__ __forceinline__ void qkt(f32x16& p0, f32x16& p1, const char* Kslot, const bf16x8* qr, const f32x16& negm, int r32, int hi) {
    const char* kb = Kslot + hi * 1024 + r32 * 16;
#pragma unroll
    for (int d0 = 0; d0 < 4; ++d0) {
        const bf16x8 b0 = *reinterpret_cast<const bf16x8*>(kb + d0 * 2048);
        const bf16x8 b1 = *reinterpret_cast<const bf16x8*>(kb + d0 * 2048 + 512);
        if (d0 == 0) { p0 = __builtin_amdgcn_mfma_f32_32x32x16_bf16(b0, qr[0], negm, 0, 0, 0); p1 = __builtin_amdgcn_mfma_f32_32x32x16_bf16(b1, qr[0], negm, 0, 0, 0); }
        else { p0 = __builtin_amdgcn_mfma_f32_32x32x16_bf16(b0, qr[d0], p0, 0, 0, 0); p1 = __builtin_amdgcn_mfma_f32_32x32x16_bf16(b1, qr[d0], p1, 0, 0, 0); } }
}
__device__ __forceinline__ void pv(f32x16* o, int vb, bf16x8 pa0, bf16x8 pa1, bf16x8 pa2, bf16x8 pa3) {
#pragma unroll
    for (int d0 = 0; d0 < 2; ++d0) { s16x4 lo[4], hi[4];
#pragma unroll
        for (int ks = 0; ks < 4; ++ks) {
            asm volatile("ds_read_b64_tr_b16 %0,%1 offset:%c2" : "=&v"(lo[ks]) : "v"(vb), "i"(d0 * 4096 + ks * 1024) : "memory");
            asm volatile("ds_read_b64_tr_b16 %0,%1 offset:%c2" : "=&v"(hi[ks]) : "v"(vb), "i"(d0 * 4096 + ks * 1024 + 512) : "memory"); }
        asm volatile("s_waitcnt lgkmcnt(0)" ::: "memory"); SBAR();
#define PK(k) (bf16x8){lo[k][0], lo[k][1], lo[k][2], lo[k][3], hi[k][0], hi[k][1], hi[k][2], hi[k][3]}
        o[d0] = __builtin_amdgcn_mfma_f32_32x32x16_bf16(pa0, PK(0), o[d0], 0, 0, 0);
        o[d0] = __builtin_amdgcn_mfma_f32_32x32x16_bf16(pa1, PK(1), o[d0], 0, 0, 0);
        o[d0] = __builtin_amdgcn_mfma_f32_32x32x16_bf16(pa2, PK(2), o[d0], 0, 0, 0);
        o[d0] = __builtin_amdgcn_mfma_f32_32x32x16_bf16(pa3, PK(3), o[d0], 0, 0, 0);
#undef PK
    }
}
constexpr int OFF_CKA = 32768, OFF_WSF2 = 49408, OFF_OST2 = 51456;
__device__ __forceinline__ void attn_unit_sample(char* shm, const bf16_t* Q, const float* kc, const float* vc, const float* kn, const float* vn, bf16_t* O, const float* lfc, const float* lfn) {
    int tid_ = threadIdx.x; asm volatile("" : "+v"(tid_));
    const int tid = tid_, lane = tid & 63, r32 = lane & 31, hi = lane >> 5; const int wid = __builtin_amdgcn_readfirstlane(tid >> 6);
    const unsigned lds0 = (unsigned)(uintptr_t)shm;
    float* wsf = (float*)(shm + OFF_WSF2) + wid * 64;
    float* cka = (float*)(shm + OFF_CKA);
    constexpr int NT = KALL / 64, qpos0 = PAST;
    const int vrow = 16 * (wid & 3) + (lane >> 2), vcol = (wid >> 2) * 32 + (lane & 3) * 8;
    f32x4 kreg[4][2], vreg[4][2];
#define LOADT(t, q) do { const float* kp = (t) < PAST / 64 ? kc + ((size_t)(t) * 64 + lane) * DM + wid * 8 : kn + (size_t)lane * DM + wid * 8; \
        const float* vp = (t) < PAST / 64 ? vc + ((size_t)(t) * 64 + vrow) * DM + vcol : vn + (size_t)vrow * DM + vcol; \
        kreg[q][0] = *(const f32x4*)kp; kreg[q][1] = *(const f32x4*)(kp + 4); vreg[q][0] = *(const f32x4*)vp; vreg[q][1] = *(const f32x4*)(vp + 4); } while (0)
#define STORET(slot, q) do { u32x4 kw, vw; kw.x = cvt_pk_bf16(kreg[q][0][0], kreg[q][0][1]); kw.y = cvt_pk_bf16(kreg[q][0][2], kreg[q][0][3]); kw.z = cvt_pk_bf16(kreg[q][1][0], kreg[q][1][1]); kw.w = cvt_pk_bf16(kreg[q][1][2], kreg[q][1][3]); \
        vw.x = cvt_pk_bf16(vreg[q][0][0], vreg[q][0][1]); vw.y = cvt_pk_bf16(vreg[q][0][2], vreg[q][0][3]); vw.z = cvt_pk_bf16(vreg[q][1][0], vreg[q][1][1]); vw.w = cvt_pk_bf16(vreg[q][1][2], vreg[q][1][3]); \
        *(u32x4*)(shm + OFF_K + (slot) * 8192 + wid * 1024 + lane * 16) = kw; *(u32x4*)(shm + OFF_V + (slot) * 8192 + wid * 1024 + lane * 16) = vw; } while (0)
    LOADT(0, 0); LOADT(1, 1); LOADT(2, 2); LOADT(3, 3);
    {
        float v[9]; float tot = 0.f;
#pragma unroll
        for (int j = 0; j < 9; ++j) { const int k = 9 * tid + j; float x = 0.f; if (k < PAST) x = lfc[(size_t)k * NH]; else if (k < KALL) x = lfn[(size_t)(k - PAST) * NH]; tot += x; v[j] = tot; }
        float sc = tot;
#pragma unroll
        for (int o = 1; o < 64; o <<= 1) { const float t = __shfl_up(sc, o); if (lane >= o) sc += t; }
        float* wtot = (float*)(shm + OFF_WSF2);
        if (lane == 63) wtot[wid] = sc;
        asm volatile("s_waitcnt lgkmcnt(0)\n\ts_barrier" ::: "memory");
        float base = sc - tot;
#pragma unroll
        for (int w = 0; w < 8; ++w) { const float t = wtot[w]; if (w < wid) base += t; }
#pragma unroll
        for (int j = 0; j < 9; ++j) { const int k = 9 * tid + j; if (k < KALL) cka[k] = (base + v[j]) * LOG2E; }
        asm volatile("s_waitcnt lgkmcnt(0)\n\ts_barrier" ::: "memory");
    }
    const bool active = wid < 4; const int qw = wid & 1, kh = (wid >> 1) & 1;
    const int vb0 = (int)(lds0 + OFF_V) + ((lane >> 4) & 1) * 32 + (lane & 3) * 8 + (4 * hi + ((lane & 15) >> 2)) * 64 + kh * 2048;
    const bf16_t* Qw = Q + (long)(qw * 32) * DM;
    bf16x8 qr[4];
#pragma unroll
    for (int d0 = 0; d0 < 4; ++d0) qr[d0] = *reinterpret_cast<const bf16x8*>(&Qw[(long)r32 * DM + d0 * 16 + hi * 8]);
    const int qpos = qpos0 + qw * 32 + r32, qmin = qpos0 + qw * 32;
    float mhat = -cka[qpos], l_reg = 0.f;
    f32x16 o[2]; o[0] = f32x16{}; o[1] = f32x16{};
    f32x16 negm;
#pragma unroll
    for (int r = 0; r < 16; ++r) negm[r] = -mhat;
    for (int t0 = 0; t0 < NT; t0 += 4) {
#pragma unroll
      for (int q = 0; q < 4; ++q) {
        const int t = t0 + q; if (t >= NT) break;
        const int slot = q & 1;
        STORET(slot, q);
        if (t + 4 < NT) LOADT(t + 4, q);
        asm volatile("s_waitcnt lgkmcnt(0)\n\ts_barrier" ::: "memory");
        if (active) {
            f32x16 p0;
            { const char* kb = shm + OFF_K + slot * 8192 + hi * 1024 + (r32 + 32 * kh) * 16;
#pragma unroll
              for (int d0 = 0; d0 < 4; ++d0) { const bf16x8 b0 = *reinterpret_cast<const bf16x8*>(kb + d0 * 2048);
                  p0 = __builtin_amdgcn_mfma_f32_32x32x16_bf16(b0, qr[d0], d0 == 0 ? negm : p0, 0, 0, 0); } }
            const float* ckp = cka + 64 * t + 32 * kh;
#pragma unroll
            for (int a = 0; a < 4; ++a) { const f32x4 c0 = *(const f32x4*)(ckp + 8 * a + 4 * hi);
#pragma unroll
                for (int j = 0; j < 4; ++j) p0[4 * a + j] -= c0[j]; }
            if (64 * t + 63 > qmin) {
#pragma unroll
                for (int r = 0; r < 16; ++r) { const int kv = 64 * t + 32 * kh + crow(r, hi); if (kv > qpos) p0[r] = -1e30f; }
            }
            float a = max3f(p0[0], p0[1], p0[2]), b = max3f(p0[3], p0[4], p0[5]);
#pragma unroll
            for (int r = 6; r < 16; r += 2) { a = __builtin_fmaxf(a, p0[r]); b = __builtin_fmaxf(b, p0[r + 1]); }
            float rm = __builtin_fmaxf(a, b); rm = __builtin_fmaxf(rm, __shfl_xor(rm, 32));
            if (__any(rm > 8.f)) {
                const float dl = __builtin_fmaxf(rm, 0.f); mhat += dl;
#pragma unroll
                for (int r = 0; r < 16; ++r) p0[r] -= dl;
#pragma unroll
                for (int r = 0; r < 16; ++r) negm[r] = -mhat;
                const float f = __builtin_amdgcn_exp2f(-dl); l_reg *= f; if (hi == 0) wsf[r32] = f;
                LDS_WAIT();
#pragma unroll
                for (int d_ = 0; d_ < 2; ++d_)
#pragma unroll
                    for (int r = 0; r < 16; ++r) o[d_][r] *= wsf[crow(r, hi)];
            }
            float sacc = 0.f;
#pragma unroll
            for (int r = 0; r < 16; ++r) { p0[r] = __builtin_amdgcn_exp2f(p0[r]); sacc += p0[r]; }
            l_reg += sacc;
            u32x4 pw0, pw1;
            pw0 = (u32x4){cvtpk_s(p0[0], p0[1]), cvtpk_s(p0[2], p0[3]), cvtpk_s(p0[4], p0[5]), cvtpk_s(p0[6], p0[7])};
            pw1 = (u32x4){cvtpk_s(p0[8], p0[9]), cvtpk_s(p0[10], p0[11]), cvtpk_s(p0[12], p0[13]), cvtpk_s(p0[14], p0[15])};
            SBAR();
            { const int vb = vb0 + slot * 8192; const bf16x8 pa0 = __builtin_bit_cast(bf16x8, pw0), pa1 = __builtin_bit_cast(bf16x8, pw1);
#pragma unroll
              for (int d0 = 0; d0 < 2; ++d0) { s16x4 lo[2], hi2[2];
#pragma unroll
                for (int ks = 0; ks < 2; ++ks) {
                    asm volatile("ds_read_b64_tr_b16 %0,%1 offset:%c2" : "=&v"(lo[ks]) : "v"(vb), "i"(d0 * 4096 + ks * 1024) : "memory");
                    asm volatile("ds_read_b64_tr_b16 %0,%1 offset:%c2" : "=&v"(hi2[ks]) : "v"(vb), "i"(d0 * 4096 + ks * 1024 + 512) : "memory"); }
                asm volatile("s_waitcnt lgkmcnt(0)" ::: "memory"); SBAR();
#define PK(k) (bf16x8){lo[k][0], lo[k][1], lo[k][2], lo[k][3], hi2[k][0], hi2[k][1], hi2[k][2], hi2[k][3]}
                o[d0] = __builtin_amdgcn_mfma_f32_32x32x16_bf16(pa0, PK(0), o[d0], 0, 0, 0);
                o[d0] = __builtin_amdgcn_mfma_f32_32x32x16_bf16(pa1, PK(1), o[d0], 0, 0, 0);
#undef PK
              } }
        }
      }
    }
    asm volatile("s_waitcnt lgkmcnt(0)\n\ts_barrier" ::: "memory");
    l_reg += __shfl_xor(l_reg, 32);
    float* mrg = (float*)(shm + OFF_K) + qw * (2 * 32 + 32 * 64);
    if (active && kh == 1) {
        if (hi == 0) { mrg[r32] = mhat; mrg[32 + r32] = l_reg; }
#pragma unroll
        for (int d0 = 0; d0 < 2; ++d0)
#pragma unroll
            for (int r = 0; r < 16; ++r) mrg[64 + (d0 * 16 + r) * 64 + lane] = o[d0][r];
    }
    asm volatile("s_waitcnt lgkmcnt(0)\n\ts_barrier" ::: "memory");
    if (active && kh == 0) {
        const float m1 = mrg[r32], l1 = mrg[32 + r32];
        const float mm = __builtin_fmaxf(mhat, m1), f0 = __builtin_amdgcn_exp2f(mhat - mm), f1 = __builtin_amdgcn_exp2f(m1 - mm);
        const float lt = l_reg * f0 + l1 * f1;
        if (hi == 0) { wsf[r32] = f0 * __builtin_amdgcn_rcpf(lt); wsf[32 + r32] = f1 * __builtin_amdgcn_rcpf(lt); }
        LDS_WAIT();
        bf16_t* Ow = O + (long)(qw * 32) * DM;
        __hip_bfloat16* stg = (__hip_bfloat16*)(shm + OFF_OST2) + wid * 2048;
#pragma unroll
        for (int r = 0; r < 16; ++r) { const int orow = crow(r, hi); const float s0 = wsf[orow], s1 = wsf[32 + orow];
#pragma unroll
            for (int d0 = 0; d0 < 2; ++d0) stg[orow * 64 + d0 * 32 + r32] = __float2bfloat16(o[d0][r] * s0 + mrg[64 + (d0 * 16 + r) * 64 + lane] * s1); }
        LDS_WAIT();
#pragma unroll
        for (int i = 0; i < 4; ++i) { const int row = i * 8 + (lane >> 3), ch = lane & 7; const u32x4 v = *(const u32x4*)(stg + row * 64 + ch * 8); *(u32x4*)(Ow + (long)row * DM + ch * 8) = v; }
    }
    asm volatile("s_waitcnt vmcnt(0) lgkmcnt(0)\n\ts_barrier" ::: "memory");
#undef LOADT
#undef STORET
}
#undef SBAR
}

namespace atf {
using bf16=__hip_bfloat16;
constexpr int SEQ=8192,D=64,DM=1024,NW=8,QBLK=32,QB=QBLK*NW,KVBLK=64;
__device__ __forceinline__ int crow(int r,int hi){return (r&3)+8*(r>>2)+4*hi;}
#define SBAR() __builtin_amdgcn_sched_barrier(0)
__device__ __forceinline__ void cmask(f32x16&p0,f32x16&p1,int jb,int qrel,int hi){
  const float NEG=-INFINITY; int kb=64*jb+4*hi;
  #pragma unroll
  for(int r=0;r<16;++r){int kv=kb+(r&3)+8*(r>>2); if(kv>qrel)p0[r]=NEG; if(kv+32>qrel)p1[r]=NEG;}
}

constexpr int NSLOT=3, SLOTB=8192;
constexpr int LDS_K=0, LDS_V=NSLOT*SLOTB, LDS_X=2*NSLOT*SLOTB, LDS_WS=LDS_X+NSLOT*2048, LDS_OST=LDS_WS+NW*64*4, LDS_BYTES=LDS_OST+NW*4096;
__device__ __forceinline__ void glds16(const void*gsrc,unsigned lds_dst){unsigned keep;
  asm volatile("s_mov_b32 %0, m0\n\ts_mov_b32 m0, %2\n\ts_nop 0\n\tglobal_load_lds_dwordx4 %1, off\n\ts_mov_b32 m0, %0":"=&s"(keep):"v"(gsrc),"s"(lds_dst):"memory");}
__device__ __forceinline__ void glds4(const void*gsrc,unsigned lds_dst){unsigned keep;
  asm volatile("s_mov_b32 %0, m0\n\ts_mov_b32 m0, %2\n\ts_nop 0\n\tglobal_load_lds_dword %1, off\n\ts_mov_b32 m0, %0":"=&s"(keep):"v"(gsrc),"s"(lds_dst):"memory");}
__device__ __forceinline__ bf16x8 mkqx(float mhat,int hi){ const float nv=-mhat; const unsigned h1=(__builtin_bit_cast(unsigned,nv)+0x7fffu+((__builtin_bit_cast(unsigned,nv)>>16)&1u))>>16; const float r1=nv-__builtin_bit_cast(float,h1<<16);
  const unsigned u1=__builtin_bit_cast(unsigned,r1), h2=(u1+0x7fffu+((u1>>16)&1u))>>16; const float r2=r1-__builtin_bit_cast(float,h2<<16); const unsigned u2=__builtin_bit_cast(unsigned,r2), h3=(u2+0x7fffu+((u2>>16)&1u))>>16;
  u32x4 w=hi?(u32x4){0u,0u,0u,0u}:(u32x4){0x3f803f80u,0x3f80u|(h1<<16),h2|(h3<<16),0u}; return __builtin_bit_cast(bf16x8,w); }
__device__ __forceinline__ float max3f(float a,float b,float c){float r;asm("v_max3_f32 %0, %1, %2, %3":"=v"(r):"v"(a),"v"(b),"v"(c));return r;}
__device__ __forceinline__ float max2f(float a,float b){float r;asm("v_max_f32_e32 %0, %1, %2":"=v"(r):"v"(a),"v"(b));return r;}
__device__ __forceinline__ float fadd_s(float a,float b){float r;asm("v_add_f32_e32 %0, %1, %2":"=v"(r):"v"(a),"v"(b));return r;}
__device__ __forceinline__ float fsub_s(float a,float b){float r;asm("v_sub_f32_e32 %0, %1, %2":"=v"(r):"v"(a),"v"(b));return r;}
typedef float f32x2_t __attribute__((ext_vector_type(2))); typedef __bf16 bf16x2_t __attribute__((ext_vector_type(2)));
__device__ __forceinline__ unsigned cvtpk_s(float lo,float hi){f32x2_t v={lo,hi};bf16x2_t b=__builtin_convertvector(v,bf16x2_t);return __builtin_bit_cast(unsigned,b);}
#define WAIT_BAR(N) asm volatile("s_waitcnt vmcnt(" #N ") lgkmcnt(0)\n\ts_barrier":::"memory")

__device__ __forceinline__ void qkt(f32x16&p0,f32x16&p1,const char*Kslot,const char*Xslot,const bf16x8*qr,const bf16x8 qx,const f32x16&negm,int r32,int hi){
  const char*kb=Kslot+hi*1024+r32*16;
  #pragma unroll
  for(int d0=0;d0<4;++d0){
    const bf16x8 b0=*reinterpret_cast<const bf16x8*>(kb+d0*2048);
    const bf16x8 b1=*reinterpret_cast<const bf16x8*>(kb+d0*2048+512);
    if(d0==0){p0=__builtin_amdgcn_mfma_f32_32x32x16_bf16(b0,qr[0],negm,0,0,0);p1=__builtin_amdgcn_mfma_f32_32x32x16_bf16(b1,qr[0],negm,0,0,0);}
    else{p0=__builtin_amdgcn_mfma_f32_32x32x16_bf16(b0,qr[d0],p0,0,0,0);p1=__builtin_amdgcn_mfma_f32_32x32x16_bf16(b1,qr[d0],p1,0,0,0);}}
  { const char*xb=Xslot+hi*1024+r32*16; const bf16x8 x0=*reinterpret_cast<const bf16x8*>(xb), x1=*reinterpret_cast<const bf16x8*>(xb+512);
    p0=__builtin_amdgcn_mfma_f32_32x32x16_bf16(x0,qx,p0,0,0,0);p1=__builtin_amdgcn_mfma_f32_32x32x16_bf16(x1,qx,p1,0,0,0); }
}
typedef __attribute__((address_space(3))) const char* lds_cptr;
typedef short v4i16_t __attribute__((ext_vector_type(4)));
__device__ __forceinline__ void kloadx(bf16x8*kf,lds_cptr xp){ kf[8]=*(const __attribute__((address_space(3))) bf16x8*)(xp); kf[9]=*(const __attribute__((address_space(3))) bf16x8*)(xp+512); }
__device__ __forceinline__ void kload8(bf16x8*kf,lds_cptr kp){
  kf[0]=*(const __attribute__((address_space(3))) bf16x8*)(kp);      kf[1]=*(const __attribute__((address_space(3))) bf16x8*)(kp+512);
  kf[2]=*(const __attribute__((address_space(3))) bf16x8*)(kp+2048); kf[3]=*(const __attribute__((address_space(3))) bf16x8*)(kp+2560);
  kf[4]=*(const __attribute__((address_space(3))) bf16x8*)(kp+4096); kf[5]=*(const __attribute__((address_space(3))) bf16x8*)(kp+4608);
  kf[6]=*(const __attribute__((address_space(3))) bf16x8*)(kp+6144); kf[7]=*(const __attribute__((address_space(3))) bf16x8*)(kp+6656);
}
__device__ __forceinline__ void kload2(bf16x8*kf,lds_cptr kp,int j){ kf[2*j]=*(const __attribute__((address_space(3))) bf16x8*)(kp+j*2048); kf[2*j+1]=*(const __attribute__((address_space(3))) bf16x8*)(kp+j*2048+512); }
__device__ __forceinline__ s16x4 vtr(lds_cptr p){ return __builtin_bit_cast(s16x4,__builtin_amdgcn_ds_read_tr16_b64_v4i16((__attribute__((address_space(3))) v4i16_t*)p)); }
__device__ __forceinline__ float rowmax(const f32x16&p0,const f32x16&p1){
  float a=max3f(p0[0],p0[1],p1[0]),b=max3f(p0[2],p0[3],p1[1]);a=max3f(a,p1[2],p1[3]);
  #pragma unroll
  for(int r=4;r<16;r+=4){a=max3f(a,p0[r],p0[r+1]);b=max3f(b,p0[r+2],p0[r+3]);a=max3f(a,p1[r],p1[r+1]);b=max3f(b,p1[r+2],p1[r+3]);}
  const float m=max2f(a,b);
  auto rr=__builtin_amdgcn_permlane32_swap(__float_as_uint(m),__float_as_uint(m),false,false);
  return max2f(__uint_as_float(rr[0]),__uint_as_float(rr[1]));
}
__device__ __forceinline__ void pv(f32x16*o,int vb,bf16x8 pa0,bf16x8 pa1,bf16x8 pa2,bf16x8 pa3){
  #pragma unroll
  for(int d0=0;d0<2;++d0){s16x4 lo[4],hi[4];
    #pragma unroll
    for(int ks=0;ks<4;++ks){
      asm volatile("ds_read_b64_tr_b16 %0,%1 offset:%c2":"=&v"(lo[ks]):"v"(vb),"i"(d0*4096+ks*1024):"memory");
      asm volatile("ds_read_b64_tr_b16 %0,%1 offset:%c2":"=&v"(hi[ks]):"v"(vb),"i"(d0*4096+ks*1024+512):"memory");}
    asm volatile("s_waitcnt lgkmcnt(0)":::"memory");SBAR();
    #define PK(k) (bf16x8){lo[k][0],lo[k][1],lo[k][2],lo[k][3],hi[k][0],hi[k][1],hi[k][2],hi[k][3]}
    o[d0]=__builtin_amdgcn_mfma_f32_32x32x16_bf16(pa0,PK(0),o[d0],0,0,0);
    o[d0]=__builtin_amdgcn_mfma_f32_32x32x16_bf16(pa1,PK(1),o[d0],0,0,0);
    o[d0]=__builtin_amdgcn_mfma_f32_32x32x16_bf16(pa2,PK(2),o[d0],0,0,0);
    o[d0]=__builtin_amdgcn_mfma_f32_32x32x16_bf16(pa3,PK(3),o[d0],0,0,0);
    #undef PK
  }
}

#ifndef ATTN_STORE16
#define ATTN_STORE16(p,v) (*(u32x4*)(p)=(v))
#endif
template<int THRL> __device__ __forceinline__ void attn_unit(int b,int h,int qb,const bf16*Q,const bf16*__restrict__ K,const bf16*__restrict__ V,bf16*O,const bf16*__restrict__ KX,const float*__restrict__ CK,char*shm){
  int tid_=threadIdx.x; asm volatile("":"+v"(tid_)); const int tid=tid_,lane=tid&63,r32=lane&31,hi=lane>>5; const int wid=__builtin_amdgcn_readfirstlane(tid>>6);
  const long rowbase=(long)b*SEQ; const int q0=qb*QB;
  const bf16*Qw=Q+(rowbase+q0+wid*QBLK)*DM+h*D;
  const bf16*Kh=K+rowbase*DM+h*D,*Vh=V+rowbase*DM+h*D;
  const unsigned lds0=(unsigned)(uintptr_t)shm;
  float*wsf=(float*)(shm+LDS_WS)+wid*64;
  const bf16*ksrc=Kh+(long)lane*DM+wid*8;
  const bf16*vsrc=Vh+(long)(16*(wid&3)+(lane>>2))*DM+(wid>>2)*32+(lane&3)*8;
  const bf16*xsrc=KX+(long)(16*(wid&3)+(lane>>2))*16+(wid>>2)*8+(lane&3)*2;
  const unsigned kdst=lds0+LDS_K+wid*1024, vdst=lds0+LDS_V+wid*1024, xdst=lds0+LDS_X+wid*256;
  #define DMA_K(t,slot) do{ glds16(ksrc+(long)(t)*KVBLK*DM,(unsigned)__builtin_amdgcn_readfirstlane(kdst+(slot))); glds4(xsrc+(long)(t)*KVBLK*16,(unsigned)__builtin_amdgcn_readfirstlane(xdst+((slot)>>2))); }while(0)
  #define DMA_V(t,slot) glds16(vsrc+(long)(t)*KVBLK*DM,(unsigned)__builtin_amdgcn_readfirstlane(vdst+(slot)))
  const int vb0=(int)(lds0+LDS_V)+((lane>>4)&1)*32+(lane&3)*8+(4*hi+((lane&15)>>2))*64;
  const char*Kbase=shm+LDS_K; const char*Xbase=shm+LDS_X; bf16x8 kf[10];
  const lds_cptr shm3=(lds_cptr)shm; const lds_cptr kp0=shm3+LDS_K+hi*1024+r32*16; const lds_cptr xp0=shm3+LDS_X+hi*1024+r32*16; const lds_cptr vp0=shm3+LDS_V+((lane>>4)&1)*32+(lane&3)*8+(4*hi+((lane&15)>>2))*64;
  const int NT=(q0+QB)/KVBLK;
  DMA_K(0,0);DMA_V(0,0);DMA_K(1,SLOTB);
  bf16x8 qr[4];
  #pragma unroll
  for(int d0=0;d0<4;++d0)qr[d0]=*reinterpret_cast<const bf16x8*>(&Qw[(long)r32*DM+d0*16+hi*8]);
  const int qrel=wid*QBLK+r32;
  float mhat=-CK[q0+qrel],l_reg=0.f;f32x16 o[2];o[0]=f32x16{};o[1]=f32x16{};const f32x16 negm=f32x16{};
  bf16x8 qx=mkqx(mhat,hi);
  #define CMASK(P0,P1,t) do{int jb_=(t)-(NT-4); if(jb_>=0)cmask(P0,P1,jb_,qrel,hi);}while(0)
  bool resc=false;
  #define START(P0,P1) do{ const float rm=rowmax(P0,P1); resc=false; \
    { const float dl=rm; mhat=fadd_s(mhat,dl); \
      _Pragma("unroll") for(int r=0;r<16;++r){P0[r]=fsub_s(P0[r],dl);P1[r]=fsub_s(P1[r],dl);} \
      _Pragma("unroll") for(int r=0;r<16;++r)negm[r]=-mhat; asm volatile("":"+v"(negm)); } \
    _Pragma("unroll") for(int r=0;r<16;++r)P0[r]=__builtin_amdgcn_exp2f(P0[r]); }while(0)
  #define RESC() do{ if(resc){ asm volatile("s_waitcnt lgkmcnt(0)":::"memory"); \
      _Pragma("unroll") for(int d_=0;d_<2;++d_) _Pragma("unroll") for(int r=0;r<16;++r)o[d_][r]*=wsf[crow(r,hi)]; } }while(0)
  f32x16 pA0,pA1,pB0,pB1;
  int sl_prev=0,sl_cur=0,sl_next=SLOTB;
  #define ROT() do{sl_prev=sl_cur;sl_cur=sl_next;sl_next=(sl_next==(NSLOT-1)*SLOTB)?0:sl_next+SLOTB;}while(0)
  DMA_K(2,2*SLOTB);
  WAIT_BAR(5);
  qkt(pA0,pA1,Kbase,Xbase,qr,qx,negm,r32,hi);asm volatile("s_nop 15\n\ts_nop 7":"+v"(pA0),"+v"(pA1));CMASK(pA0,pA1,0);
  _Pragma("unroll") for(int r=0;r<16;++r){pA0[r]=__builtin_amdgcn_exp2f(pA0[r]);pA1[r]=__builtin_amdgcn_exp2f(pA1[r]);}
  WAIT_BAR(0);
  DMA_K(3,0);DMA_V(1,SLOTB);
  ROT();
  kload8(kf,kp0+sl_cur); kloadx(kf,xp0+(sl_cur>>2));
  WAIT_BAR(3);
  s16x4 vlo[8],vhi[8]; u32x4 pw0,pw1,pw2,pw3;
  #define PKW(P,B) cvtpk_s(P[B],P[B+1])
  #define PAF(k) __builtin_bit_cast(bf16x8,pw##k)
  #define VFR(i) (bf16x8){vlo[i][0],vlo[i][1],vlo[i][2],vlo[i][3],vhi[i][0],vhi[i][1],vhi[i][2],vhi[i][3]}
  #define PIN(x) asm volatile("":"+v"(x))
  #define MX3(a,b,c) __builtin_fmaxf(__builtin_fmaxf((a),(b)),(c))
  #define GAPA(MF,A0,A1,A2,A3,W0,W1,PW) do{ MF; sacc+=A0; sacc+=A1; sacc+=A2; sacc+=A3; PIN(sacc); W0; W1; PIN(PW); SBAR(); }while(0)
  #define EX(v) __builtin_amdgcn_exp2f(v)
  #define GAPB(MF,X,B) do{ MF; X[B]=EX(X[B]); X[B+1]=EX(X[B+1]); X[B+2]=EX(X[B+2]); X[B+3]=EX(X[B+3]); PIN(X); SBAR(); }while(0)
  #define VRD(i) do{ vlo[i]=vtr(vp_+(((i)>>2)*4096+((i)&3)*1024)); vhi[i]=vtr(vp_+(((i)>>2)*4096+((i)&3)*1024+512)); }while(0)
  #define KRD(G,j) do{ if(G){ kload2(kf,kp0+sl_next,j); if((j)==3) kloadx(kf,xp0+(sl_next>>2)); SBAR(); } }while(0)
  #define STEP(C0,C1,P0,P1,t,GK,GV,GL) do{ SBAR(); \
    const lds_cptr vp_=vp0+sl_prev; \
    VRD(0); SBAR(); float sacc=(P0[0]+P0[1]); \
    GAPA(C0=__builtin_amdgcn_mfma_f32_32x32x16_bf16(kf[0],qr[0],negm,0,0,0), P0[2],P0[3],P0[4],P0[5],     pw0[0]=PKW(P0,0), pw0[1]=PKW(P0,2), pw0); \
    VRD(4); SBAR(); GAPA(C1=__builtin_amdgcn_mfma_f32_32x32x16_bf16(kf[1],qr[0],negm,0,0,0), P0[6],P0[7],P0[8],P0[9],     pw0[2]=PKW(P0,4), pw0[3]=PKW(P0,6), pw0); \
    VRD(1); SBAR(); GAPA(C0=__builtin_amdgcn_mfma_f32_32x32x16_bf16(kf[2],qr[1],C0,0,0,0),   P0[10],P0[11],P0[12],P0[13], pw1[0]=PKW(P0,8), pw1[1]=PKW(P0,10), pw1); \
    VRD(5); SBAR(); GAPA(C1=__builtin_amdgcn_mfma_f32_32x32x16_bf16(kf[3],qr[1],C1,0,0,0),   P0[14],P0[15],P1[0],P1[1],   pw1[2]=PKW(P0,12),pw1[3]=PKW(P0,14), pw1); \
    VRD(2); SBAR(); GAPA(C0=__builtin_amdgcn_mfma_f32_32x32x16_bf16(kf[4],qr[2],C0,0,0,0),   P1[2],P1[3],P1[4],P1[5],     pw2[0]=PKW(P1,0), pw2[1]=PKW(P1,2), pw2); \
    VRD(6); SBAR(); GAPA(C1=__builtin_amdgcn_mfma_f32_32x32x16_bf16(kf[5],qr[2],C1,0,0,0),   P1[6],P1[7],P1[8],P1[9],     pw2[2]=PKW(P1,4), pw2[3]=PKW(P1,6), pw2); \
    VRD(3); SBAR(); GAPA(C0=__builtin_amdgcn_mfma_f32_32x32x16_bf16(kf[6],qr[3],C0,0,0,0),   P1[10],P1[11],P1[12],P1[13], pw3[0]=PKW(P1,8), pw3[1]=PKW(P1,10), pw3); \
    VRD(7); SBAR(); GAPA(C1=__builtin_amdgcn_mfma_f32_32x32x16_bf16(kf[7],qr[3],C1,0,0,0),   P1[14],P1[15],0.f,0.f,       pw3[2]=PKW(P1,12),pw3[3]=PKW(P1,14), pw3); \
    C0=__builtin_amdgcn_mfma_f32_32x32x16_bf16(kf[8],qx,C0,0,0,0); C1=__builtin_amdgcn_mfma_f32_32x32x16_bf16(kf[9],qx,C1,0,0,0); SBAR(); \
    l_reg+=sacc; \
    if(GK){DMA_K((t)+3,sl_cur);} if(GV){DMA_V((t)+1,sl_next);} \
    CMASK(C0,C1,t); \
    { float a=MX3(C0[0],C0[1],C1[0]),b=MX3(C0[2],C0[3],C1[1]); a=MX3(a,C1[2],C1[3]); \
      _Pragma("unroll") for(int r=4;r<16;r+=4){a=MX3(a,C0[r],C0[r+1]);b=MX3(b,C0[r+2],C0[r+3]);a=MX3(a,C1[r],C1[r+1]);b=MX3(b,C1[r+2],C1[r+3]);} \
      float rm=__builtin_fmaxf(a,b); { auto rr=__builtin_amdgcn_permlane32_swap(__float_as_uint(rm),__float_as_uint(rm),false,false); rm=__builtin_fmaxf(__uint_as_float(rr[0]),__uint_as_float(rr[1])); } \
      resc=false; \
      if(__builtin_expect(__any(rm>(float)THRL),0)){ const float dl=__builtin_fmaxf(rm,0.f); mhat+=dl; \
        _Pragma("unroll") for(int r=0;r<16;++r){C0[r]-=dl;C1[r]-=dl;} \
        qx=mkqx(mhat,hi); \
        const float f=__builtin_amdgcn_exp2f(-dl); l_reg*=f; if(hi==0)wsf[r32]=f; resc=true; } } \
    SBAR(); \
    GAPB(o[0]=__builtin_amdgcn_mfma_f32_32x32x16_bf16(PAF(0),VFR(0),o[0],0,0,0), C0,0); \
    GAPB(o[1]=__builtin_amdgcn_mfma_f32_32x32x16_bf16(PAF(0),VFR(4),o[1],0,0,0), C0,4); \
    KRD(GL,0); GAPB(o[0]=__builtin_amdgcn_mfma_f32_32x32x16_bf16(PAF(1),VFR(1),o[0],0,0,0), C0,8); \
    KRD(GL,1); GAPB(o[1]=__builtin_amdgcn_mfma_f32_32x32x16_bf16(PAF(1),VFR(5),o[1],0,0,0), C0,12); \
    KRD(GL,2); GAPB(o[0]=__builtin_amdgcn_mfma_f32_32x32x16_bf16(PAF(2),VFR(2),o[0],0,0,0), C1,0); \
    KRD(GL,3); GAPB(o[1]=__builtin_amdgcn_mfma_f32_32x32x16_bf16(PAF(2),VFR(6),o[1],0,0,0), C1,4); \
    GAPB(o[0]=__builtin_amdgcn_mfma_f32_32x32x16_bf16(PAF(3),VFR(3),o[0],0,0,0), C1,8); \
    GAPB(o[1]=__builtin_amdgcn_mfma_f32_32x32x16_bf16(PAF(3),VFR(7),o[1],0,0,0), C1,12); \
    }while(0)
  int t=1;
  #undef CMASK
  #define CMASK(P0,P1,t) do{}while(0)
  for(;t+5<NT;t+=2){
    STEP(pB0,pB1,pA0,pA1,t,true,true,true);     WAIT_BAR(3); RESC(); ROT();
    STEP(pA0,pA1,pB0,pB1,t+1,true,true,true);   WAIT_BAR(3); RESC(); ROT();
  }
  #undef CMASK
  #define CMASK(P0,P1,t) do{int jb_=(t)-(NT-4); if(jb_>=0)cmask(P0,P1,jb_,qrel,hi);}while(0)
  #define ENDW(tt) do{ if((tt)+3<NT){WAIT_BAR(3);} else if((tt)+2<NT){WAIT_BAR(1);} else {WAIT_BAR(0);} }while(0)
  for(;t+1<NT;t+=2){
    STEP(pB0,pB1,pA0,pA1,t,(t+3<NT),(t+1<NT),(t+1<NT));       ENDW(t);   RESC(); ROT();
    STEP(pA0,pA1,pB0,pB1,t+1,(t+4<NT),(t+2<NT),(t+2<NT));     ENDW(t+1); RESC(); ROT();
  }
  STEP(pB0,pB1,pA0,pA1,NT-1,false,false,false); RESC();
  { float sacc=pB0[0]+pB0[1]; _Pragma("unroll") for(int r=2;r<16;++r)sacc+=pB0[r]; _Pragma("unroll") for(int r=0;r<16;++r)sacc+=pB1[r]; l_reg+=sacc;
    pw0=(u32x4){PKW(pB0,0),PKW(pB0,2),PKW(pB0,4),PKW(pB0,6)};pw1=(u32x4){PKW(pB0,8),PKW(pB0,10),PKW(pB0,12),PKW(pB0,14)};pw2=(u32x4){PKW(pB1,0),PKW(pB1,2),PKW(pB1,4),PKW(pB1,6)};pw3=(u32x4){PKW(pB1,8),PKW(pB1,10),PKW(pB1,12),PKW(pB1,14)};
    SBAR(); pv(o,vb0+sl_cur,PAF(0),PAF(1),PAF(2),PAF(3)); }
  #undef PKW
  #undef PAF
  #undef VFR
  #undef PIN
  #undef MX3
  #undef GAPA
  #undef GAPB
  #undef EX
  #undef VRD
  #undef KRD
  #undef STEP
  #undef ENDW
  {auto rr=__builtin_amdgcn_permlane32_swap(__float_as_uint(l_reg),__float_as_uint(l_reg),false,false);l_reg=__uint_as_float(rr[0])+__uint_as_float(rr[1]);}
  if(hi==0)wsf[32+r32]=l_reg;asm volatile("s_waitcnt lgkmcnt(0)":::"memory");
  float rli[16];
  #pragma unroll
  for(int r=0;r<16;++r)rli[r]=__builtin_amdgcn_rcpf(wsf[32+crow(r,hi)]);
  bf16*Ow=O+(rowbase+q0+wid*QBLK)*DM+h*D;
  { bf16*stg=(bf16*)(shm+LDS_OST)+wid*2048;
    #pragma unroll
    for(int r=0;r<16;++r){const int orow=crow(r,hi);
      #pragma unroll
      for(int d0=0;d0<2;++d0)stg[orow*64+d0*32+r32]=__float2bfloat16(o[d0][r]*rli[r]);}
    asm volatile("s_waitcnt lgkmcnt(0)":::"memory");
    #pragma unroll
    for(int i=0;i<4;++i){const int row=i*8+(lane>>3),ch=lane&7; const u32x4 v=*(const u32x4*)(stg+row*64+ch*8); ATTN_STORE16(Ow+(long)row*DM+ch*8,v);} }
  asm volatile("s_waitcnt lgkmcnt(0)\n\ts_barrier":::"memory");
  #undef DMA_K
  #undef DMA_V
  #undef CMASK
  #undef START
  #undef RESC
  #undef ROT
}
#undef SBAR
#undef WAIT_BAR
}

__device__ __forceinline__ unsigned f2bf(float f) { unsigned u = __builtin_bit_cast(unsigned, f); return (u + 0x7fffu + ((u >> 16) & 1u)) >> 16; }
__device__ __forceinline__ unsigned pk2(float lo, float hi) { return f2bf(lo) | (f2bf(hi) << 16); }
__device__ __forceinline__ void wg_cumsum_prompt(const float* lf, int b, int h, float* ckw, bf16_t* kxw, LAS float* scr) {
    int tid = threadIdx.x; asm volatile("" : "+v"(tid)); const int lane = tid & 63, wave = tid >> 6;
    const float* src = lf + ((size_t)b * SEQ + 16 * tid) * NH + h;
    float v[16]; float tot = 0.f;
#pragma unroll
    for (int j = 0; j < 16; ++j) { tot += src[j * NH]; v[j] = tot; }
    float sc = tot;
#pragma unroll
    for (int o = 1; o < 64; o <<= 1) { const float t = __shfl_up(sc, o); if (lane >= o) sc += t; }
    if (lane == 63) scr[wave] = sc;
    __syncthreads();
    float base = sc - tot;
#pragma unroll
    for (int w = 0; w < 8; ++w) { const float t = scr[w]; if (w < wave) base += t; }
    float* cd = ckw + 16 * tid; u32x4* kx = (u32x4*)(kxw + (size_t)16 * tid * 16);
#pragma unroll
    for (int j = 0; j < 16; ++j) { const float c2 = (base + v[j]) * LOG2E; cd[j] = c2; const float nv = -c2; const unsigned h1 = f2bf(nv); const float r1 = nv - __uint_as_float(h1 << 16);
        const unsigned h2 = f2bf(r1); const float r2 = r1 - __uint_as_float(h2 << 16); const unsigned h3 = f2bf(r2);
        kx[2 * j] = (u32x4){h1 | (h2 << 16), h3 | 0x3f800000u, 0x3f803f80u, 0u}; kx[2 * j + 1] = (u32x4){0u, 0u, 0u, 0u}; }
    asm volatile("s_waitcnt vmcnt(0)" ::: "memory");
    __syncthreads();
}

__device__ __forceinline__ void transpose_item(const float* W, int K, int Nsrc, int src_n0, int valid, const float* kscale, bf16_t* WT, int dst_row0, LAS float* scr, int kb, int lane) {
    const int k0 = 64 * kb;
#pragma unroll
    for (int i = 0; i < 8; ++i) { const int kk = 8 * i + (lane >> 3), c4 = (lane & 7) * 4;
        f32x4 v = (c4 < valid) ? *(const f32x4*)(W + (size_t)(k0 + kk) * Nsrc + src_n0 + c4) : (f32x4){0.f, 0.f, 0.f, 0.f};
        if (kscale) v *= kscale[k0 + kk];
#pragma unroll
        for (int j = 0; j < 4; ++j) scr[kk * 33 + c4 + j] = (c4 + j < valid) ? v[j] : 0.f; }
    LDS_WAIT(); asm volatile("" ::: "memory");
    const int c = lane & 7;
#pragma unroll
    for (int j = 0; j < 4; ++j) { const int n = (lane >> 3) + 8 * j; const LAS float* s = scr + (8 * c) * 33 + n;
        u32x4 o; o.x = pk2(s[0 * 33], s[1 * 33]); o.y = pk2(s[2 * 33], s[3 * 33]); o.z = pk2(s[4 * 33], s[5 * 33]); o.w = pk2(s[6 * 33], s[7 * 33]);
        *(u32x4*)(WT + (size_t)(dst_row0 + n) * K + k0 + 8 * c) = o; }
    LDS_WAIT(); asm volatile("" ::: "memory");
}

#define XB_TMO      128
#define XB_XCNT(j)  (256  + 64 * (j))
#define XB_XSUB(j)  (1280 + 64 * (j))
#define XB_XGEN(j)  (2304 + 64 * (j))
#define XB_TOP      3328
#define XB_TOPGEN   3392
#define XCD_BAR_WORDS 3456
#define XB_SPIN_CAP (1u << 18)

__device__ __forceinline__ unsigned xb_ld(unsigned* p)              { return __hip_atomic_load(p, __ATOMIC_RELAXED, __HIP_MEMORY_SCOPE_AGENT); }
__device__ __forceinline__ unsigned xb_add(unsigned* p, unsigned v) { return __hip_atomic_fetch_add(p, v, __ATOMIC_RELAXED, __HIP_MEMORY_SCOPE_AGENT); }
__device__ __forceinline__ unsigned xb_xcc_id() { return (unsigned)__builtin_amdgcn_s_getreg((3 << 11) | 20) & 0xFu; }
#define XB_SPIN(cond, bar) do { unsigned _sp = 0; while (cond) { __builtin_amdgcn_s_sleep(1); \
    if ((++_sp & 255u) == 0u) { if (xb_ld(&(bar)[XB_TMO])) break; if (_sp > XB_SPIN_CAP) { atomicAdd(&(bar)[XB_TMO], 1u); break; } } } } while (0)

struct XcdBarrier {
    unsigned* bar; unsigned x;
    volatile LAS unsigned* st;
};

__device__ __forceinline__ XcdBarrier xcd_barrier_post(unsigned* bar, volatile LAS unsigned* st) {
    XcdBarrier b; b.bar = bar; b.x = xb_xcc_id(); b.st = st;
    if (threadIdx.x == 0) (void)xb_add(&bar[XB_XCNT(b.x)], 1u);
    return b;
}
__device__ __forceinline__ void xcd_barrier_complete(unsigned* bar, unsigned x, unsigned& nloc, unsigned& nx) {
    const unsigned G = gridDim.x * gridDim.y * gridDim.z;
    unsigned sum, cnt, mine, sp = 0u;
    for (;;) {
        sum = 0u; cnt = 0u; mine = 0u;
#pragma unroll
        for (unsigned j = 0; j < 16; ++j) { const unsigned c = xb_ld(&bar[XB_XCNT(j)]); sum += c; cnt += (c > 0u) ? 1u : 0u; mine = (j == x) ? c : mine; }
        if (sum == G) break;
        __builtin_amdgcn_s_sleep(1);
        if ((++sp & 255u) == 0u) { if (xb_ld(&bar[XB_TMO])) break; if (sp > XB_SPIN_CAP) { atomicAdd(&bar[XB_TMO], 1u); break; } }
    }
    nloc = mine > 0u ? mine : 1u; nx = cnt > 0u ? cnt : 1u;
}

__device__ __forceinline__ void xcd_barrier(const XcdBarrier& b) {
    asm volatile("s_waitcnt vmcnt(0)" ::: "memory");
    __syncthreads();
    if (threadIdx.x == 0) {
        unsigned* bar = b.bar;
        __builtin_amdgcn_s_waitcnt(0);
        unsigned nloc = b.st[0], nx = b.st[1];
        if (nloc == 0u) { xcd_barrier_complete(bar, b.x, nloc, nx); b.st[0] = nloc; b.st[1] = nx; }
        const unsigned old = xb_add(&bar[XB_XSUB(b.x)], 1u);
        const unsigned gen = old / nloc;
        if (old + 1u == (gen + 1u) * nloc) {
            __builtin_amdgcn_fence(__ATOMIC_RELEASE, "agent");
            asm volatile("s_waitcnt vmcnt(0)" ::: "memory");
            const unsigned og = xb_add(&bar[XB_TOP], 1u);
            const unsigned tg = og / nx;
            if (og + 1u == (tg + 1u) * nx) xb_add(&bar[XB_TOPGEN], 1u);
            else XB_SPIN(xb_ld(&bar[XB_TOPGEN]) == tg, bar);
            __builtin_amdgcn_fence(__ATOMIC_ACQUIRE, "agent");
            xb_add(&bar[XB_XGEN(b.x)], 1u);
            asm volatile("s_waitcnt vmcnt(0)" ::: "memory");
        } else {
            XB_SPIN(xb_ld(&bar[XB_XGEN(b.x)]) == gen, bar);
            __builtin_amdgcn_fence(__ATOMIC_ACQUIRE, "agent");
            asm volatile("s_waitcnt vmcnt(0)" ::: "memory");
        }
    }
    __syncthreads();
}

struct Args { const float* in[28]; float* out; unsigned char* ws; };

__device__ __forceinline__ void s5_tables(const Args& A, int g, int p) {
    const double lre = A.in[11][g * NP + p], lim = A.in[12][g * NP + p], dt = exp((double)A.in[13][g]);
    const double mag = exp(lre * dt); double x = lim * dt;
    const double TWO_PI = 6.283185307179586476925; x -= TWO_PI * rint(x / TWO_PI);
    const double x2 = x * x; double sn = 0.0, cs = 0.0;
#pragma unroll
    for (int k = 14; k >= 0; --k) { sn = sn * x2 * (-1.0 / ((2.0 * k + 2.0) * (2.0 * k + 3.0))) + 1.0; cs = cs * x2 * (-1.0 / ((2.0 * k + 1.0) * (2.0 * k + 2.0))) + 1.0; }
    sn *= x;
    const double ar = mag * cs, ai = mag * sn;
    const double den = lre * lre + lim * lim, nr = ar - 1.0;
    const double zr = (nr * lre + ai * lim) / den, zi = (ai * lre - nr * lim) / den;
    unsigned char* ws = A.ws;
    float* abar = (float*)(ws + WS_ABAR); float* a16 = (float*)(ws + WS_A16); float* a64 = (float*)(ws + WS_A64);
    abar[(g * NP + p) * 2] = (float)ar; abar[(g * NP + p) * 2 + 1] = (float)ai;
    double pr = ar, pi = ai;
#pragma unroll
    for (int s = 0; s < 4; ++s) { const double t = pr * pr - pi * pi; pi = 2.0 * pr * pi; pr = t; }
    a16[(g * NP + p) * 2] = (float)pr; a16[(g * NP + p) * 2 + 1] = (float)pi;
#pragma unroll
    for (int s = 0; s < 2; ++s) { const double t = pr * pr - pi * pi; pi = 2.0 * pr * pi; pr = t; }
    a64[(g * NP + p) * 2] = (float)pr; a64[(g * NP + p) * 2 + 1] = (float)pi;
    bf16_t* bbT = (bf16_t*)(ws + WS_BBT); bf16_t* cmT = (bf16_t*)(ws + WS_CMT);
    const int pb = p >> 5, pp = p & 31;
    const float* bre = A.in[14] + ((size_t)g * NP + p) * 16; const float* bim = A.in[15] + ((size_t)g * NP + p) * 16;
#pragma unroll
    for (int h = 0; h < 16; ++h) {
        const double br = bre[h], bi = bim[h];
        const float vr = (float)(zr * br - zi * bi), vi = (float)(zr * bi + zi * br);
        const int ln = pp + 32 * (h >> 3), i = h & 7;
        bbT[(((size_t)g * 4 + pb) * 64 + ln) * 8 + i] = (bf16_t)f2bf(vr);
        bbT[(((size_t)g * 4 + pb + 2) * 64 + ln) * 8 + i] = (bf16_t)f2bf(vi);
        const float cr = A.in[16][((size_t)g * 16 + h) * NP + p], ci = A.in[17][((size_t)g * 16 + h) * NP + p];
        const int ks = pp >> 4, l2 = h + 16 * ((pp & 15) >> 2), i2 = 2 * (pp & 3);
        cmT[((((size_t)g * 2 + pb) * 2 + ks) * 64 + l2) * 8 + i2] = (bf16_t)f2bf(cr);
        cmT[((((size_t)g * 2 + pb) * 2 + ks) * 64 + l2) * 8 + i2 + 1] = (bf16_t)f2bf(-ci);
    }
}

__device__ __forceinline__ const float* xrow_ptr(const Args& A, int row) { return row < MP ? A.in[0] + (size_t)row * DM : A.in[1] + (size_t)(row - MP) * DM; }

template <int PASS> __device__ __forceinline__ void s5_item(const Args& A, int item, int g, LAS unsigned char* sbuf  , int lane, bool use_carry, float& carry_r, float& carry_i, LAS float* ubuf  ) {
    unsigned char* ws = A.ws;
    const bool samp = item >= NB * NCH; const int n = item / NCH, c = item % NCH, b = item - NB * NCH;
    const int row0 = samp ? MP + 64 * b : n * SEQ + 64 * c;
    const float* ir0 = (const float*)(ws + WS_IR0);
    const float* gm = A.in[8];
    const int n32 = lane & 31, hh = lane >> 5;
    bf16x8 ua[2];
    {
        const int tp = 16 * ((n32 >> 2) & 1) + 4 * (n32 >> 3) + (n32 & 3);
        const f32x4 g0 = *(const f32x4*)(gm + 16 * g + 8 * hh), g1 = *(const f32x4*)(gm + 16 * g + 8 * hh + 4);
#pragma unroll
        for (int tb = 0; tb < 2; ++tb) { const int row = row0 + 32 * tb + tp; const float* xp = xrow_ptr(A, row) + 16 * g + 8 * hh; const float rs = ir0[row];
            const f32x4 x0 = *(const f32x4*)xp * rs * g0, x1 = *(const f32x4*)(xp + 4) * rs * g1;
            if (PASS == 2) { LAS float* up = ubuf + (32 * tb + tp) * 16 + 8 * hh; *(LAS f32x4*)up = x0; *(LAS f32x4*)(up + 4) = x1; }
            u32x4 w; w.x = cvt_pk_bf16(x0[0], x0[1]); w.y = cvt_pk_bf16(x0[2], x0[3]); w.z = cvt_pk_bf16(x1[0], x1[1]); w.w = cvt_pk_bf16(x1[2], x1[3]); ua[tb] = __builtin_bit_cast(bf16x8, w); }
    }
    float hin_r = 0.f, hin_i = 0.f;
    if (PASS == 2) {
        if (samp) { hin_r = A.in[2][((size_t)b * NG + g) * NP + lane]; hin_i = A.in[3][((size_t)b * NG + g) * NP + lane]; }
        else if (use_carry) { hin_r = carry_r; hin_i = carry_i; }
        else if (c > 0) { const f32x2 hv = *(const f32x2*)((const float*)(ws + WS_HIN) + (((size_t)item * NG + g) * NP + lane) * 2); hin_r = hv.x; hin_i = hv.y; }
    }
    f32x4 yacc[4] = {(f32x4){0, 0, 0, 0}, (f32x4){0, 0, 0, 0}, (f32x4){0, 0, 0, 0}, (f32x4){0, 0, 0, 0}};
    const bf16_t* bbT = (const bf16_t*)(ws + WS_BBT); const bf16_t* cmT = (const bf16_t*)(ws + WS_CMT);
#pragma unroll 1
    for (int pb = 0; pb < 2; ++pb) {
        const int p = 32 * pb + n32;
        const bf16x8 Bre = *(const bf16x8*)(bbT + (((size_t)g * 4 + pb) * 64 + lane) * 8), Bim = *(const bf16x8*)(bbT + (((size_t)g * 4 + pb + 2) * 64 + lane) * 8);
        f32x16 xr[2], xi[2];
        const f32x16 z16 = f32x16{};
#pragma unroll
        for (int tb = 0; tb < 2; ++tb) { xr[tb] = __builtin_amdgcn_mfma_f32_32x32x16_bf16(ua[tb], Bre, z16, 0, 0, 0); xi[tb] = __builtin_amdgcn_mfma_f32_32x32x16_bf16(ua[tb], Bim, z16, 0, 0, 0); }
        const f32x2 ab = *(const f32x2*)(ws + WS_ABAR + ((size_t)(g * NP + p)) * 8), a16 = *(const f32x2*)(ws + WS_A16 + ((size_t)(g * NP + p)) * 8);
        const float ar = ab.x, ai = ab.y;
#pragma unroll
        for (int tb = 0; tb < 2; ++tb)
#pragma unroll
            for (int r = 1; r < 16; ++r) { const float pr = xr[tb][r - 1], pi = xi[tb][r - 1];
                xr[tb][r] += ar * pr - ai * pi; xi[tb][r] += ar * pi + ai * pr; }
        float H_r = __shfl(hin_r, p), H_i = __shfl(hin_i, p);
        float Hs_r[2], Hs_i[2];
#pragma unroll
        for (int tb = 0; tb < 2; ++tb) {
            const float er = xr[tb][15], ei = xi[tb][15];
            const float or_ = __shfl_xor(er, 32), oi_ = __shfl_xor(ei, 32);
            const float e0r = hh ? or_ : er, e0i = hh ? oi_ : ei, e1r = hh ? er : or_, e1i = hh ? ei : oi_;
            const float h0r = H_r, h0i = H_i;
            const float h1r = a16.x * h0r - a16.y * h0i + e0r, h1i = a16.x * h0i + a16.y * h0r + e0i;
            const float h2r = a16.x * h1r - a16.y * h1i + e1r, h2i = a16.x * h1i + a16.y * h1r + e1i;
            Hs_r[tb] = hh ? h1r : h0r; Hs_i[tb] = hh ? h1i : h0i;
            H_r = h2r; H_i = h2i;
        }
        if (PASS == 2) { if ((lane >> 5) == pb) { carry_r = H_r; carry_i = H_i; } }
        if (PASS == 1) {
            if (hh == 0) { float* e1 = (float*)(ws + WS_E1) + (((size_t)item * NG + g) * NP + p) * 2; *(f32x2*)e1 = (f32x2){H_r, H_i}; }
        } else {
            if (samp || c == NCH - 1) { if (hh == 0) { const size_t o = samp ? ((size_t)b * NG + g) * NP + p : ((size_t)n * NG + g) * NP + p;
                A.out[(samp ? O_SRE_S : O_SRE_P) + o] = H_r; A.out[(samp ? O_SIM_S : O_SIM_P) + o] = H_i; } }
#pragma unroll
            for (int tb = 0; tb < 2; ++tb) { float cr = Hs_r[tb], ci = Hs_i[tb];
#pragma unroll
                for (int r = 0; r < 16; ++r) { const float t = ar * cr - ai * ci; ci = ar * ci + ai * cr; cr = t;
                    const float sr = xr[tb][r] + cr, si = xi[tb][r] + ci;
                    LAS unsigned* rowp = (LAS unsigned*)(sbuf + (32 * tb + 16 * hh + r) * 144);
                    rowp[n32] = cvt_pk_bf16(sr, si); } }
            LDS_WAIT(); asm volatile("" ::: "memory");
#pragma unroll
            for (int ks = 0; ks < 2; ++ks) { const bf16x8 Bc = *(const bf16x8*)(cmT + ((((size_t)g * 2 + pb) * 2 + ks) * 64 + lane) * 8);
#pragma unroll
                for (int t4 = 0; t4 < 4; ++t4) { const bf16x8 Af = *(const LAS bf16x8*)(sbuf + (16 * t4 + (lane & 15)) * 144 + ks * 64 + (lane >> 4) * 16);
                    yacc[t4] = __builtin_amdgcn_mfma_f32_16x16x32_bf16(Af, Bc, yacc[t4], 0, 0, 0); } }
            LDS_WAIT(); asm volatile("" ::: "memory");
        }
    }
    if (PASS == 2) {
        const int h = lane & 15, ch = 16 * g + h; const float dsk = A.in[18][ch];
        bf16_t* G = (bf16_t*)(ws + WS_G);
#pragma unroll
        for (int t4 = 0; t4 < 4; ++t4)
#pragma unroll
            for (int r = 0; r < 4; ++r) { const int row = row0 + 16 * t4 + 4 * (lane >> 4) + r;
                const float u = ubuf[(16 * t4 + 4 * (lane >> 4) + r) * 16 + h]; const float v = yacc[t4][r] + dsk * u;
                G[(size_t)row * DM + ch] = (bf16_t)f2bf(gelu_tanh(v)); }
        LDS_WAIT(); asm volatile("" ::: "memory");
    }
}

#ifndef PHM
#define PHM 2047
#endif
constexpr int LDS_BYTES = 147456;
constexpr int XCH_OFF = 131072;

__device__ __forceinline__ Args ldargs() {
#if defined(__HIP_DEVICE_COMPILE__)
    const __attribute__((address_space(4))) Args* p = (const __attribute__((address_space(4))) Args*)__builtin_amdgcn_kernarg_segment_ptr(); asm volatile("" : "+s"(p)); return *p;
#else
    return Args{};
#endif
}
#define PHASE_ARGS const Args A = ldargs(); unsigned char* const ws = A.ws; float* const sumsq = (float*)(ws + WS_SS); float* const X = (float*)(ws + WS_X); bf16_t* const XB = (bf16_t*)(ws + WS_XB); \
    int tid_p = threadIdx.x; asm volatile("" : "+v"(tid_p)); const int tid = tid_p, lane = tid & 63, wave = __builtin_amdgcn_readfirstlane(tid >> 6); const int gw = bx * 8 + wave; \
    (void)sumsq; (void)X; (void)XB; (void)lane; (void)gw; (void)ws
__global__ void __launch_bounds__(512, 2) fwd_mega(Args Aparam) {
    extern __shared__ __attribute__((aligned(16))) unsigned char lds[];
    cg::grid_group grid = cg::this_grid();
    LAS unsigned char* L = (LAS unsigned char*)lds;
    const int G = gridDim.x, bx = blockIdx.x, NGW = G * 8;
    volatile LAS unsigned* bst = (volatile LAS unsigned*)(L + 139008);
    if (threadIdx.x == 0) { bst[0] = 0u; bst[1] = 0u; }
    __syncthreads();
    const XcdBarrier xbar = xcd_barrier_post((unsigned*)(ldargs().ws + WS_BAR), bst);
    if (G == 0x7fffffff) grid.sync();

    volatile LAS unsigned long long* TS = (volatile LAS unsigned long long*)(L + 140000);
    int n_ts = 0;
#ifdef PROBE_A
#define STAMP() do { if (threadIdx.x == 0) TS[n_ts] = __builtin_amdgcn_s_memrealtime(); ++n_ts; } while (0)
#else
#define STAMP() do { (void)TS; (void)n_ts; } while (0)
#endif
    STAMP();
    if (PHM & 1) { PHASE_ARGS;
        for (int i = bx * 512 + tid; i < 4 * MT; i += G * 512) sumsq[i] = 0.f;
        if (bx == 0 && tid < 128) ((unsigned*)(ws + WS_CNT))[tid] = 0u;
        for (int g = gw; g < NG; g += NGW) s5_tables(A, g, lane);
        float* ir0 = (float*)(ws + WS_IR0);
        for (int m = gw; m < MT; m += NGW) { const f32x4* xr = (const f32x4*)xrow_ptr(A, m) + lane; float s = 0.f;
#pragma unroll
            for (int j = 0; j < 4; ++j) { const f32x4 v = xr[64 * j]; s += (v.x * v.x + v.y * v.y) + (v.z * v.z + v.w * v.w); }
            s = wave_sum(s); if (lane == 0) ir0[m] = __builtin_amdgcn_rsqf(s * (1.0f / DM) + EPS); }
    }
    xcd_barrier(xbar); STAMP();

    if (PHM & 2) { PHASE_ARGS;
        {
        LAS float* scr = (LAS float*)(L + wave * 16384);
        constexpr int I_GLU = 16 * 64, I_UG = 16 * 176, I_DN = 44 * 32, I_QKV = 16 * 104, I_WO = 16 * 32;
        constexpr int NW_ITEMS = I_GLU + 2 * I_UG + 2 * I_DN + I_QKV + I_WO;
        for (int it = gw; it < NW_ITEMS; it += NGW) {
            int r = it;
            if (r < I_GLU) { const int kb = r / 64, nb = r % 64, pn = nb >> 3, j = nb & 7; const int src = j < 4 ? 128 * pn + 32 * j : 1024 + 128 * pn + 32 * (j - 4);
                transpose_item(A.in[19], DM, 2048, src, 32, nullptr, (bf16_t*)(ws + WS_WGLU), 32 * nb, scr, kb, lane); continue; } r -= I_GLU;
            if (r < 2 * I_UG) { const int l = r / I_UG; r %= I_UG; const int kb = r / 176, nb = r % 176, pn = nb >> 3, j = nb & 7;
                const float* W = (j < 4 ? A.in[23] : A.in[24]) + (size_t)l * DM * FF; const int src = 128 * pn + 32 * (j & 3);
                transpose_item(W, DM, FF, src, 32, A.in[9] + l * DM, (bf16_t*)(ws + WS_WUG) + (size_t)l * 5632 * DM, 32 * nb, scr, kb, lane); continue; } r -= 2 * I_UG;
            if (r < 2 * I_DN) { const int l = r / I_DN; r %= I_DN; const int kb = r / 32, nb = r % 32;
                transpose_item(A.in[27] + (size_t)l * FF * DM, FF, DM, 32 * nb, 32, nullptr, (bf16_t*)(ws + WS_WDN) + (size_t)l * DM * FF, 32 * nb, scr, kb, lane); continue; } r -= 2 * I_DN;
            if (r < I_QKV) { const int kb = r / 104, nb = r % 104; int valid = 3088 - 32 * nb; valid = valid < 0 ? 0 : (valid > 32 ? 32 : valid);
                transpose_item(A.in[20], DM, 3088, 32 * nb, valid, A.in[8] + DM, (bf16_t*)(ws + WS_WQKV), 32 * nb, scr, kb, lane); continue; } r -= I_QKV;
            { const int kb = r / 32, nb = r % 32; transpose_item(A.in[22], DM, DM, 32 * nb, 32, nullptr, (bf16_t*)(ws + WS_WO), 32 * nb, scr, kb, lane); }
        }
        }
        __syncthreads();
        LAS unsigned char* sbuf = L + wave * 9216;
        float cr_ = 0.f, ci_ = 0.f;
        for (int it = gw; it < NB * NCH * NG; it += NGW) { const int item = it / NG, g = it % NG; if ((item % NCH) == NCH - 1) continue; s5_item<1>(A, item, g, sbuf, lane, false, cr_, ci_, (LAS float*)(L + 73728 + wave * 4096)); }
    }
    xcd_barrier(xbar); STAMP();
    if (PHM & 4) { PHASE_ARGS;
        for (int sq = gw; sq < NB * NG; sq += NGW) { const int n = sq / NG, g = sq % NG;
            const f32x2 a64 = *(const f32x2*)(ws + WS_A64 + ((size_t)(g * NP + lane)) * 8);
            const float* e1 = (const float*)(ws + WS_E1) + (((size_t)(n * NCH) * NG + g) * NP + lane) * 2; float* ho = (float*)(ws + WS_HIN) + (((size_t)(n * NCH) * NG + g) * NP + lane) * 2;
            float hr = 0.f, hi_ = 0.f;
            for (int c0 = 0; c0 < NCH - 1; c0 += 16) { f32x2 ev[16];
#pragma unroll
                for (int k = 0; k < 16; ++k) if (c0 + k < NCH - 1) ev[k] = *(const f32x2*)(e1 + (size_t)(c0 + k) * NG * NP * 2);
#pragma unroll
                for (int k = 0; k < 16; ++k) if (c0 + k < NCH - 1) { const float tr = a64.x * hr - a64.y * hi_ + ev[k].x; hi_ = a64.x * hi_ + a64.y * hr + ev[k].y; hr = tr;
                    *(f32x2*)(ho + (size_t)(c0 + k + 1) * NG * NP * 2) = (f32x2){hr, hi_}; } }
        }
    }
    xcd_barrier(xbar); STAMP();
    if (PHM & 4) { PHASE_ARGS;
        LAS unsigned char* sbuf = L + wave * 9216;
        { float cr_ = 0.f, ci_ = 0.f;
          for (int it = gw; it < NITEM * NG; it += NGW) { const int item = it / NG, g = it % NG; s5_item<2>(A, item, g, sbuf, lane, false, cr_, ci_, (LAS float*)(L + 73728 + wave * 4096)); } }
    }
    xcd_barrier(xbar); STAMP();

    if (PHM & 8) { PHASE_ARGS;
        pg8::Gemm g{(const bf16_t*)(ws + WS_G), (const bf16_t*)(ws + WS_WGLU), DM, 16}; pg8::Order<false> S; S.init(MT / 256, 8, G, bx);
        EpiRes<1, true, true, false> E{A.in[0], A.in[1], X, XB, sumsq};
        pg8::gemm_phase(L, g, S, E);
    }
    xcd_barrier(xbar); STAMP();

    { constexpr int layer = 0;
        if (layer == 1) {
            if (PHM & 16) { PHASE_ARGS;
                pg8::Gemm g{XB, (const bf16_t*)(ws + WS_WQKV), DM, 16}; pg8::Order<false> S; S.init(MT / 256, 13, G, bx);
                EpiQKV E{sumsq + 1 * MT, A.in[21], (bf16_t*)(ws + WS_Q), (bf16_t*)(ws + WS_KP), (bf16_t*)(ws + WS_VP), (bf16_t*)(ws + WS_KS), (bf16_t*)(ws + WS_VS), A.out};
                pg8::gemm_phase(L, g, S, E);
            }
            xcd_barrier(xbar); STAMP();
            if (PHM & 64) { PHASE_ARGS;
                const bf16_t* Q = (const bf16_t*)(ws + WS_Q); bf16_t* O = (bf16_t*)(ws + WS_Q);
                const bf16_t* Kp = (const bf16_t*)(ws + WS_KP); const bf16_t* Vp = (const bf16_t*)(ws + WS_VP);
                const bf16_t* Ks = (const bf16_t*)(ws + WS_KS); const bf16_t* Vs = (const bf16_t*)(ws + WS_VS);
                float* ckw = (float*)(ws + WS_CKW) + (size_t)(bx & 255) * SEQ; bf16_t* kxw = (bf16_t*)(ws + WS_KXW) + (size_t)(bx & 255) * SEQ * 16;
                int last_bh = -1;
                for (int idx = bx; idx < 9 * 256; idx += G) {
                    const int i = idx >> 8, v = idx & 255;
                    if (i < 8) { const int bh = v >> 2, s = v & 3, b = bh >> 4, h = bh & 15; const int qb = (i & 1) ? (8 * (i >> 1) + 7 - s) : (8 * (i >> 1) + s);
                        if (bh != last_bh) { wg_cumsum_prompt(A.out + O_LF_P, b, h, ckw, kxw, (LAS float*)L); last_bh = bh; }
                        atf::attn_unit<8>(b, h, qb, (const atf::bf16*)Q, (const atf::bf16*)Kp, (const atf::bf16*)Vp, (atf::bf16*)O, (const atf::bf16*)kxw, ckw, (char*)lds);
                    } else { const int b = v >> 4, h = v & 15;
                        att::attn_unit_sample((char*)lds, Q + ((size_t)MP + 64 * b) * DM + h * HD, A.in[4] + (size_t)b * PAST * DM + h * HD, A.in[5] + (size_t)b * PAST * DM + h * HD,
                                              A.out + O_K_S + (size_t)b * SS * DM + h * HD, A.out + O_V_S + (size_t)b * SS * DM + h * HD, O + ((size_t)MP + 64 * b) * DM + h * HD,
                                              A.in[6] + (size_t)b * PAST * NH + h, A.out + O_LF_S + (size_t)b * SS * NH + h);
                    }
                }
            }
            xcd_barrier(xbar); STAMP();
            if (PHM & 128) { PHASE_ARGS;
                pg8::Gemm g{(const bf16_t*)(ws + WS_Q), (const bf16_t*)(ws + WS_WO), DM, 16}; pg8::Order<false> S; S.init(MT / 256, 4, G, bx);
                EpiRes<0, false, true, false> E{X, X + (size_t)MP * DM, X, XB, sumsq + 2 * MT};
                pg8::gemm_phase(L, g, S, E);
            }
            xcd_barrier(xbar); STAMP();
        }
        if (PHM & 256) { PHASE_ARGS;
            pg8::Gemm g{XB, (const bf16_t*)(ws + WS_WUG) + (size_t)layer * 5632 * DM, DM, 16}; pg8::Order<true> S; S.init(136, 22, G, bx);
            EpiConv E{(bf16_t*)(ws + WS_H), sumsq + (layer == 0 ? 0 : 2 * MT), A.in[25] + (size_t)layer * 3 * FF, A.in[26] + (size_t)layer * FF, A.in[7] + (size_t)layer * SB * 2 * FF,
                      A.out + O_CV_P + (size_t)layer * NB * 2 * FF, A.out + O_CV_S + (size_t)layer * SB * 2 * FF, (LAS float*)(L + XCH_OFF)};
            pg8::gemm_phase(L, g, S, E);
        }
        xcd_barrier(xbar); STAMP();
        if (PHM & 512) { PHASE_ARGS;
            pg8::Gemm g{(const bf16_t*)(ws + WS_H), (const bf16_t*)(ws + WS_WDN) + (size_t)layer * DM * FF, FF, 44}; pg8::Order<false> S; S.init(MP / 256, 4, G, bx);
            pg8::Gemm gt{g.A, g.Bt, FF, 4}; pg8::OrderTail<MP / 256, 4, 4, 11> St{G, bx};
            if (layer == 0) { EpiRes<0, false, true, false> E{X, X + (size_t)MP * DM, X, XB, sumsq + 1 * MT}; pg8::gemm_phase(L, g, S, E);
                EpiSplitK<EpiRes<0, false, true, false>, 11, 4, MP / 256, WS_PDN0, 64> Et{E, ws}; pg8::gemm_phase(L, gt, St, Et); }
            else { EpiRes<0, false, false, true> E{X, X + (size_t)MP * DM, X, XB, sumsq + 3 * MT}; pg8::gemm_phase(L, g, S, E);
                EpiSplitK<EpiRes<0, false, false, true>, 11, 4, MP / 256, WS_PDN1, 96> Et{E, ws}; pg8::gemm_phase(L, gt, St, Et); }
        }
        xcd_barrier(xbar); STAMP();
        }
    { constexpr int layer = 1;
        if (layer == 1) {
            if (PHM & 16) { PHASE_ARGS;
                pg8::Gemm g{XB, (const bf16_t*)(ws + WS_WQKV), DM, 16}; pg8::Order<false> S; S.init(MT / 256, 13, G, bx);
                EpiQKV E{sumsq + 1 * MT, A.in[21], (bf16_t*)(ws + WS_Q), (bf16_t*)(ws + WS_KP), (bf16_t*)(ws + WS_VP), (bf16_t*)(ws + WS_KS), (bf16_t*)(ws + WS_VS), A.out};
                pg8::gemm_phase(L, g, S, E);
            }
            xcd_barrier(xbar); STAMP();
            if (PHM & 64) { PHASE_ARGS;
                const bf16_t* Q = (const bf16_t*)(ws + WS_Q); bf16_t* O = (bf16_t*)(ws + WS_Q);
                const bf16_t* Kp = (const bf16_t*)(ws + WS_KP); const bf16_t* Vp = (const bf16_t*)(ws + WS_VP);
                const bf16_t* Ks = (const bf16_t*)(ws + WS_KS); const bf16_t* Vs = (const bf16_t*)(ws + WS_VS);
                float* ckw = (float*)(ws + WS_CKW) + (size_t)(bx & 255) * SEQ; bf16_t* kxw = (bf16_t*)(ws + WS_KXW) + (size_t)(bx & 255) * SEQ * 16;
                int last_bh = -1;
                for (int idx = bx; idx < 9 * 256; idx += G) {
                    const int i = idx >> 8, v = idx & 255;
                    if (i < 8) { const int bh = v >> 2, s = v & 3, b = bh >> 4, h = bh & 15; const int qb = (i & 1) ? (8 * (i >> 1) + 7 - s) : (8 * (i >> 1) + s);
                        if (bh != last_bh) { wg_cumsum_prompt(A.out + O_LF_P, b, h, ckw, kxw, (LAS float*)L); last_bh = bh; }
                        atf::attn_unit<8>(b, h, qb, (const atf::bf16*)Q, (const atf::bf16*)Kp, (const atf::bf16*)Vp, (atf::bf16*)O, (const atf::bf16*)kxw, ckw, (char*)lds);
                    } else { const int b = v >> 4, h = v & 15;
                        att::attn_unit_sample((char*)lds, Q + ((size_t)MP + 64 * b) * DM + h * HD, A.in[4] + (size_t)b * PAST * DM + h * HD, A.in[5] + (size_t)b * PAST * DM + h * HD,
                                              A.out + O_K_S + (size_t)b * SS * DM + h * HD, A.out + O_V_S + (size_t)b * SS * DM + h * HD, O + ((size_t)MP + 64 * b) * DM + h * HD,
                                              A.in[6] + (size_t)b * PAST * NH + h, A.out + O_LF_S + (size_t)b * SS * NH + h);
                    }
                }
            }
            xcd_barrier(xbar); STAMP();
            if (PHM & 128) { PHASE_ARGS;
                pg8::Gemm g{(const bf16_t*)(ws + WS_Q), (const bf16_t*)(ws + WS_WO), DM, 16}; pg8::Order<false> S; S.init(MT / 256, 4, G, bx);
                EpiRes<0, false, true, false> E{X, X + (size_t)MP * DM, X, XB, sumsq + 2 * MT};
                pg8::gemm_phase(L, g, S, E);
            }
            xcd_barrier(xbar); STAMP();
        }
        if (PHM & 256) { PHASE_ARGS;
            pg8::Gemm g{XB, (const bf16_t*)(ws + WS_WUG) + (size_t)layer * 5632 * DM, DM, 16}; pg8::Order<true> S; S.init(136, 22, G, bx);
            EpiConv E{(bf16_t*)(ws + WS_H), sumsq + (layer == 0 ? 0 : 2 * MT), A.in[25] + (size_t)layer * 3 * FF, A.in[26] + (size_t)layer * FF, A.in[7] + (size_t)layer * SB * 2 * FF,
                      A.out + O_CV_P + (size_t)layer * NB * 2 * FF, A.out + O_CV_S + (size_t)layer * SB * 2 * FF, (LAS float*)(L + XCH_OFF)};
            pg8::gemm_phase(L, g, S, E);
        }
        xcd_barrier(xbar); STAMP();
        if (PHM & 512) { PHASE_ARGS;
            pg8::Gemm g{(const bf16_t*)(ws + WS_H), (const bf16_t*)(ws + WS_WDN) + (size_t)layer * DM * FF, FF, 44}; pg8::Order<false> S; S.init(MP / 256, 4, G, bx);
            pg8::Gemm gt{g.A, g.Bt, FF, 4}; pg8::OrderTail<MP / 256, 4, 4, 11> St{G, bx};
            if (layer == 0) { EpiRes<0, false, true, false> E{X, X + (size_t)MP * DM, X, XB, sumsq + 1 * MT}; pg8::gemm_phase(L, g, S, E);
                EpiSplitK<EpiRes<0, false, true, false>, 11, 4, MP / 256, WS_PDN0, 64> Et{E, ws}; pg8::gemm_phase(L, gt, St, Et); }
            else { EpiRes<0, false, false, true> E{X, X + (size_t)MP * DM, X, XB, sumsq + 3 * MT}; pg8::gemm_phase(L, g, S, E);
                EpiSplitK<EpiRes<0, false, false, true>, 11, 4, MP / 256, WS_PDN1, 96> Et{E, ws}; pg8::gemm_phase(L, gt, St, Et); }
        }
        xcd_barrier(xbar); STAMP();
        }
    if (PHM & 1024) { PHASE_ARGS;
        const float* gf = A.in[10]; const float* ssq = sumsq + 3 * MT;
        for (int m = gw; m < MT; m += NGW) { const float rs = __builtin_amdgcn_rsqf(ssq[m] * (1.0f / DM) + EPS);
            const f32x4* xr = (const f32x4*)(X + (size_t)m * DM) + lane; f32x4* o = (f32x4*)(A.out + O_Y + (size_t)m * DM) + lane; const f32x4* gg = (const f32x4*)gf + lane;
#pragma unroll
            for (int j = 0; j < 4; ++j) __builtin_nontemporal_store(xr[64 * j] * rs * gg[64 * j], o + 64 * j); }
    }
#ifdef PROBE_A
    STAMP();
    if (bx == 0 && threadIdx.x == 0) { const unsigned long long dt = TS[PROBE_B] - TS[PROBE_A], t0 = __builtin_amdgcn_s_memrealtime(); while (__builtin_amdgcn_s_memrealtime() - t0 < dt) __builtin_amdgcn_s_sleep(8); }
#endif
}

extern "C" void kernel_launch(void* const* d_in, const int* in_sizes, int n_in, void* d_out, int out_size, void* d_ws, size_t ws_size, hipStream_t stream) {
    static int grid = 0;
    if (grid == 0) {
        int dev = 0, cus = 0, per_cu = 0;
        hipGetDevice(&dev); hipDeviceGetAttribute(&cus, hipDeviceAttributeMultiprocessorCount, dev);
        hipFuncSetAttribute((const void*)fwd_mega, hipFuncAttributeMaxDynamicSharedMemorySize, LDS_BYTES);
        hipOccupancyMaxActiveBlocksPerMultiprocessor(&per_cu, (const void*)fwd_mega, 512, LDS_BYTES);
        if (per_cu < 1) per_cu = 1;
        grid = cus * 1;
        if (grid <= 0) grid = 256;
    }
    (void)hipMemsetAsync((char*)d_ws + WS_BAR, 0, XCD_BAR_WORDS * 4, stream);
    Args a{};
    for (int i = 0; i < 28; ++i) a.in[i] = (const float*)d_in[i];
    a.out = (float*)d_out; a.ws = (unsigned char*)d_ws;
    void* args[] = {&a};
    hipError_t e = hipLaunchCooperativeKernel((const void*)fwd_mega, dim3(grid), dim3(512), args, LDS_BYTES, stream);
    if (e != hipSuccess) fprintf(stderr, "cooperative launch failed: %s (grid %d)\n", hipGetErrorString(e), grid);
}
```
